# Optimizing an MI355X kernel written in HIP

```python
import jax, jax.numpy as jnp
from jax import lax
import numpy as np


D_MODEL = 2048
BATCH = 2
SEQ = 4096
DEPTH = 1

EPS = 1e-6
HEAD_DIM = 64
ATTN_WIDTH = D_MODEL // 2
N_HEADS_A = ATTN_WIDTH // HEAD_DIM
N_KV_HEADS = 4
GROUP_SIZE = N_HEADS_A // N_KV_HEADS
KV_WIDTH = N_KV_HEADS * HEAD_DIM
IDX_HEADS = 16
IDX_DIM = 64
TOPK_MAX = 256
Q_BLOCK = 128
CONV_WIDTH = D_MODEL // 2
CONV_K = 3
N_GROUPS = 4
EXPERTS_PER_GROUP = 8
N_EXPERTS = N_GROUPS * EXPERTS_PER_GROUP
TOP_K_IN_GROUP = 2
EXPERT_FF = 512
TOKEN_CHUNK = 128
N_MOD = 6
PROJ_SIZES = (ATTN_WIDTH, KV_WIDTH, KV_WIDTH, IDX_HEADS * IDX_DIM, IDX_DIM, IDX_HEADS,
              CONV_WIDTH, CONV_WIDTH, CONV_WIDTH, D_MODEL, D_MODEL)
PROJ_WIDTH = sum(PROJ_SIZES)

kernel_name = 'hybrid_dsa_shortconv_hmoe_block'


def _rmsnorm(x, g):
    xf = x.astype(jnp.float32)
    r = lax.rsqrt(jnp.mean(xf * xf, axis=-1, keepdims=True) + EPS)
    return (xf * r).astype(x.dtype) * g


def _sparse_attention(q, k, v, iq, ik, iw):
    b, s = q.shape[0], q.shape[1]
    k_top = min(TOPK_MAX, s // 4)
    nb = s // Q_BLOCK
    neg = jnp.finfo(jnp.float32).min
    key_pos = jnp.arange(s)
    ik32 = ik.astype(jnp.float32)

    def to_blocks(a):
        return jnp.moveaxis(a.reshape((b, nb, Q_BLOCK) + a.shape[2:]), 1, 0)

    def block(args):
        qb, iqb, iwb, t0 = args
        q_pos = t0 + jnp.arange(Q_BLOCK)
        rel = jax.nn.relu(jnp.einsum('bqhd,bsd->bqhs', iqb.astype(jnp.float32), ik32) * (IDX_DIM ** -0.5))
        score = jnp.einsum('bqhs,bqh->bqs', rel, iwb.astype(jnp.float32) * (IDX_HEADS ** -0.5))
        causal = key_pos[None, :] <= q_pos[:, None]
        score = jnp.where(causal[None], score, neg)
        _, sel = lax.top_k(score, k_top)
        k_sel = jax.vmap(lambda kb, ib: kb[ib])(k, sel)
        v_sel = jax.vmap(lambda vb, ib: vb[ib])(v, sel)
        qg = qb.reshape(b, Q_BLOCK, N_KV_HEADS, GROUP_SIZE, HEAD_DIM)
        logits = jnp.einsum('bqgrd,bqkgd->bqgrk', qg, k_sel).astype(jnp.float32) * (HEAD_DIM ** -0.5)
        valid = (sel <= q_pos[None, :, None])[:, :, None, None, :]
        p = jax.nn.softmax(jnp.where(valid, logits, neg), axis=-1).astype(v.dtype)
        o = jnp.einsum('bqgrk,bqkgd->bqgrd', p, v_sel)
        return o.reshape(b, Q_BLOCK, N_HEADS_A * HEAD_DIM)

    starts = jnp.arange(nb) * Q_BLOCK
    out = lax.map(block, (to_blocks(q), to_blocks(iq), to_blocks(iw), starts))
    return jnp.moveaxis(out, 0, 1).reshape(b, s, N_HEADS_A * HEAD_DIM)


def _short_conv(u, w):
    s = u.shape[1]
    pad = jnp.pad(u, ((0, 0), (CONV_K - 1, 0), (0, 0)))
    y = w[0] * pad[:, 0:s]
    for j in range(1, CONV_K):
        y = y + w[j] * pad[:, j:j + s]
    return y


def _hybrid_mixer(h, w_in, conv_w, w_a_up, w_b_out, w_o):
    b, s, _ = h.shape
    proj = h @ w_in
    points = np.cumsum(PROJ_SIZES)[:-1].tolist()
    q, k, v, iq, ik, iw, bg, cg, xc, gate_a, gate_b = jnp.split(proj, points, axis=-1)
    o_a = _sparse_attention(q.reshape(b, s, N_HEADS_A, HEAD_DIM),
                            k.reshape(b, s, N_KV_HEADS, HEAD_DIM),
                            v.reshape(b, s, N_KV_HEADS, HEAD_DIM),
                            iq.reshape(b, s, IDX_HEADS, IDX_DIM), ik, iw)
    y_a = o_a @ w_a_up
    y_b = (bg * _short_conv(cg * xc, conv_w)) @ w_b_out
    merged = jax.nn.sigmoid(gate_a) * y_a + jax.nn.sigmoid(gate_b) * y_b
    return merged @ w_o


def _hier_moe(h, w_rg, b_rg, w_re, b_re, w_gate, w_up, w_down):
    b, s, d = h.shape
    t = h.reshape(b * s, d)
    g_logits = (t @ w_rg + b_rg).astype(jnp.float32)
    p_group = jax.nn.softmax(g_logits, axis=-1)
    g_sel = jnp.argmax(g_logits, axis=-1)
    e_logits = (t @ w_re + b_re).astype(jnp.float32).reshape(-1, N_GROUPS, EXPERTS_PER_GROUP)
    within = jnp.take_along_axis(e_logits, g_sel[:, None, None], axis=1)[:, 0]
    top_v, top_e = lax.top_k(within, TOP_K_IN_GROUP)
    p_in = jax.nn.softmax(top_v, axis=-1)
    p_g = jnp.take_along_axis(p_group, g_sel[:, None], axis=1)
    weights = p_g * p_in
    eid = g_sel[:, None] * EXPERTS_PER_GROUP + top_e
    combine = jnp.einsum('nk,nke->ne', weights,
                         jax.nn.one_hot(eid, N_EXPERTS, dtype=jnp.float32)).astype(h.dtype)
    nc = t.shape[0] // TOKEN_CHUNK

    def chunk(args):
        tc, cc = args
        a = jnp.einsum('nd,edf->nef', tc, w_gate)
        u = jnp.einsum('nd,edf->nef', tc, w_up)
        act = jax.nn.silu(a) * u * cc[:, :, None]
        return jnp.einsum('nef,efd->nd', act, w_down)

    out = lax.map(chunk, (t.reshape(nc, TOKEN_CHUNK, d), combine.reshape(nc, TOKEN_CHUNK, N_EXPERTS)))
    return out.reshape(b, s, d)


def _normal(key, shape, scale):
    return jax.random.normal(key, shape, jnp.float32) * scale


def setup_inputs(seed: int = 0) -> dict:
    key = jax.random.key(seed)
    ks = jax.random.split(key, 19)
    D = D_MODEL
    return {
        'x': _normal(ks[0], (BATCH, SEQ, D), 1.0),
        'c': _normal(ks[1], (BATCH, D), 1.0),
        'w_ada': _normal(ks[2], (DEPTH, D, N_MOD * D), D ** -0.5),
        'b_ada': _normal(ks[3], (DEPTH, N_MOD * D), 0.02),
        'g_norm_mix': 1.0 + _normal(ks[4], (DEPTH, D), 0.05),
        'w_in': _normal(ks[5], (DEPTH, D, PROJ_WIDTH), D ** -0.5),
        'conv_w': _normal(ks[6], (DEPTH, CONV_K, CONV_WIDTH), CONV_K ** -0.5),
        'w_a_up': _normal(ks[7], (DEPTH, ATTN_WIDTH, D), ATTN_WIDTH ** -0.5),
        'w_b_out': _normal(ks[8], (DEPTH, CONV_WIDTH, D), CONV_WIDTH ** -0.5),
        'w_o': _normal(ks[9], (DEPTH, D, D), D ** -0.5),
        'g_norm_ffn': 1.0 + _normal(ks[10], (DEPTH, D), 0.05),
        'w_rg': _normal(ks[11], (DEPTH, D, N_GROUPS), D ** -0.5),
        'b_rg': _normal(ks[12], (DEPTH, N_GROUPS), 0.01),
        'w_re': _normal(ks[13], (DEPTH, D, N_EXPERTS), D ** -0.5),
        'b_re': _normal(ks[14], (DEPTH, N_EXPERTS), 0.01),
        'w_e_gate': _normal(ks[15], (DEPTH, N_EXPERTS, D, EXPERT_FF), D ** -0.5),
        'w_e_up': _normal(ks[16], (DEPTH, N_EXPERTS, D, EXPERT_FF), D ** -0.5),
        'w_e_down': _normal(ks[17], (DEPTH, N_EXPERTS, EXPERT_FF, D), EXPERT_FF ** -0.5),
        'g_norm_final': 1.0 + _normal(ks[18], (D,), 0.05),
    }


def reference(x, c, w_ada, b_ada, g_norm_mix, w_in, conv_w, w_a_up, w_b_out, w_o,
              g_norm_ffn, w_rg, b_rg, w_re, b_re, w_e_gate, w_e_up, w_e_down, g_norm_final):
    c_act = jax.nn.silu(c)
    for l in range(DEPTH):
        mod = (c_act @ w_ada[l] + b_ada[l])[:, None, :]
        sh1, sc1, g1, sh2, sc2, g2 = jnp.split(mod, N_MOD, axis=-1)
        h = _rmsnorm(x, g_norm_mix[l]) * (1.0 + sc1) + sh1
        x = x + g1 * _hybrid_mixer(h, w_in[l], conv_w[l], w_a_up[l], w_b_out[l], w_o[l])
        h = _rmsnorm(x, g_norm_ffn[l]) * (1.0 + sc2) + sh2
        x = x + g2 * _hier_moe(h, w_rg[l], b_rg[l], w_re[l], b_re[l],
                               w_e_gate[l], w_e_up[l], w_e_down[l])
    return _rmsnorm(x, g_norm_final)
```

```cpp
#include <hip/hip_runtime.h>
#include <cstdio>
#include <cstdint>
namespace pg8 {
#define PG8_LAS __attribute__((address_space(3)))
typedef unsigned short bf16_t;
typedef short bf16x8 __attribute__((ext_vector_type(8)));
typedef float f32x4 __attribute__((ext_vector_type(4)));
typedef unsigned u32x4 __attribute__((ext_vector_type(4)));
constexpr int BM = 256, BK = 64, HALF = 128, HTB = HALF * BK * 2  , STAGE_BYTES = 8 * HTB, NXCD = 8, WGM = 8;

__host__ __device__ __forceinline__ int lds_byte(int r, int c) { const int st = (r >> 4) * 2 + (c >> 5), rr = r & 15, cc = c & 31, ob = rr * 64 + cc * 2; return st * 1024 + (ob ^ (((ob >> 9) & 1) << 5)); }
__host__ __device__ __forceinline__ void stage_rc(int b, int& R, int& C) { const int st = b / 1024, sb = b % 1024, swz = sb ^ (((sb >> 9) & 1) << 5); R = (st >> 1) * 16 + swz / 64; C = (st & 1) * 32 + (swz % 64) / 2; }
__host__ __device__ __forceinline__ int perm32(int rho) { const int n = rho >> 4, i = rho & 15; return 8 * (i >> 2) + 4 * n + (i & 3); }

struct Unit { int pm, pn; };
struct Gemm { const bf16_t* A; const bf16_t* Bt; int M, N, K; };

struct StaticOrder {
    int nM, nN, nwg, G, c;
    __host__ __device__ void init(int M, int N, int G_, int c_) { nM = M / BM; nN = N / BM; nwg = nM * nN; G = G_; c = c_; }
    __host__ __device__ bool next(int i, Unit& u) const {
        const long L = (long)i * G + c; if (L >= nwg) return false;
        int wgid = (int)L; { const int q = nwg / NXCD, r = nwg % NXCD, xcd = wgid % NXCD, off = wgid / NXCD; wgid = (xcd < r ? xcd * (q + 1) : r * (q + 1) + (xcd - r) * q) + off; }
        const int nig = WGM * nN, gid = wgid / nig, fm = gid * WGM, gsz = (nM - fm) < WGM ? (nM - fm) : WGM;
        u.pm = fm + ((wgid % nig) % gsz); u.pn = (wgid % nig) / gsz; return true;
    }
    __device__ __forceinline__ void a_ready(const Unit&) const {}
    __device__ __forceinline__ void done(const Unit&) const {}
};

__device__ __forceinline__ unsigned cvt_pk_bf16(float lo, float hi) { unsigned r; asm volatile("v_cvt_pk_bf16_f32 %0, %1, %2" : "=v"(r) : "v"(lo), "v"(hi)); return r; }
typedef float f32x2 __attribute__((ext_vector_type(2)));
__device__ __forceinline__ f32x2 gelu_pk(f32x2 v) {
    const f32x2 av = __builtin_elementwise_abs(v), d = av * 0.2316418882f + 1.0f;
    f32x2 t; t.x = __builtin_amdgcn_rcpf(d.x); t.y = __builtin_amdgcn_rcpf(d.y);
    f32x2 q = t * 0.5307027145f + (-0.7265760135f); q = q * t + 0.7107068705f; q = q * t + (-0.142248368f); q = q * t + 0.127414796f; q = q * t;
    const f32x2 s = (v * v) * (-0.72134752044f);
    f32x2 e; e.x = __builtin_amdgcn_exp2f(s.x); e.y = __builtin_amdgcn_exp2f(s.y);
    const f32x2 m = v * (q * e), r = v - m;
    f32x2 o; o.x = v.x < 0.f ? m.x : r.x; o.y = v.y < 0.f ? m.y : r.y; return o;
}

template <int ACT  > struct EpiBf16 {
    static constexpr bool PERM = true, AFTER_DRAIN = false; static_assert(ACT == 0 || ACT == 1, "EpiBf16: ACT is 0 (none) or 1 (gelu_pk)");
    bf16_t* O; int ldc; const float* bias; int split_cols; size_t split_stride; float scale0;
    __device__ __forceinline__ void operator()(const f32x4 (&acc)[2][2][4][2], const Unit& u, int wr, int wc, int fr, int fq) const {
        const int row0 = u.pm * BM + wr * 64 + fr; int colt = u.pn * BM; bf16_t* base = O;
        float sc = 1.f; if (split_cols) { const int t = colt / split_cols; base += (size_t)t * split_stride; colt -= t * split_cols; if (t == 0) sc = scale0; }
        const int col0 = colt + wc * 32 + 8 * fq, bcol0 = u.pn * BM + wc * 32 + 8 * fq;
        f32x4 bv[2][2];
#pragma unroll
        for (int bj = 0; bj < 2; ++bj)
#pragma unroll
            for (int n = 0; n < 2; ++n) bv[bj][n] = bias ? *(const f32x4*)(bias + bcol0 + bj * HALF + 4 * n) : (f32x4){0.f, 0.f, 0.f, 0.f};
#pragma unroll
        for (int ai = 0; ai < 2; ++ai)
#pragma unroll
            for (int m = 0; m < 4; ++m) { bf16_t* rowp = base + (size_t)(row0 + ai * HALF + m * 16) * ldc + col0;
#pragma unroll
                for (int bj = 0; bj < 2; ++bj) { f32x4 v0 = acc[ai][bj][m][0] + bv[bj][0], v1 = acc[ai][bj][m][1] + bv[bj][1];
                    if (ACT == 1) { f32x2 a = gelu_pk((f32x2){v0[0], v0[1]}), b = gelu_pk((f32x2){v0[2], v0[3]}), c = gelu_pk((f32x2){v1[0], v1[1]}), d = gelu_pk((f32x2){v1[2], v1[3]});
                        v0 = (f32x4){a.x, a.y, b.x, b.y}; v1 = (f32x4){c.x, c.y, d.x, d.y}; }
                    v0 = v0 * sc; v1 = v1 * sc; u32x4 w; w.x = cvt_pk_bf16(v0[0], v0[1]); w.y = cvt_pk_bf16(v0[2], v0[3]); w.z = cvt_pk_bf16(v1[0], v1[1]); w.w = cvt_pk_bf16(v1[2], v1[3]);
                    *(u32x4*)(rowp + bj * HALF) = w; } }
    }
};
__device__ __forceinline__ float bf_lo(unsigned w) { return __builtin_bit_cast(float, w << 16); }
__device__ __forceinline__ float bf_hi(unsigned w) { return __builtin_bit_cast(float, w & 0xffff0000u); }
__device__ __forceinline__ float sigmoid_f(float x) { return __builtin_amdgcn_rcpf(1.0f + __builtin_amdgcn_exp2f(-1.4426950408889634f * x)); }
struct EpiGate {
    static constexpr bool PERM = true, AFTER_DRAIN = false;
    bf16_t* O; int ldc; const bf16_t* Gt; int ldg; int goff; int add;
    __device__ __forceinline__ void operator()(const f32x4 (&acc)[2][2][4][2], const Unit& u, int wr, int wc, int fr, int fq) const {
        const int row0 = u.pm * BM + wr * 64 + fr, col0 = u.pn * BM + wc * 32 + 8 * fq;
#pragma unroll
        for (int ai = 0; ai < 2; ++ai)
#pragma unroll
            for (int m = 0; m < 4; ++m) { const size_t row = (size_t)(row0 + ai * HALF + m * 16);
#pragma unroll
                for (int bj = 0; bj < 2; ++bj) { const int col = col0 + bj * HALF;
                    const u32x4 g = *(const u32x4*)(Gt + row * ldg + goff + col);
                    const f32x4 v0 = acc[ai][bj][m][0], v1 = acc[ai][bj][m][1];
                    float r0 = sigmoid_f(bf_lo(g.x)) * v0[0], r1 = sigmoid_f(bf_hi(g.x)) * v0[1], r2 = sigmoid_f(bf_lo(g.y)) * v0[2], r3 = sigmoid_f(bf_hi(g.y)) * v0[3];
                    float r4 = sigmoid_f(bf_lo(g.z)) * v1[0], r5 = sigmoid_f(bf_hi(g.z)) * v1[1], r6 = sigmoid_f(bf_lo(g.w)) * v1[2], r7 = sigmoid_f(bf_hi(g.w)) * v1[3];
                    bf16_t* op = O + row * ldc + col;
                    if (add) { const u32x4 o = *(const u32x4*)op; r0 += bf_lo(o.x); r1 += bf_hi(o.x); r2 += bf_lo(o.y); r3 += bf_hi(o.y); r4 += bf_lo(o.z); r5 += bf_hi(o.z); r6 += bf_lo(o.w); r7 += bf_hi(o.w); }
                    u32x4 w; w.x = cvt_pk_bf16(r0, r1); w.y = cvt_pk_bf16(r2, r3); w.z = cvt_pk_bf16(r4, r5); w.w = cvt_pk_bf16(r6, r7);
                    *(u32x4*)op = w; } }
    }
};
struct EpiRes {
    static constexpr bool PERM = false, AFTER_DRAIN = false;
    const float* X; float* O; const float* gate0; int gate_bstride; int ldc; int rows_per_batch;
    __device__ __forceinline__ void operator()(const f32x4 (&acc)[2][2][4][2], const Unit& u, int wr, int wc, int fr, int fq) const {
        const int row0 = u.pm * BM + wr * 64 + fr, col0 = u.pn * BM + wc * 32 + 4 * fq;
        const float* gp = gate0 + (size_t)((u.pm * BM) / rows_per_batch) * gate_bstride;
#pragma unroll
        for (int bj = 0; bj < 2; ++bj)
#pragma unroll
            for (int n = 0; n < 2; ++n) { const int col = col0 + bj * HALF + n * 16; const f32x4 g = *(const f32x4*)(gp + col);
#pragma unroll
                for (int ai = 0; ai < 2; ++ai)
#pragma unroll
                    for (int m = 0; m < 4; ++m) { const size_t off = (size_t)(row0 + ai * HALF + m * 16) * ldc + col;
                        const f32x4 x = *(const f32x4*)(X + off); *(f32x4*)(O + off) = x + g * acc[ai][bj][m][n]; } }
    }
};
struct EpiLogit {
    static constexpr bool PERM = false, AFTER_DRAIN = false;
    float* O;
    __device__ __forceinline__ void operator()(const f32x4 (&acc)[2][2][4][2], const Unit& u, int wr, int wc, int fr, int fq) const {
        if (wc < 2) {
            const int row0 = u.pm * BM + wr * 64 + fr, col0 = wc * 32 + 4 * fq;
#pragma unroll
            for (int ai = 0; ai < 2; ++ai)
#pragma unroll
                for (int m = 0; m < 4; ++m)
#pragma unroll
                    for (int n = 0; n < 2; ++n) *(f32x4*)(O + (size_t)(row0 + ai * HALF + m * 16) * 64 + col0 + n * 16) = acc[ai][0][m][n];
        }
    }
};
struct EpiAct {
    static constexpr bool PERM = true, AFTER_DRAIN = false;
    bf16_t* ACT; const float* roww;
    __device__ __forceinline__ void operator()(const f32x4 (&acc)[2][2][4][2], const Unit& u, int wr, int wc, int fr, int fq) const {
        const int row0 = u.pm * BM + wr * 64 + fr, col0 = (u.pn & 3) * 128 + wc * 32 + 8 * fq;
#pragma unroll
        for (int ai = 0; ai < 2; ++ai)
#pragma unroll
            for (int m = 0; m < 4; ++m) { const size_t R = (size_t)(row0 + ai * HALF + m * 16); const float w = roww[R];
                const f32x4 g0 = acc[ai][0][m][0], g1 = acc[ai][0][m][1], u0 = acc[ai][1][m][0], u1 = acc[ai][1][m][1];
                float r[8];
#pragma unroll
                for (int i = 0; i < 4; ++i) { r[i] = g0[i] * sigmoid_f(g0[i]) * u0[i] * w; r[4 + i] = g1[i] * sigmoid_f(g1[i]) * u1[i] * w; }
                u32x4 o; o.x = cvt_pk_bf16(r[0], r[1]); o.y = cvt_pk_bf16(r[2], r[3]); o.z = cvt_pk_bf16(r[4], r[5]); o.w = cvt_pk_bf16(r[6], r[7]);
                *(u32x4*)(ACT + R * 512 + col0) = o; }
    }
};
struct EpiDown {
    static constexpr bool PERM = true, AFTER_DRAIN = false;
    bf16_t* Y; const int* rowtok; int ntok;
    __device__ __forceinline__ void operator()(const f32x4 (&acc)[2][2][4][2], const Unit& u, int wr, int wc, int fr, int fq) const {
        const int row0 = u.pm * BM + wr * 64 + fr, col0 = (u.pn & 7) * BM + wc * 32 + 8 * fq;
#pragma unroll
        for (int ai = 0; ai < 2; ++ai)
#pragma unroll
            for (int m = 0; m < 4; ++m) { const int tk = rowtok[row0 + ai * HALF + m * 16];
                if (tk >= 0) { bf16_t* yp = Y + ((size_t)(tk & 1) * ntok + (size_t)(tk >> 1)) * 2048 + col0;
#pragma unroll
                    for (int bj = 0; bj < 2; ++bj) { const f32x4 v0 = acc[ai][bj][m][0], v1 = acc[ai][bj][m][1];
                        u32x4 o; o.x = cvt_pk_bf16(v0[0], v0[1]); o.y = cvt_pk_bf16(v0[2], v0[3]); o.z = cvt_pk_bf16(v1[0], v1[1]); o.w = cvt_pk_bf16(v1[2], v1[3]);
                        *(u32x4*)(yp + bj * HALF) = o; } } }
    }
};
struct MoeOrder {
    const PG8_LAS int* tile_e; int ntiles, ncol, G, c;
    __device__ __forceinline__ bool next(int i, Unit& u) const {
        const long L = (long)i * G + c; if (L >= (long)ntiles * ncol) return false;
        const int rt = (int)(L / ncol), pl = (int)(L % ncol); u.pm = rt; u.pn = __builtin_amdgcn_readfirstlane(tile_e[rt]) * ncol + pl; return true;
    }
    __device__ __forceinline__ void a_ready(const Unit&) const {}
    __device__ __forceinline__ void done(const Unit&) const {}
};

template <class Epi, class Sched, bool ALIGN_EPI = false, bool SP2 = false>
__device__ __forceinline__ void gemm_phase(PG8_LAS unsigned char* lds, const Gemm g, const Sched& S, const Epi& E) {
    const int tid = threadIdx.x, wid = __builtin_amdgcn_readfirstlane(tid >> 6), lane = tid & 63, wr = wid >> 2, wc = wid & 3, fr = lane & 15, fq = lane >> 4;
    const int K = g.K, nt = K / BK;
    unsigned voffA[2], voffB[2];
#pragma unroll
    for (int i = 0; i < 2; ++i) { int R, C; stage_rc(tid * 16 + i * 8192, R, C); const int Rb = Epi::PERM ? ((R & ~31) + perm32(R & 31)) : R;
        voffA[i] = (unsigned)(R * K + C) * 2u; voffB[i] = (unsigned)(Rb * K + C) * 2u; }
    const size_t kstep = (size_t)(BK * 2);
    const size_t hstep = (size_t)HALF * K * 2;
    const size_t tstep = 2 * hstep;
    const unsigned ldsw = (unsigned)wid * 1024u;
    const int aoff = lds_byte(wr * 64 + fr, fq * 8), boff = lds_byte(wc * 32 + fr, fq * 8);
#define PG8_SA(b, h) (((b) * 2 + (h)) * HTB)
#define PG8_SB(b, h) ((4 + (b) * 2 + (h)) * HTB)
#define PG8_STAGE(bufoff, gbase, voff) do { _Pragma("unroll") for (int _i = 0; _i < 2; ++_i) \
        __builtin_amdgcn_global_load_lds((const unsigned*)((const char*)(gbase) + (voff)[_i]), (PG8_LAS unsigned*)(lds + (bufoff) + ldsw + _i * 8192), 16, 0, 0); } while (0)
#define PG8_LDA(dst, b, h) do { _Pragma("unroll") for (int m = 0; m < 4; ++m) _Pragma("unroll") for (int k = 0; k < 2; ++k) dst[m][k] = *(const PG8_LAS bf16x8*)(lds + PG8_SA(b, h) + aoff + m * 2048 + k * 1024); } while (0)
#define PG8_LDB(dst, b, h) do { _Pragma("unroll") for (int n = 0; n < 2; ++n) _Pragma("unroll") for (int k = 0; k < 2; ++k) dst[n][k] = *(const PG8_LAS bf16x8*)(lds + PG8_SB(b, h) + boff + n * 2048 + k * 1024); } while (0)
#define PG8_MMA(ai, bj, At, Bt) do { __builtin_amdgcn_s_setprio(1); _Pragma("unroll") for (int m = 0; m < 4; ++m) _Pragma("unroll") for (int n = 0; n < 2; ++n) _Pragma("unroll") for (int k = 0; k < 2; ++k) \
        acc[ai][bj][m][n] = __builtin_amdgcn_mfma_f32_16x16x32_bf16(Bt[n][k], At[m][k], acc[ai][bj][m][n], 0, 0, 0); __builtin_amdgcn_s_setprio(0); } while (0)
#define PG8_WAIT_V(n) asm volatile("s_waitcnt vmcnt(" #n ")" ::: "memory")
#define PG8_WAIT_L(n) asm volatile("s_waitcnt lgkmcnt(" #n ")" ::: "memory")
#define PG8_BAR __builtin_amdgcn_s_barrier()
#define PG8_SCHED __builtin_amdgcn_sched_barrier(0)
    Unit cur, nxt; int ui = 0;
    if (!S.next(0, cur)) return;
    f32x4 acc[2][2][4][2];
#pragma unroll
    for (int a = 0; a < 2; ++a)
#pragma unroll
        for (int b = 0; b < 2; ++b)
#pragma unroll
            for (int m = 0; m < 4; ++m)
#pragma unroll
                for (int n = 0; n < 2; ++n) acc[a][b][m][n] = (f32x4){0.f, 0.f, 0.f, 0.f};
    bf16x8 At[4][2], B0[2][2], B1[2][2];
    const char* cA = (const char*)g.A + (size_t)cur.pm * tstep; const char* cB = (const char*)g.Bt + (size_t)cur.pn * tstep;
    S.a_ready(cur);
    if constexpr (SP2) {
        PG8_STAGE(PG8_SB(0, 0), cB, voffB); PG8_STAGE(PG8_SB(0, 1), cB + hstep, voffB); PG8_STAGE(PG8_SA(0, 0), cA, voffA); PG8_STAGE(PG8_SA(0, 1), cA + hstep, voffA);
        if (wr == 1) PG8_BAR;
        PG8_WAIT_V(2); PG8_BAR;
        PG8_STAGE(PG8_SB(1, 0), cB + kstep, voffB); PG8_STAGE(PG8_SA(1, 0), cA + kstep, voffA); PG8_STAGE(PG8_SB(1, 1), cB + hstep + kstep, voffB);
        PG8_WAIT_V(6); PG8_BAR;
    } else {
        PG8_STAGE(PG8_SB(0, 0), cB, voffB); PG8_STAGE(PG8_SA(0, 0), cA, voffA); PG8_STAGE(PG8_SB(0, 1), cB + hstep, voffB); PG8_STAGE(PG8_SA(0, 1), cA + hstep, voffA);
        if (wr == 1) PG8_BAR;
        PG8_WAIT_V(4); PG8_BAR;
        PG8_STAGE(PG8_SB(1, 0), cB + kstep, voffB); PG8_STAGE(PG8_SA(1, 0), cA + kstep, voffA); PG8_STAGE(PG8_SB(1, 1), cB + hstep + kstep, voffB);
        PG8_WAIT_V(6); PG8_BAR;
    }
    for (;;) {
        const bool has_next = S.next(ui + 1, nxt);
        const char* nA = has_next ? (const char*)g.A + (size_t)nxt.pm * tstep : cA; const char* nB = has_next ? (const char*)g.Bt + (size_t)nxt.pn * tstep : cB;
        for (int t = 0; t < nt; t += 2) {
            const bool last = (t == nt - 2);
            const char* a1 = cA + (size_t)(t + 1) * kstep;
            const char* a2 = last ? nA : cA + (size_t)(t + 2) * kstep; const char* b2 = last ? nB : cB + (size_t)(t + 2) * kstep;
            const char* a3 = a2 + kstep; const char* b3 = b2 + kstep;
            if (last && has_next) S.a_ready(nxt);
            if constexpr (SP2) {
            PG8_LDB(B0, 0, 0); PG8_LDB(B1, 0, 1); PG8_SCHED; PG8_LDA(At, 0, 0); PG8_STAGE(PG8_SA(1, 1), a1 + hstep, voffA);
            PG8_WAIT_V(8); PG8_WAIT_L(0); PG8_BAR; PG8_MMA(0, 0, At, B0); PG8_MMA(0, 1, At, B1); PG8_BAR; PG8_SCHED;
            PG8_LDA(At, 0, 1); PG8_STAGE(PG8_SB(0, 0), b2, voffB); PG8_STAGE(PG8_SB(0, 1), b2 + hstep, voffB); PG8_STAGE(PG8_SA(0, 0), a2, voffA);
            PG8_WAIT_V(8); PG8_WAIT_L(0); PG8_BAR; PG8_MMA(1, 0, At, B0); PG8_MMA(1, 1, At, B1); PG8_BAR; PG8_SCHED;
            PG8_LDB(B0, 1, 0); PG8_LDB(B1, 1, 1); PG8_SCHED; PG8_LDA(At, 1, 0); PG8_STAGE(PG8_SA(0, 1), a2 + hstep, voffA);
            PG8_WAIT_V(8); PG8_WAIT_L(0); PG8_BAR; PG8_MMA(0, 0, At, B0); PG8_MMA(0, 1, At, B1); PG8_BAR; PG8_SCHED;
            PG8_LDA(At, 1, 1); PG8_STAGE(PG8_SB(1, 0), b3, voffB); PG8_STAGE(PG8_SB(1, 1), b3 + hstep, voffB); PG8_STAGE(PG8_SA(1, 0), a3, voffA);
            PG8_WAIT_V(8); PG8_WAIT_L(0); PG8_BAR; PG8_MMA(1, 0, At, B0); PG8_MMA(1, 1, At, B1); PG8_BAR; PG8_SCHED;
            } else {
            PG8_LDB(B0, 0, 0); PG8_SCHED; PG8_LDA(At, 0, 0); PG8_STAGE(PG8_SA(1, 1), a1 + hstep, voffA);
            PG8_WAIT_L(8); PG8_BAR; PG8_WAIT_L(0); PG8_MMA(0, 0, At, B0); PG8_BAR; PG8_SCHED;
            PG8_LDB(B1, 0, 1); PG8_STAGE(PG8_SB(0, 0), b2, voffB);
            PG8_BAR; PG8_WAIT_L(0); PG8_MMA(0, 1, At, B1); PG8_BAR;
            PG8_LDA(At, 0, 1); PG8_STAGE(PG8_SA(0, 0), a2, voffA);
            PG8_BAR; PG8_WAIT_L(0); PG8_MMA(1, 0, At, B0); PG8_BAR; PG8_SCHED;
            PG8_STAGE(PG8_SB(0, 1), b2 + hstep, voffB);
            PG8_WAIT_V(6); PG8_BAR; PG8_MMA(1, 1, At, B1); PG8_BAR;
            PG8_LDB(B0, 1, 0); PG8_SCHED; PG8_LDA(At, 1, 0); PG8_STAGE(PG8_SA(0, 1), a2 + hstep, voffA);
            PG8_WAIT_L(8); PG8_BAR; PG8_WAIT_L(0); PG8_MMA(0, 0, At, B0); PG8_BAR; PG8_SCHED;
            PG8_LDB(B1, 1, 1); PG8_STAGE(PG8_SB(1, 0), b3, voffB);
            PG8_BAR; PG8_WAIT_L(0); PG8_MMA(0, 1, At, B1); PG8_BAR;
            PG8_LDA(At, 1, 1); PG8_STAGE(PG8_SA(1, 0), a3, voffA);
            PG8_BAR; PG8_WAIT_L(0); PG8_MMA(1, 0, At, B0); PG8_BAR; PG8_SCHED;
            PG8_STAGE(PG8_SB(1, 1), b3 + hstep, voffB);
            PG8_WAIT_V(6); PG8_BAR; PG8_MMA(1, 1, At, B1); PG8_BAR;
            }
        }
        if constexpr (ALIGN_EPI) { if (wr == 0) PG8_BAR; }
        if constexpr (!Epi::AFTER_DRAIN) { E(acc, cur, wr, wc, fr, fq); S.done(cur); }
        if (!has_next) break;
#pragma unroll
        for (int a = 0; a < 2; ++a)
#pragma unroll
            for (int b = 0; b < 2; ++b)
#pragma unroll
                for (int m = 0; m < 4; ++m)
#pragma unroll
                    for (int n = 0; n < 2; ++n) acc[a][b][m][n] = (f32x4){0.f, 0.f, 0.f, 0.f};
        cur = nxt; cA = nA; cB = nB; ++ui;
        if constexpr (ALIGN_EPI) { if (wr == 1) PG8_BAR; }
    }
    PG8_WAIT_V(0);
    if constexpr (!ALIGN_EPI) { if (wr == 0) PG8_BAR; }
    PG8_BAR;
    if constexpr (Epi::AFTER_DRAIN) { E.fused(acc, cur, wr, wc, fr, fq, lds, wid, lane); S.done(cur); }
#undef PG8_SA
#undef PG8_SB
#undef PG8_STAGE
#undef PG8_LDA
#undef PG8_LDB
#undef PG8_MMA
#undef PG8_WAIT_V
#undef PG8_WAIT_L
#undef PG8_BAR
#undef PG8_SCHED
}
}

#ifndef PG8_SP2
#define PG8_SP2 true
#endif
#ifndef PG8_ALIGN
#define PG8_ALIGN true
#endif
#include <hip/hip_bf16.h>
#include <cmath>
namespace attn_body {
using bf16=__hip_bfloat16;
using bf16x8=__attribute__((ext_vector_type(8)))short;
using s16x4=__attribute__((ext_vector_type(4)))short;
using f32x16=__attribute__((ext_vector_type(16)))float;
using u32x4=__attribute__((ext_vector_type(4)))unsigned;
constexpr int BATCH=2,NHEAD=16,SEQ=4096,D=64,DM=NHEAD*D,QP=9984,KP=9984,VP=9984,OP=1024,GQA=4;
constexpr int NW=8,QBLK=32,QB=QBLK*NW,KVBLK=64,NQB=SEQ/QB;
constexpr int ATTN_UNIT_ROWS=QB;
__device__ __forceinline__ int crow(int r,int hi){return (r&3)+8*(r>>2)+4*hi;}
#define SBAR() __builtin_amdgcn_sched_barrier(0)
__device__ __forceinline__ void cmask(f32x16&p0,f32x16&p1,int jb,int qrel,int hi){
  const float NEG=-INFINITY; int kb=64*jb+4*hi;
  #pragma unroll
  for(int r=0;r<16;++r){int kv=kb+(r&3)+8*(r>>2); if(kv>qrel)p0[r]=NEG; if(kv+32>qrel)p1[r]=NEG;}
}

constexpr int NSLOT=3, SLOTB=8192;
constexpr int LDS_K=0, LDS_V=NSLOT*SLOTB, LDS_WS=2*NSLOT*SLOTB, LDS_OST=LDS_WS+NW*64*4, LDS_MK=LDS_OST+NW*4096, LDS_BYTES=LDS_MK+NW*4096;
constexpr float C2=0.125f*1.4426950408889634f;
__device__ __forceinline__ void glds16(const void*gsrc,unsigned lds_dst){unsigned keep;
  asm volatile("s_mov_b32 %0, m0\n\ts_mov_b32 m0, %2\n\ts_nop 0\n\tglobal_load_lds_dwordx4 %1, off\n\ts_mov_b32 m0, %0":"=&s"(keep):"v"(gsrc),"s"(lds_dst):"memory");}
__device__ __forceinline__ float max3f(float a,float b,float c){float r;asm("v_max3_f32 %0, %1, %2, %3":"=v"(r):"v"(a),"v"(b),"v"(c));return r;}
__device__ __forceinline__ float max2f(float a,float b){float r;asm("v_max_f32_e32 %0, %1, %2":"=v"(r):"v"(a),"v"(b));return r;}
__device__ __forceinline__ float fadd_s(float a,float b){float r;asm("v_add_f32_e32 %0, %1, %2":"=v"(r):"v"(a),"v"(b));return r;}
__device__ __forceinline__ float fsub_s(float a,float b){float r;asm("v_sub_f32_e32 %0, %1, %2":"=v"(r):"v"(a),"v"(b));return r;}
typedef float f32x2_t __attribute__((ext_vector_type(2))); typedef __bf16 bf16x2_t __attribute__((ext_vector_type(2)));
__device__ __forceinline__ unsigned cvtpk_s(float lo,float hi){f32x2_t v={lo,hi};bf16x2_t b=__builtin_convertvector(v,bf16x2_t);return __builtin_bit_cast(unsigned,b);}
#define WAIT_BAR(N) asm volatile("s_waitcnt vmcnt(" #N ") lgkmcnt(0)\n\ts_barrier":::"memory")

__device__ __forceinline__ void qkt(f32x16&p0,f32x16&p1,const char*Kslot,const bf16x8*qr,const f32x16&negm,int r32,int hi){
  const char*kb=Kslot+hi*1024+r32*16;
  #pragma unroll
  for(int d0=0;d0<4;++d0){
    const bf16x8 b0=*reinterpret_cast<const bf16x8*>(kb+d0*2048);
    const bf16x8 b1=*reinterpret_cast<const bf16x8*>(kb+d0*2048+512);
    if(d0==0){p0=__builtin_amdgcn_mfma_f32_32x32x16_bf16(b0,qr[0],negm,0,0,0);p1=__builtin_amdgcn_mfma_f32_32x32x16_bf16(b1,qr[0],negm,0,0,0);}
    else{p0=__builtin_amdgcn_mfma_f32_32x32x16_bf16(b0,qr[d0],p0,0,0,0);p1=__builtin_amdgcn_mfma_f32_32x32x16_bf16(b1,qr[d0],p1,0,0,0);}}
}
typedef __attribute__((address_space(3))) const char* lds_cptr;
typedef short v4i16_t __attribute__((ext_vector_type(4)));
__device__ __forceinline__ void kload8(bf16x8*kf,lds_cptr kp){
  kf[0]=*(const __attribute__((address_space(3))) bf16x8*)(kp);      kf[1]=*(const __attribute__((address_space(3))) bf16x8*)(kp+512);
  kf[2]=*(const __attribute__((address_space(3))) bf16x8*)(kp+2048); kf[3]=*(const __attribute__((address_space(3))) bf16x8*)(kp+2560);
  kf[4]=*(const __attribute__((address_space(3))) bf16x8*)(kp+4096); kf[5]=*(const __attribute__((address_space(3))) bf16x8*)(kp+4608);
  kf[6]=*(const __attribute__((address_space(3))) bf16x8*)(kp+6144); kf[7]=*(const __attribute__((address_space(3))) bf16x8*)(kp+6656);
}
__device__ __forceinline__ void kload2(bf16x8*kf,lds_cptr kp,int j){ kf[2*j]=*(const __attribute__((address_space(3))) bf16x8*)(kp+j*2048); kf[2*j+1]=*(const __attribute__((address_space(3))) bf16x8*)(kp+j*2048+512); }
__device__ __forceinline__ s16x4 vtr(lds_cptr p){ return __builtin_bit_cast(s16x4,__builtin_amdgcn_ds_read_tr16_b64_v4i16((__attribute__((address_space(3))) v4i16_t*)p)); }
__device__ __forceinline__ float rowmax(const f32x16&p0,const f32x16&p1){
  float a=max3f(p0[0],p0[1],p1[0]),b=max3f(p0[2],p0[3],p1[1]);a=max3f(a,p1[2],p1[3]);
  #pragma unroll
  for(int r=4;r<16;r+=4){a=max3f(a,p0[r],p0[r+1]);b=max3f(b,p0[r+2],p0[r+3]);a=max3f(a,p1[r],p1[r+1]);b=max3f(b,p1[r+2],p1[r+3]);}
  const float m=max2f(a,b);
  auto rr=__builtin_amdgcn_permlane32_swap(__float_as_uint(m),__float_as_uint(m),false,false);
  return max2f(__uint_as_float(rr[0]),__uint_as_float(rr[1]));
}
__device__ __forceinline__ void pv(f32x16*o,int vb,bf16x8 pa0,bf16x8 pa1,bf16x8 pa2,bf16x8 pa3){
  #pragma unroll
  for(int d0=0;d0<2;++d0){s16x4 lo[4],hi[4];
    #pragma unroll
    for(int ks=0;ks<4;++ks){
      asm volatile("ds_read_b64_tr_b16 %0,%1 offset:%c2":"=&v"(lo[ks]):"v"(vb),"i"(d0*4096+ks*1024):"memory");
      asm volatile("ds_read_b64_tr_b16 %0,%1 offset:%c2":"=&v"(hi[ks]):"v"(vb),"i"(d0*4096+ks*1024+512):"memory");}
    asm volatile("s_waitcnt lgkmcnt(0)":::"memory");SBAR();
    #define PK(k) (bf16x8){lo[k][0],lo[k][1],lo[k][2],lo[k][3],hi[k][0],hi[k][1],hi[k][2],hi[k][3]}
    o[d0]=__builtin_amdgcn_mfma_f32_32x32x16_bf16(pa0,PK(0),o[d0],0,0,0);
    o[d0]=__builtin_amdgcn_mfma_f32_32x32x16_bf16(pa1,PK(1),o[d0],0,0,0);
    o[d0]=__builtin_amdgcn_mfma_f32_32x32x16_bf16(pa2,PK(2),o[d0],0,0,0);
    o[d0]=__builtin_amdgcn_mfma_f32_32x32x16_bf16(pa3,PK(3),o[d0],0,0,0);
    #undef PK
  }
}

#ifndef ATTN_STORE16
#define ATTN_STORE16(p,v) (*(u32x4*)(p)=(v))
#endif
template<int THRL> __device__ __forceinline__ void attn_unit(int b,int h,int qb,const bf16*Q,const bf16*__restrict__ K,const bf16*__restrict__ V,bf16*O,const unsigned long long*__restrict__ MK,char*shm){
  const int tid=threadIdx.x,lane=tid&63,r32=lane&31,hi=lane>>5; const int wid=__builtin_amdgcn_readfirstlane(tid>>6);
  const long rowbase=(long)b*SEQ; const int q0=qb*QB;
  const bf16*Qw=Q+(rowbase+q0+wid*QBLK)*QP+h*D;
  const bf16*Kh=K+rowbase*KP+(h/GQA)*D,*Vh=V+rowbase*VP+(h/GQA)*D;
  const unsigned lds0=(unsigned)(uintptr_t)shm;
  float*wsf=(float*)(shm+LDS_WS)+wid*64;
  const bf16*ksrc=Kh+(long)lane*KP+wid*8;
  const bf16*vsrc=Vh+(long)(16*(wid&3)+(lane>>2))*VP+(wid>>2)*32+(lane&3)*8;
  const unsigned kdst=lds0+LDS_K+wid*1024, vdst=lds0+LDS_V+wid*1024;
  #define DMA_K(t,slot) glds16(ksrc+(long)(t)*KVBLK*KP,(unsigned)__builtin_amdgcn_readfirstlane(kdst+(slot)))
  #define DMA_V(t,slot) glds16(vsrc+(long)(t)*KVBLK*VP,(unsigned)__builtin_amdgcn_readfirstlane(vdst+(slot)))
  const int vb0=(int)(lds0+LDS_V)+((lane>>4)&1)*32+(lane&3)*8+(4*hi+((lane&15)>>2))*64;
  const char*Kbase=shm+LDS_K; bf16x8 kf[8];
  const lds_cptr shm3=(lds_cptr)shm; const lds_cptr kp0=shm3+LDS_K+hi*1024+r32*16; const lds_cptr vp0=shm3+LDS_V+((lane>>4)&1)*32+(lane&3)*8+(4*hi+((lane&15)>>2))*64;
  const int NT=(q0+QB)/KVBLK;
  DMA_K(0,0);DMA_V(0,0);DMA_K(1,SLOTB);
  bf16x8 qr[4];
  #pragma unroll
  for(int d0=0;d0<4;++d0)qr[d0]=*reinterpret_cast<const bf16x8*>(&Qw[(long)r32*QP+d0*16+hi*8]);
  float mhat=0.f,l_reg=0.f;f32x16 o[2];o[0]=f32x16{};o[1]=f32x16{};const f32x16 negm=f32x16{};
  const int qrel=wid*QBLK+r32; (void)qrel;
  const unsigned long long*MKw=MK+((size_t)(rowbase+q0+wid*QBLK))*64;
  typedef __attribute__((address_space(3))) unsigned long long lds_u64;
  lds_u64*mks=(lds_u64*)((lds_cptr)shm+LDS_MK+wid*4096);
  #define MK_REFILL(t0) do{ _Pragma("unroll") for(int i_=0;i_<4;++i_){ const int idx_=i_*64+lane, q_=idx_>>3, pr_=idx_&7; \
      const u32x4 w_=*(const u32x4*)(MKw+(size_t)q_*64+(t0)+2*pr_); \
      mks[(2*pr_)*32+q_]=((unsigned long long)w_.y<<32)|w_.x; mks[(2*pr_+1)*32+q_]=((unsigned long long)w_.w<<32)|w_.z; } }while(0)
  #define MK_LOAD(t,ML,MH) do{ if(((t)&15)==0){ MK_REFILL(t); } const unsigned long long mw_=mks[((t)&15)*32+r32]; ML=(unsigned)mw_>>(4*hi); MH=(unsigned)(mw_>>32)>>(4*hi); }while(0)
  #define MKB(r) (((r)&3)+8*((r)>>2))
  #define MAND(x,M,r) __builtin_bit_cast(float,__builtin_bit_cast(unsigned,(x))&(unsigned)__builtin_amdgcn_sbfe((int)(M),MKB(r),1))
  unsigned mlo,mhi;
  #define CMASK(P0,P1,t) do{}while(0)
  bool resc=false;
  #define START(P0,P1) do{ const float rm=rowmax(P0,P1); resc=false; \
    { const float dl=rm; mhat=fadd_s(mhat,dl); \
      _Pragma("unroll") for(int r=0;r<16;++r){P0[r]=fsub_s(P0[r],dl);P1[r]=fsub_s(P1[r],dl);} \
      } \
    _Pragma("unroll") for(int r=0;r<16;++r)P0[r]=MAND(__builtin_amdgcn_exp2f(P0[r]),mlo,r); }while(0)
  #define RESC() do{ if(resc){ asm volatile("s_waitcnt lgkmcnt(0)":::"memory"); \
      _Pragma("unroll") for(int d_=0;d_<2;++d_) _Pragma("unroll") for(int r=0;r<16;++r)o[d_][r]*=wsf[crow(r,hi)]; } }while(0)
  f32x16 pA0,pA1,pB0,pB1;
  int sl_prev=0,sl_cur=0,sl_next=SLOTB;
  #define ROT() do{sl_prev=sl_cur;sl_cur=sl_next;sl_next=(sl_next==(NSLOT-1)*SLOTB)?0:sl_next+SLOTB;}while(0)
  DMA_K(2,2*SLOTB);
  WAIT_BAR(3);
  qkt(pA0,pA1,Kbase,qr,negm,r32,hi);asm volatile("s_nop 15\n\ts_nop 7":"+v"(pA0),"+v"(pA1));CMASK(pA0,pA1,0);
  MK_LOAD(0,mlo,mhi);
  START(pA0,pA1);
  _Pragma("unroll") for(int r=0;r<16;++r)pA1[r]=MAND(__builtin_amdgcn_exp2f(pA1[r]),mhi,r);
  WAIT_BAR(0);
  DMA_K(3,0);DMA_V(1,SLOTB);
  ROT();
  kload8(kf,kp0+sl_cur);
  WAIT_BAR(2);
  s16x4 vlo[8],vhi[8]; u32x4 pw0,pw1,pw2,pw3;
  #define PKW(P,B) cvtpk_s(P[B],P[B+1])
  #define PAF(k) __builtin_bit_cast(bf16x8,pw##k)
  #define VFR(i) (bf16x8){vlo[i][0],vlo[i][1],vlo[i][2],vlo[i][3],vhi[i][0],vhi[i][1],vhi[i][2],vhi[i][3]}
  #define PIN(x) asm volatile("":"+v"(x))
  #define MX3(a,b,c) __builtin_fmaxf(__builtin_fmaxf((a),(b)),(c))
  #define GAPA(MF,A0,A1,A2,A3,W0,W1,PW) do{ MF; sacc+=A0; sacc+=A1; sacc+=A2; sacc+=A3; PIN(sacc); W0; W1; PIN(PW); SBAR(); }while(0)
  #define EX(v) __builtin_amdgcn_exp2f(v)
  #define GAPB(MF,X,B,M) do{ MF; X[B]=MAND(EX(X[B]),M,B); X[B+1]=MAND(EX(X[B+1]),M,B+1); X[B+2]=MAND(EX(X[B+2]),M,B+2); X[B+3]=MAND(EX(X[B+3]),M,B+3); PIN(X); SBAR(); }while(0)
  #define VRD(i) do{ vlo[i]=vtr(vp_+(((i)>>2)*4096+((i)&3)*1024)); vhi[i]=vtr(vp_+(((i)>>2)*4096+((i)&3)*1024+512)); }while(0)
  #define KRD(G,j) do{ if(G){ kload2(kf,kp0+sl_next,j); SBAR(); } }while(0)
  #define STEP(C0,C1,P0,P1,t,GK,GV,GL) do{ SBAR(); MK_LOAD(t,mlo,mhi); SBAR(); \
    const lds_cptr vp_=vp0+sl_prev; \
    VRD(0); SBAR(); float sacc=(P0[0]+P0[1]); \
    GAPA(C0=__builtin_amdgcn_mfma_f32_32x32x16_bf16(kf[0],qr[0],negm,0,0,0), P0[2],P0[3],P0[4],P0[5],     pw0[0]=PKW(P0,0), pw0[1]=PKW(P0,2), pw0); \
    VRD(4); SBAR(); GAPA(C1=__builtin_amdgcn_mfma_f32_32x32x16_bf16(kf[1],qr[0],negm,0,0,0), P0[6],P0[7],P0[8],P0[9],     pw0[2]=PKW(P0,4), pw0[3]=PKW(P0,6), pw0); \
    VRD(1); SBAR(); GAPA(C0=__builtin_amdgcn_mfma_f32_32x32x16_bf16(kf[2],qr[1],C0,0,0,0),   P0[10],P0[11],P0[12],P0[13], pw1[0]=PKW(P0,8), pw1[1]=PKW(P0,10), pw1); \
    VRD(5); SBAR(); GAPA(C1=__builtin_amdgcn_mfma_f32_32x32x16_bf16(kf[3],qr[1],C1,0,0,0),   P0[14],P0[15],P1[0],P1[1],   pw1[2]=PKW(P0,12),pw1[3]=PKW(P0,14), pw1); \
    VRD(2); SBAR(); GAPA(C0=__builtin_amdgcn_mfma_f32_32x32x16_bf16(kf[4],qr[2],C0,0,0,0),   P1[2],P1[3],P1[4],P1[5],     pw2[0]=PKW(P1,0), pw2[1]=PKW(P1,2), pw2); \
    VRD(6); SBAR(); GAPA(C1=__builtin_amdgcn_mfma_f32_32x32x16_bf16(kf[5],qr[2],C1,0,0,0),   P1[6],P1[7],P1[8],P1[9],     pw2[2]=PKW(P1,4), pw2[3]=PKW(P1,6), pw2); \
    VRD(3); SBAR(); GAPA(C0=__builtin_amdgcn_mfma_f32_32x32x16_bf16(kf[6],qr[3],C0,0,0,0),   P1[10],P1[11],P1[12],P1[13], pw3[0]=PKW(P1,8), pw3[1]=PKW(P1,10), pw3); \
    VRD(7); SBAR(); GAPA(C1=__builtin_amdgcn_mfma_f32_32x32x16_bf16(kf[7],qr[3],C1,0,0,0),   P1[14],P1[15],0.f,0.f,       pw3[2]=PKW(P1,12),pw3[3]=PKW(P1,14), pw3); \
    l_reg+=sacc; \
    if(GK){DMA_K((t)+3,sl_cur);} if(GV){DMA_V((t)+1,sl_next);} \
    { const float nm_=-mhat; _Pragma("unroll") for(int r=0;r<16;++r){C0[r]+=nm_;C1[r]+=nm_;} } \
    { float a=MX3(C0[0],C0[1],C1[0]),b=MX3(C0[2],C0[3],C1[1]); a=MX3(a,C1[2],C1[3]); \
      _Pragma("unroll") for(int r=4;r<16;r+=4){a=MX3(a,C0[r],C0[r+1]);b=MX3(b,C0[r+2],C0[r+3]);a=MX3(a,C1[r],C1[r+1]);b=MX3(b,C1[r+2],C1[r+3]);} \
      float rm=__builtin_fmaxf(a,b); { auto rr=__builtin_amdgcn_permlane32_swap(__float_as_uint(rm),__float_as_uint(rm),false,false); rm=__builtin_fmaxf(__uint_as_float(rr[0]),__uint_as_float(rr[1])); } \
      resc=false; \
      if(__builtin_expect(__any(rm>(float)THRL),0)){ const float dl=__builtin_fmaxf(rm,0.f); mhat+=dl; \
        _Pragma("unroll") for(int r=0;r<16;++r){C0[r]-=dl;C1[r]-=dl;} \
        const float f=__builtin_amdgcn_exp2f(-dl); l_reg*=f; if(hi==0)wsf[r32]=f; resc=true; } } \
    SBAR(); \
    GAPB(o[0]=__builtin_amdgcn_mfma_f32_32x32x16_bf16(PAF(0),VFR(0),o[0],0,0,0), C0,0,mlo); \
    GAPB(o[1]=__builtin_amdgcn_mfma_f32_32x32x16_bf16(PAF(0),VFR(4),o[1],0,0,0), C0,4,mlo); \
    KRD(GL,0); GAPB(o[0]=__builtin_amdgcn_mfma_f32_32x32x16_bf16(PAF(1),VFR(1),o[0],0,0,0), C0,8,mlo); \
    KRD(GL,1); GAPB(o[1]=__builtin_amdgcn_mfma_f32_32x32x16_bf16(PAF(1),VFR(5),o[1],0,0,0), C0,12,mlo); \
    KRD(GL,2); GAPB(o[0]=__builtin_amdgcn_mfma_f32_32x32x16_bf16(PAF(2),VFR(2),o[0],0,0,0), C1,0,mhi); \
    KRD(GL,3); GAPB(o[1]=__builtin_amdgcn_mfma_f32_32x32x16_bf16(PAF(2),VFR(6),o[1],0,0,0), C1,4,mhi); \
    GAPB(o[0]=__builtin_amdgcn_mfma_f32_32x32x16_bf16(PAF(3),VFR(3),o[0],0,0,0), C1,8,mhi); \
    GAPB(o[1]=__builtin_amdgcn_mfma_f32_32x32x16_bf16(PAF(3),VFR(7),o[1],0,0,0), C1,12,mhi); \
    }while(0)
  int t=1;
  #undef CMASK
  #define CMASK(P0,P1,t) do{}while(0)
  for(;t+5<NT;t+=2){
    STEP(pB0,pB1,pA0,pA1,t,true,true,true);     WAIT_BAR(2); RESC(); ROT();
    STEP(pA0,pA1,pB0,pB1,t+1,true,true,true);   WAIT_BAR(2); RESC(); ROT();
  }
  #undef CMASK
  #define CMASK(P0,P1,t) do{}while(0)
  #define ENDW(tt) do{ if((tt)+3<NT){WAIT_BAR(2);} else if((tt)+2<NT){WAIT_BAR(1);} else {WAIT_BAR(0);} }while(0)
  for(;t+1<NT;t+=2){
    STEP(pB0,pB1,pA0,pA1,t,(t+3<NT),(t+1<NT),(t+1<NT));       ENDW(t);   RESC(); ROT();
    STEP(pA0,pA1,pB0,pB1,t+1,(t+4<NT),(t+2<NT),(t+2<NT));     ENDW(t+1); RESC(); ROT();
  }
  STEP(pB0,pB1,pA0,pA1,NT-1,false,false,false); RESC();
  { float sacc=pB0[0]+pB0[1]; _Pragma("unroll") for(int r=2;r<16;++r)sacc+=pB0[r]; _Pragma("unroll") for(int r=0;r<16;++r)sacc+=pB1[r]; l_reg+=sacc;
    pw0=(u32x4){PKW(pB0,0),PKW(pB0,2),PKW(pB0,4),PKW(pB0,6)};pw1=(u32x4){PKW(pB0,8),PKW(pB0,10),PKW(pB0,12),PKW(pB0,14)};pw2=(u32x4){PKW(pB1,0),PKW(pB1,2),PKW(pB1,4),PKW(pB1,6)};pw3=(u32x4){PKW(pB1,8),PKW(pB1,10),PKW(pB1,12),PKW(pB1,14)};
    SBAR(); pv(o,vb0+sl_cur,PAF(0),PAF(1),PAF(2),PAF(3)); }
  #undef PKW
  #undef PAF
  #undef VFR
  #undef PIN
  #undef MX3
  #undef GAPA
  #undef GAPB
  #undef EX
  #undef VRD
  #undef KRD
  #undef STEP
  #undef ENDW
  {auto rr=__builtin_amdgcn_permlane32_swap(__float_as_uint(l_reg),__float_as_uint(l_reg),false,false);l_reg=__uint_as_float(rr[0])+__uint_as_float(rr[1]);}
  if(hi==0)wsf[32+r32]=l_reg;asm volatile("s_waitcnt lgkmcnt(0)":::"memory");
  float rli[16];
  #pragma unroll
  for(int r=0;r<16;++r)rli[r]=__builtin_amdgcn_rcpf(wsf[32+crow(r,hi)]);
  bf16*Ow=O+(rowbase+q0+wid*QBLK)*OP+h*D;
  { bf16*stg=(bf16*)(shm+LDS_OST)+wid*2048;
    #pragma unroll
    for(int r=0;r<16;++r){const int orow=crow(r,hi);
      #pragma unroll
      for(int d0=0;d0<2;++d0)stg[orow*64+d0*32+r32]=__float2bfloat16(o[d0][r]*rli[r]);}
    asm volatile("s_waitcnt lgkmcnt(0)":::"memory");
    #pragma unroll
    for(int i=0;i<4;++i){const int row=i*8+(lane>>3),ch=lane&7; const u32x4 v=*(const u32x4*)(stg+row*64+ch*8); ATTN_STORE16(Ow+(long)row*OP+ch*8,v);} }
  asm volatile("s_waitcnt lgkmcnt(0)\n\ts_barrier":::"memory");
  #undef DMA_K
  #undef MK_REFILL
  #undef MK_LOAD
  #undef MKB
  #undef MAND
  #undef DMA_V
  #undef CMASK
  #undef START
  #undef RESC
  #undef ROT
}
constexpr int ATTN_LDS_BYTES=LDS_BYTES;
struct AttnTensors { const bf16* Q; const bf16* K; const bf16* V; bf16* O; const unsigned long long* MK; };
struct AttnUnit { int bh; int qb; };
struct StaticOrder {
  int vcu;
  __device__ __forceinline__ explicit StaticOrder(int grid,int block):vcu((grid%8==0)?(block%8)*(grid/8)+block/8:block),G(grid){}
  int G;
  __device__ __forceinline__ bool next(int i,AttnUnit&u)const{ const int L=i*G+vcu; if(L>=512)return false; const int s=L&7; u.bh=(L&255)>>3; u.qb=(L<256)?s:15-s; return true; }
  __device__ __forceinline__ void a_ready(const AttnUnit&)const{}
  __device__ __forceinline__ void done(const AttnUnit&)const{}
};
template<class Sched,int THRL=8> __device__ __forceinline__ void attn_phase(char*lds,const AttnTensors&T,const Sched&S){
  AttnUnit u;
  for(int i=0;S.next(i,u);++i){ S.a_ready(u); attn_unit<THRL>(u.bh/NHEAD,u.bh%NHEAD,u.qb,T.Q,T.K,T.V,T.O,T.MK,lds); S.done(u); }
}
#undef SBAR
#undef WAIT_BAR
}
constexpr int NWAVES = 8;
#ifndef MK_N_LAUNCHES
#define MK_N_LAUNCHES 1
#endif
constexpr int N_LAUNCHES = MK_N_LAUNCHES;

constexpr int D = 2048, BATCH = 2, SEQ = 4096, M = BATCH * SEQ;
constexpr int NHEAD = 16, HD = 64, NKV = 4, IDXH = 16, IDXD = 64, TOPK = 256;
constexpr int NE = 32, EPG = 8, NGRP = 4, FF = 512;
constexpr int NPROJ = 9808, NP = 9984;
constexpr int C_Q = 0, C_K = 1024, C_V = 1280, C_IQ = 1536, C_IK = 2560, C_IW = 2624, C_BG = 2640, C_CG = 3664, C_XC = 4688, C_GA = 5712, C_GB = 7760;
constexpr int NMOD = 6 * D;
constexpr float EPS = 1e-6f;
constexpr int ROWCAP = 24576;
constexpr int MAXTILES = ROWCAP / 256;

constexpr size_t MiB = 1u << 20;
constexpr size_t WS_CTL = 0, CTL_ZERO_BYTES = 65536;
constexpr size_t WS_MOD = 1 * MiB;
constexpr size_t WS_ROWTOK = 2 * MiB;
constexpr size_t WS_ROWW = 3 * MiB;
constexpr size_t WS_ROWTOK2 = 4 * MiB;
constexpr size_t WS_ROWW2 = 4 * MiB + 512 * 1024;
constexpr size_t WS_LOGIT = 5 * MiB;
constexpr size_t WS_MASK = 8 * MiB;
constexpr size_t WS_WMIX = 12 * MiB;
constexpr size_t WS_WR = 28 * MiB;
constexpr size_t WS_WIN = 32 * MiB;
constexpr size_t WS_OA = 32 * MiB, WS_CB = 48 * MiB;
constexpr size_t WS_WGU = 72 * MiB;
constexpr size_t WS_WDN = 200 * MiB;
constexpr size_t WS_H = 264 * MiB;
constexpr size_t WS_PROJ = 296 * MiB;
constexpr size_t WS_HS = 296 * MiB;
constexpr size_t WS_ACT = 392 * MiB;
constexpr size_t WS_SCORE = 452 * MiB;
constexpr size_t WS_MERGED = 452 * MiB;
constexpr size_t WS_Y = 484 * MiB;
constexpr size_t WS_END = 580 * MiB;
static_assert(WS_WIN + (size_t)NP * D * 2 <= WS_WGU && WS_PROJ + (size_t)M * NP * 2 <= WS_SCORE && WS_ACT + (size_t)ROWCAP * FF * 2 <= WS_SCORE && WS_Y + (size_t)2 * M * D * 2 <= WS_END, "d_ws map");
constexpr int CW_CNT = 64;
constexpr int CW_BAR = 4096;

constexpr int RING_OFF = 0, RING_BYTES = 131072;
constexpr int LDSCTL_OFF = RING_BYTES, MISC_OFF = LDSCTL_OFF + 320;
constexpr int TILEE_OFF = RING_BYTES + 1024;
constexpr int LDS_BYTES = 147456;
static_assert(MISC_OFF + 128 <= TILEE_OFF && TILEE_OFF + 1024 <= LDS_BYTES, "LDS map");

#define GAS __attribute__((address_space(1)))
#define LAS __attribute__((address_space(3)))
typedef unsigned short bf16;
typedef unsigned v4u __attribute__((ext_vector_type(4)));
typedef float f32x4 __attribute__((ext_vector_type(4)));
typedef short bf16x8 __attribute__((ext_vector_type(8)));
typedef GAS unsigned gu32;
typedef GAS unsigned long long gu64;
#define RLX_AGENT __ATOMIC_RELAXED, __HIP_MEMORY_SCOPE_AGENT
#define LDS_WAIT() asm volatile("s_waitcnt lgkmcnt(0)" ::: "memory")
#define VM_WAIT() asm volatile("s_waitcnt vmcnt(0)" ::: "memory")
__device__ __forceinline__ unsigned long long rt() { return __builtin_amdgcn_s_memrealtime(); }
__device__ __forceinline__ unsigned f2bf(float f) { unsigned u = __builtin_bit_cast(unsigned, f); return (u + 0x7fffu + ((u >> 16) & 1u)) >> 16; }
__device__ __forceinline__ unsigned pk2(float lo, float hi) { return f2bf(lo) | (f2bf(hi) << 16); }

#define XB_TMO      128
#define XB_XCNT(j)  (256  + 64 * (j))
#define XB_XSUB(j)  (1280 + 64 * (j))
#define XB_XGEN(j)  (2304 + 64 * (j))
#define XB_TOP      3328
#define XB_TOPGEN   3392
#define XCD_BAR_WORDS 3456
#define XB_SPIN_CAP (1u << 18)

__device__ __forceinline__ unsigned xb_ld(unsigned* p)              { return __hip_atomic_load(p, __ATOMIC_RELAXED, __HIP_MEMORY_SCOPE_AGENT); }
__device__ __forceinline__ unsigned xb_add(unsigned* p, unsigned v) { return __hip_atomic_fetch_add(p, v, __ATOMIC_RELAXED, __HIP_MEMORY_SCOPE_AGENT); }
__device__ __forceinline__ unsigned xb_xcc_id() { return (unsigned)__builtin_amdgcn_s_getreg((3 << 11) | 20) & 0xFu; }
#define XB_SPIN(cond, bar) do { unsigned _sp = 0; while (cond) { __builtin_amdgcn_s_sleep(1); \
    if ((++_sp & 255u) == 0u) { if (xb_ld(&(bar)[XB_TMO])) break; if (_sp > XB_SPIN_CAP) { atomicAdd(&(bar)[XB_TMO], 1u); break; } } } } while (0)

struct XcdBarrier {
    unsigned* bar; unsigned x;
    volatile LAS unsigned* st;
};

__device__ __forceinline__ XcdBarrier xcd_barrier_post(unsigned* bar, volatile LAS unsigned* st) {
    XcdBarrier b; b.bar = bar; b.x = xb_xcc_id(); b.st = st;
    if (threadIdx.x == 0) (void)xb_add(&bar[XB_XCNT(b.x)], 1u);
    return b;
}
__device__ __forceinline__ void xcd_barrier_complete(unsigned* bar, unsigned x, unsigned& nloc, unsigned& nx) {
    const unsigned G = gridDim.x * gridDim.y * gridDim.z;
    unsigned sum, cnt, mine, sp = 0u;
    for (;;) {
        sum = 0u; cnt = 0u; mine = 0u;
#pragma unroll
        for (unsigned j = 0; j < 16; ++j) { const unsigned c = xb_ld(&bar[XB_XCNT(j)]); sum += c; cnt += (c > 0u) ? 1u : 0u; mine = (j == x) ? c : mine; }
        if (sum == G) break;
        __builtin_amdgcn_s_sleep(1);
        if ((++sp & 255u) == 0u) { if (xb_ld(&bar[XB_TMO])) break; if (sp > XB_SPIN_CAP) { atomicAdd(&bar[XB_TMO], 1u); break; } }
    }
    nloc = mine > 0u ? mine : 1u; nx = cnt > 0u ? cnt : 1u;
}

__device__ __forceinline__ void xcd_barrier(const XcdBarrier& b) {
    asm volatile("s_waitcnt vmcnt(0)" ::: "memory");
    __syncthreads();
    if (threadIdx.x == 0) {
        unsigned* bar = b.bar;
        __builtin_amdgcn_s_waitcnt(0);
        unsigned nloc = b.st[0], nx = b.st[1];
        if (nloc == 0u) { xcd_barrier_complete(bar, b.x, nloc, nx); b.st[0] = nloc; b.st[1] = nx; }
        const unsigned old = xb_add(&bar[XB_XSUB(b.x)], 1u);
        const unsigned gen = old / nloc;
        if (old + 1u == (gen + 1u) * nloc) {
            __builtin_amdgcn_fence(__ATOMIC_RELEASE, "agent");
            asm volatile("s_waitcnt vmcnt(0)" ::: "memory");
            const unsigned og = xb_add(&bar[XB_TOP], 1u);
            const unsigned tg = og / nx;
            if (og + 1u == (tg + 1u) * nx) xb_add(&bar[XB_TOPGEN], 1u);
            else XB_SPIN(xb_ld(&bar[XB_TOPGEN]) == tg, bar);
            __builtin_amdgcn_fence(__ATOMIC_ACQUIRE, "agent");
            xb_add(&bar[XB_XGEN(b.x)], 1u);
            asm volatile("s_waitcnt vmcnt(0)" ::: "memory");
        } else {
            XB_SPIN(xb_ld(&bar[XB_XGEN(b.x)]) == gen, bar);
            __builtin_amdgcn_fence(__ATOMIC_ACQUIRE, "agent");
            asm volatile("s_waitcnt vmcnt(0)" ::: "memory");
        }
    }
    __syncthreads();
}
struct Frame {
    LAS unsigned char* lds;
    volatile LAS unsigned* MISC;
    gu32* ctl;
    int tid, lane, wave;
    int vcu, G;
    unsigned char* ws;
};
struct Args { const float* in[19]; float* out; unsigned char* ws; int ph_lo, ph_hi; };
__device__ __forceinline__ const float* ld_in(const Args& a, int i) { asm volatile("" : "+s"(i)); return a.in[i]; }
__device__ __forceinline__ unsigned char* ld_ws(const Args& a) { int i = 0; asm volatile("" : "+s"(i)); return (&a.ws)[i]; }
enum { I_X = 0, I_C, I_WADA, I_BADA, I_GMIX, I_WIN, I_CONVW, I_WAUP, I_WBOUT, I_WO, I_GFFN, I_WRG, I_BRG, I_WRE, I_BRE, I_WEG, I_WEU, I_WED, I_GFIN };

__device__ __forceinline__ float wave_sum(float v) {
#pragma unroll
    for (int o = 1; o < 64; o <<= 1) v += __shfl_xor(v, o);
    return v;
}
__device__ __forceinline__ float bfu_lo(unsigned w) { return __builtin_bit_cast(float, w << 16); }
__device__ __forceinline__ float bfu_hi(unsigned w) { return __builtin_bit_cast(float, w & 0xffff0000u); }

__device__ __forceinline__ void p0_mod(Frame& F, const Args& A) {
    LAS float* sc = (LAS float*)(F.lds);
    LAS float* red = (LAS float*)(F.lds + 16384);
    const float* c = ld_in(A, I_C); const float* W = ld_in(A, I_WADA); const float* bias = ld_in(A, I_BADA);
    float* mod = (float*)(F.ws + WS_MOD);
    for (int i = F.tid; i < 2 * D; i += NWAVES * 64) { const float v = c[i]; sc[i] = v / (1.0f + __expf(-v)); }
    __syncthreads();
    const int cq = F.tid % 12, rr = F.tid / 12;
    for (int cg = F.vcu; cg < NMOD / 48; cg += F.G) {
        f32x4 a0 = {0.f, 0.f, 0.f, 0.f}, a1 = {0.f, 0.f, 0.f, 0.f};
        if (rr < 42) {
            const float* wp = W + (size_t)cg * 48 + cq * 4;
#pragma unroll 8
            for (int k = rr; k < D; k += 42) { const f32x4 w = *(const f32x4*)(wp + (size_t)k * NMOD); a0 += sc[k] * w; a1 += sc[D + k] * w; }
#pragma unroll
            for (int i = 0; i < 4; ++i) { red[rr * 96 + cq * 4 + i] = a0[i]; red[rr * 96 + 48 + cq * 4 + i] = a1[i]; }
        }
        __syncthreads();
        if (F.tid < 96) { const int b = F.tid / 48, col = F.tid % 48; float s = 0.f;
            for (int r = 0; r < 42; ++r) s += red[r * 96 + F.tid];
            mod[(size_t)b * NMOD + cg * 48 + col] = s + bias[cg * 48 + col]; }
        __syncthreads();
    }
}
__device__ __forceinline__ void p0_transpose_item(const float* W, int N, bf16* WT, int wt_pitch, int dst_row0, LAS float* scr, int kb, int nb, int lane) {
    const int k0 = 64 * kb, n0 = 32 * nb; const int col = n0 + (lane & 31); const bool cv = col < N;
#pragma unroll 8
    for (int i = 0; i < 32; ++i) { const int kk = 2 * i + (lane >> 5); scr[kk * 33 + (lane & 31)] = cv ? W[(size_t)(k0 + kk) * N + col] : 0.f; }
    LDS_WAIT(); asm volatile("" ::: "memory");
    const int c = lane & 7;
#pragma unroll
    for (int j = 0; j < 4; ++j) { const int n = (lane >> 3) + 8 * j; const LAS float* s = scr + (8 * c) * 33 + n;
        v4u o; o.x = pk2(s[0 * 33], s[1 * 33]); o.y = pk2(s[2 * 33], s[3 * 33]); o.z = pk2(s[4 * 33], s[5 * 33]); o.w = pk2(s[6 * 33], s[7 * 33]);
        if (n0 + n < N) *(GAS v4u*)(WT + (size_t)(dst_row0 + n) * wt_pitch + k0 + 8 * c) = o; }
    LDS_WAIT(); asm volatile("" ::: "memory");
}
__device__ __forceinline__ void p0_weights(Frame& F, const Args& A) {
    LAS float* scr = (LAS float*)(F.lds + 32768 + F.wave * 8704);
    const int gw = F.vcu * NWAVES + F.wave, NGW = F.G * NWAVES;
    bf16* WT_in = (bf16*)(F.ws + WS_WIN); bf16* WT_aup = (bf16*)(F.ws + WS_WMIX); bf16* WT_bout = WT_aup + (size_t)D * 1024; bf16* WT_o = WT_bout + (size_t)D * 1024;
    bf16* WT_gu = (bf16*)(F.ws + WS_WGU); bf16* WT_dn = (bf16*)(F.ws + WS_WDN);
    constexpr int NB_IN = (NPROJ + 31) / 32;
    constexpr int I_IN = 32 * NB_IN, I_A = 16 * 64, I_B = 16 * 64, I_O = 32 * 64, I_G = NE * 32 * 16, I_U = I_G, I_D = NE * 8 * 64;
    constexpr int NITEMS = I_IN + I_A + I_B + I_O + I_G + I_U + I_D;
    for (int it = gw; it < NITEMS; it += NGW) {
        int r = it;
        if (r < I_IN) { const int kb = r / NB_IN, nb = r % NB_IN; p0_transpose_item(ld_in(A, I_WIN), NPROJ, WT_in, D, 32 * nb, scr, kb, nb, F.lane); continue; } r -= I_IN;
        if (r < I_A) { const int kb = r / 64, nb = r % 64; p0_transpose_item(ld_in(A, I_WAUP), D, WT_aup, 1024, 32 * nb, scr, kb, nb, F.lane); continue; } r -= I_A;
        if (r < I_B) { const int kb = r / 64, nb = r % 64; p0_transpose_item(ld_in(A, I_WBOUT), D, WT_bout, 1024, 32 * nb, scr, kb, nb, F.lane); continue; } r -= I_B;
        if (r < I_O) { const int kb = r / 64, nb = r % 64; p0_transpose_item(ld_in(A, I_WO), D, WT_o, D, 32 * nb, scr, kb, nb, F.lane); continue; } r -= I_O;
        if (r < I_G + I_U) { const int up = r >= I_G; if (up) r -= I_G; const int e = r / 512, q = r % 512, kb = q / 16, nb = q % 16, n0 = 32 * nb;
            p0_transpose_item(ld_in(A, up ? I_WEU : I_WEG) + (size_t)e * D * FF, FF, WT_gu, D, e * 1024 + (n0 >> 7) * 256 + up * 128 + (n0 & 127), scr, kb, nb, F.lane); continue; } r -= I_G + I_U;
        { const int e = r / 512, q = r % 512, kb = q / 64, nb = q % 64;
            p0_transpose_item(ld_in(A, I_WED) + (size_t)e * FF * D, D, WT_dn, FF, e * D + 32 * nb, scr, kb, nb, F.lane); }
    }
    bf16* WR = (bf16*)(F.ws + WS_WR); const float* wrg = ld_in(A, I_WRG); const float* wre = ld_in(A, I_WRE);
    for (int i = F.vcu * (NWAVES * 64) + F.tid; i < 64 * D; i += F.G * NWAVES * 64) { const int n = i / D, k = i % D;
        const float v = n < 4 ? wrg[k * 4 + n] : (n < 36 ? wre[k * 32 + (n - 4)] : 0.f); WR[i] = (bf16)f2bf(v); }
}
__device__ __forceinline__ void row_norm_mod_bf16(const float* xrow, const float* g, const float* sc, const float* sh, bf16* orow, int lane) {
    const GAS f32x4* xr = (const GAS f32x4*)xrow + lane; f32x4 v[8]; float s = 0.f;
#pragma unroll
    for (int j = 0; j < 8; ++j) { v[j] = xr[64 * j]; s += (v[j].x * v[j].x + v[j].y * v[j].y) + (v[j].z * v[j].z + v[j].w * v[j].w); }
    const float r = 1.0f / sqrtf(wave_sum(s) * (1.0f / D) + EPS);
    GAS unsigned long long* o8 = (GAS unsigned long long*)orow + lane;
#pragma unroll
    for (int j = 0; j < 8; ++j) { const f32x4 gg = ((const GAS f32x4*)g)[lane + 64 * j], ss = ((const GAS f32x4*)sc)[lane + 64 * j], hh = ((const GAS f32x4*)sh)[lane + 64 * j];
        const f32x4 o = (v[j] * r) * gg * (1.0f + ss) + hh;
        o8[64 * j] = (unsigned long long)pk2(o.x, o.y) | ((unsigned long long)pk2(o.z, o.w) << 32); }
}
__device__ __forceinline__ void p_norm_rows(Frame& F, const Args& A, const float* X, const float* g, int which) {
    const int gw = F.vcu * NWAVES + F.wave, NGW = F.G * NWAVES;
    const float* mod = (const float*)(F.ws + WS_MOD); bf16* H = (bf16*)(F.ws + WS_H);
    for (int m = gw; m < M; m += NGW) { const float* mb = mod + (size_t)(m / SEQ) * NMOD + which * 3 * D;
        row_norm_mod_bf16(X + (size_t)m * D, g, mb + D, mb, H + (size_t)m * D, F.lane); }
}
__device__ __forceinline__ void p3_scores(Frame& F, const Args& A) {
    const bf16* P = (const bf16*)(F.ws + WS_PROJ); float* S = (float*)(F.ws + WS_SCORE);
    const int grp = F.wave >> 2, sub = F.wave & 3, c16 = F.lane & 15, kq = F.lane >> 4;
    for (int pair = F.vcu; pair < 256; pair += F.G) {
        const int b = pair >> 7, p = pair & 127, qb = grp == 0 ? p : 255 - p;
        const size_t qrow = (size_t)b * SEQ + qb * 16 + c16;
        const bf16* qp = P + qrow * NP;
        bf16x8 bq[IDXH][2]; float w[IDXH];
#pragma unroll
        for (int h = 0; h < IDXH; ++h)
#pragma unroll
            for (int ks = 0; ks < 2; ++ks) bq[h][ks] = *(const bf16x8*)(qp + C_IQ + h * 64 + ks * 32 + kq * 8);
        { const v4u w0 = *(const v4u*)(qp + C_IW), w1 = *(const v4u*)(qp + C_IW + 8);
            w[0] = bfu_lo(w0.x); w[1] = bfu_hi(w0.x); w[2] = bfu_lo(w0.y); w[3] = bfu_hi(w0.y); w[4] = bfu_lo(w0.z); w[5] = bfu_hi(w0.z); w[6] = bfu_lo(w0.w); w[7] = bfu_hi(w0.w);
            w[8] = bfu_lo(w1.x); w[9] = bfu_hi(w1.x); w[10] = bfu_lo(w1.y); w[11] = bfu_hi(w1.y); w[12] = bfu_lo(w1.z); w[13] = bfu_hi(w1.z); w[14] = bfu_lo(w1.w); w[15] = bfu_hi(w1.w); }
        float* srow = S + qrow * SEQ + kq * 4;
        for (int kt = sub; kt <= qb; kt += 4) {
            const bf16* kp = P + ((size_t)b * SEQ + kt * 16 + c16) * NP + C_IK + kq * 8;
            const bf16x8 a0 = *(const bf16x8*)kp, a1 = *(const bf16x8*)(kp + 32);
            f32x4 sc = {0.f, 0.f, 0.f, 0.f};
#pragma unroll
            for (int h = 0; h < IDXH; ++h) {
                f32x4 acc = {0.f, 0.f, 0.f, 0.f};
                acc = __builtin_amdgcn_mfma_f32_16x16x32_bf16(a0, bq[h][0], acc, 0, 0, 0);
                acc = __builtin_amdgcn_mfma_f32_16x16x32_bf16(a1, bq[h][1], acc, 0, 0, 0);
#pragma unroll
                for (int i = 0; i < 4; ++i) sc[i] += w[h] * fmaxf(acc[i], 0.f);
            }
            *(f32x4*)(srow + kt * 16) = sc;
        }
    }
}
__device__ __forceinline__ void p3_conv(Frame& F, const Args& A) {
    const bf16* P = (const bf16*)(F.ws + WS_PROJ); bf16* CB = (bf16*)(F.ws + WS_CB); const float* cw = ld_in(A, I_CONVW);
    const int nthr = F.G * NWAVES * 64;
    for (int idx = F.vcu * (NWAVES * 64) + F.tid; idx < M * 128; idx += nthr) {
        const int t = idx >> 7, ch = (idx & 127) * 8, tl = t & (SEQ - 1);
        float acc[8] = {0.f, 0.f, 0.f, 0.f, 0.f, 0.f, 0.f, 0.f};
#pragma unroll
        for (int j = 0; j < 3; ++j) { if (tl - 2 + j >= 0) { const bf16* rp = P + (size_t)(t - 2 + j) * NP;
            const v4u cg = *(const v4u*)(rp + C_CG + ch), xc = *(const v4u*)(rp + C_XC + ch);
            const f32x4 w0 = *(const f32x4*)(cw + j * 1024 + ch), w1 = *(const f32x4*)(cw + j * 1024 + ch + 4);
            acc[0] += w0.x * (bfu_lo(cg.x) * bfu_lo(xc.x)); acc[1] += w0.y * (bfu_hi(cg.x) * bfu_hi(xc.x)); acc[2] += w0.z * (bfu_lo(cg.y) * bfu_lo(xc.y)); acc[3] += w0.w * (bfu_hi(cg.y) * bfu_hi(xc.y));
            acc[4] += w1.x * (bfu_lo(cg.z) * bfu_lo(xc.z)); acc[5] += w1.y * (bfu_hi(cg.z) * bfu_hi(xc.z)); acc[6] += w1.z * (bfu_lo(cg.w) * bfu_lo(xc.w)); acc[7] += w1.w * (bfu_hi(cg.w) * bfu_hi(xc.w)); } }
        const v4u bg = *(const v4u*)(P + (size_t)t * NP + C_BG + ch);
        v4u o; o.x = pk2(bfu_lo(bg.x) * acc[0], bfu_hi(bg.x) * acc[1]); o.y = pk2(bfu_lo(bg.y) * acc[2], bfu_hi(bg.y) * acc[3]);
        o.z = pk2(bfu_lo(bg.z) * acc[4], bfu_hi(bg.z) * acc[5]); o.w = pk2(bfu_lo(bg.w) * acc[6], bfu_hi(bg.w) * acc[7]);
        *(v4u*)(CB + (size_t)t * 1024 + ch) = o;
    }
}
__device__ __forceinline__ void p4_select_row(const float* srow, unsigned long long* mrow, int t, int lane) {
    unsigned key[64];
#pragma unroll
    for (int j = 0; j < 64; ++j) {
        unsigned k = 0u;
        if (j * 64 <= t) { const int idx = j * 64 + lane; if (idx <= t) { const unsigned u = __builtin_bit_cast(unsigned, srow[idx]); k = (u & 0x80000000u) ? ~u : (u | 0x80000000u); } }
        key[j] = k;
    }
    unsigned thr = 1u;
    if (t >= TOPK) {
        unsigned prefix = 0u;
        for (int bit = 31; bit >= 0; --bit) {
            const unsigned cand = prefix | (1u << bit); unsigned cnt = 0u;
#pragma unroll
            for (int j = 0; j < 64; ++j) { cnt += (unsigned)__popcll(__ballot(key[j] >= cand)); if ((j & 7) == 7) __builtin_amdgcn_sched_barrier(0); }
            if (cnt >= (unsigned)TOPK) prefix = cand;
        }
        thr = prefix;
    }
    unsigned mlo = 0u, mhi = 0u;
#define P4_WL1(j) { const unsigned long long bm_ = __ballot(key[j] >= thr); const unsigned bl_ = (unsigned)bm_, bh_ = (unsigned)(bm_ >> 32); \
        asm volatile("s_nop 3\n\tv_writelane_b32 %0, %1, %2" : "+v"(mlo) : "s"(bl_), "i"(j)); asm volatile("s_nop 3\n\tv_writelane_b32 %0, %1, %2" : "+v"(mhi) : "s"(bh_), "i"(j)); }
#define P4_WL4(j) P4_WL1(j) P4_WL1((j) + 1) P4_WL1((j) + 2) P4_WL1((j) + 3)
#define P4_WL16(j) P4_WL4(j) P4_WL4((j) + 4) P4_WL4((j) + 8) P4_WL4((j) + 12)
    P4_WL16(0) P4_WL16(16) P4_WL16(32) P4_WL16(48)
#undef P4_WL16
#undef P4_WL4
#undef P4_WL1
    mrow[lane] = ((unsigned long long)mhi << 32) | mlo;
}
__device__ __forceinline__ void p4_select(Frame& F, const Args& A) {
    const float* S = (const float*)(F.ws + WS_SCORE); unsigned long long* MK = (unsigned long long*)(F.ws + WS_MASK);
    const int gw = F.vcu * NWAVES + F.wave, NGW = F.G * NWAVES;
    for (int pi = gw; pi < M / 2; pi += NGW) {
        const int b = pi / (SEQ / 2), p = pi % (SEQ / 2);
#pragma unroll 1
        for (int z = 0; z < 2; ++z) { const int t = z == 0 ? p : SEQ - 1 - p; const size_t row = (size_t)b * SEQ + t;
            p4_select_row(S + row * SEQ, MK + row * 64, t, F.lane); }
    }
}
__device__ __forceinline__ void p7_route(Frame& F, const Args& A) {
    const float* LG = (const float*)(F.ws + WS_LOGIT); const float* brg = ld_in(A, I_BRG); const float* bre = ld_in(A, I_BRE);
    int* rowtok = (int*)(F.ws + WS_ROWTOK); float* roww = (float*)(F.ws + WS_ROWW);
    for (int t = F.vcu * (NWAVES * 64) + F.tid; t < M; t += F.G * NWAVES * 64) {
        const float* lg = LG + (size_t)t * 64;
        float gl[NGRP]; int g = 0;
#pragma unroll
        for (int i = 0; i < NGRP; ++i) { gl[i] = lg[i] + brg[i]; }
#pragma unroll
        for (int i = 1; i < NGRP; ++i) if (gl[i] > gl[g]) g = i;
        float den = 0.f;
#pragma unroll
        for (int i = 0; i < NGRP; ++i) den += __expf(gl[i] - gl[g]);
        const float pg = 1.0f / den;
        float v0 = -INFINITY, v1 = -INFINITY; int i0 = 0, i1 = 0;
        for (int j = 0; j < EPG; ++j) { const float v = lg[4 + g * EPG + j] + bre[g * EPG + j];
            if (v > v0) { v1 = v0; i1 = i0; v0 = v; i0 = j; } else if (v > v1) { v1 = v; i1 = j; } }
        const float e1 = __expf(v1 - v0), p0 = 1.0f / (1.0f + e1), p1 = e1 * p0;
        const int ea = g * EPG + i0, eb = g * EPG + i1;
        const unsigned pa = __hip_atomic_fetch_add(F.ctl + CW_CNT + 64 * ea, 1u, __ATOMIC_RELAXED, __HIP_MEMORY_SCOPE_AGENT);
        const unsigned pb = __hip_atomic_fetch_add(F.ctl + CW_CNT + 64 * eb, 1u, __ATOMIC_RELAXED, __HIP_MEMORY_SCOPE_AGENT);
        rowtok[(size_t)ea * M + pa] = t * 2 + 0; roww[(size_t)ea * M + pa] = pg * p0;
        rowtok[(size_t)eb * M + pb] = t * 2 + 1; roww[(size_t)eb * M + pb] = pg * p1;
    }
}
__device__ __forceinline__ void moe_table(Frame& F, const Args& A) {
    LAS int* tb = (LAS int*)(F.lds + TILEE_OFF);
    if (F.tid == 0) { int base = 0, nt = 0;
        for (int e = 0; e < NE; ++e) { const int c = (int)__hip_atomic_load(F.ctl + CW_CNT + 64 * e, __ATOMIC_RELAXED, __HIP_MEMORY_SCOPE_AGENT); const int tl = (c + 255) >> 8;
            tb[128 + e] = base; for (int i = 0; i < tl; ++i) tb[nt + i] = e; nt += tl; base += tl * 256; }
        tb[192] = nt; }
    __syncthreads();
}
__device__ __forceinline__ void p7_gather(Frame& F, const Args& A) {
    moe_table(F, A);
    const LAS int* tb = (const LAS int*)(F.lds + TILEE_OFF);
    const int nrows = tb[192] * 256; const int gw = F.vcu * NWAVES + F.wave, NGW = F.G * NWAVES;
    const bf16* H = (const bf16*)(F.ws + WS_H); bf16* HS = (bf16*)(F.ws + WS_HS);
    const int* rowtok = (const int*)(F.ws + WS_ROWTOK); const float* roww = (const float*)(F.ws + WS_ROWW);
    int* rowtok2 = (int*)(F.ws + WS_ROWTOK2); float* roww2 = (float*)(F.ws + WS_ROWW2);
    for (int R = gw; R < nrows; R += NGW) {
        const int e = tb[R >> 8]; const int i = R - tb[128 + e];
        const int cnt = (int)__hip_atomic_load(F.ctl + CW_CNT + 64 * e, __ATOMIC_RELAXED, __HIP_MEMORY_SCOPE_AGENT);
        if (i < cnt) { const int tk = rowtok[(size_t)e * M + i]; const float w = roww[(size_t)e * M + i];
            const GAS v4u* src = (const GAS v4u*)(H + (size_t)(tk >> 1) * D) + F.lane; GAS v4u* dst = (GAS v4u*)(HS + (size_t)R * D) + F.lane;
#pragma unroll
            for (int j = 0; j < 4; ++j) dst[64 * j] = src[64 * j];
            if (F.lane == 0) { rowtok2[R] = tk; roww2[R] = w; } }
        else { GAS v4u* dst = (GAS v4u*)(HS + (size_t)R * D) + F.lane; const v4u z = {0u, 0u, 0u, 0u};
#pragma unroll
            for (int j = 0; j < 4; ++j) dst[64 * j] = z;
            if (F.lane == 0) { rowtok2[R] = -1; roww2[R] = 0.f; } }
    }
}
__device__ __forceinline__ void p9_final(Frame& F, const Args& A) {
    const int gw = F.vcu * NWAVES + F.wave, NGW = F.G * NWAVES;
    const float* mod = (const float*)(F.ws + WS_MOD); const bf16* Y = (const bf16*)(F.ws + WS_Y); const float* gf = ld_in(A, I_GFIN);
    for (int m = gw; m < M; m += NGW) {
        const float* g2 = mod + (size_t)(m / SEQ) * NMOD + 5 * D;
        GAS f32x4* xr = (GAS f32x4*)(A.out + (size_t)m * D) + F.lane;
        const GAS unsigned long long* y0 = (const GAS unsigned long long*)(Y + (size_t)m * D) + F.lane; const GAS unsigned long long* y1 = (const GAS unsigned long long*)(Y + ((size_t)M + m) * D) + F.lane;
        f32x4 v[8]; float s = 0.f;
#pragma unroll
        for (int j = 0; j < 8; ++j) { const f32x4 x = xr[64 * j]; const f32x4 gg = ((const GAS f32x4*)g2)[F.lane + 64 * j]; const unsigned long long a = y0[64 * j], bq = y1[64 * j];
            const unsigned al = (unsigned)a, ah = (unsigned)(a >> 32), bl = (unsigned)bq, bh = (unsigned)(bq >> 32);
            f32x4 ys; ys.x = bfu_lo(al) + bfu_lo(bl); ys.y = bfu_hi(al) + bfu_hi(bl); ys.z = bfu_lo(ah) + bfu_lo(bh); ys.w = bfu_hi(ah) + bfu_hi(bh);
            v[j] = x + gg * ys; s += (v[j].x * v[j].x + v[j].y * v[j].y) + (v[j].z * v[j].z + v[j].w * v[j].w); }
        const float r = 1.0f / sqrtf(wave_sum(s) * (1.0f / D) + EPS);
#pragma unroll
        for (int j = 0; j < 8; ++j) { const f32x4 gg = ((const GAS f32x4*)gf)[F.lane + 64 * j]; xr[64 * j] = (v[j] * r) * gg; }
    }
}

constexpr int NPHASE = 16;
__global__ void __launch_bounds__(NWAVES * 64, 2) mk_fwd(Args args) {
    extern __shared__ __attribute__((aligned(16))) unsigned char lds[];
    Frame F;
    F.lds = (LAS unsigned char*)lds;
    F.MISC = (volatile LAS unsigned*)(F.lds + MISC_OFF);
    F.tid = threadIdx.x; F.lane = F.tid & 63; F.wave = __builtin_amdgcn_readfirstlane(F.tid >> 6);
    F.G = gridDim.x; { const int bx = blockIdx.x; F.vcu = (F.G % 8 == 0) ? (bx % 8) * (F.G / 8) + bx / 8 : bx; }
    F.ws = args.ws; F.ctl = (gu32*)(args.ws + WS_CTL);
    const Args& A = args;
    for (int u = F.tid; u < (LDS_BYTES - LDSCTL_OFF) / 4; u += NWAVES * 64) ((LAS unsigned*)(F.lds + LDSCTL_OFF))[u] = 0u;
    __syncthreads();
    XcdBarrier bar; bar.bar = (unsigned*)(F.ctl + CW_BAR); bar.x = 0; bar.st = nullptr;
    if (N_LAUNCHES == 1) bar = xcd_barrier_post((unsigned*)(F.ctl + CW_BAR), F.MISC + 8);
#define GRID_BAR() do { if (N_LAUNCHES == 1) { xcd_barrier(bar); } } while (0)
    const int lo = args.ph_lo, hi = args.ph_hi;
#ifndef PHMASK
#define PHMASK 0xFFFF
#endif
#define IN(k) (((PHMASK >> (k)) & 1) && lo <= (k) && (k) < hi)
#define BOTH(k) (IN(k) && IN((k) + 1))
#define PHASE_FENCE() do { asm volatile("" : "+v"(F.tid), "+v"(F.lane)); F.ws = ld_ws(A); F.ctl = (gu32*)(F.ws + WS_CTL); } while (0)

#define W_H ((bf16*)(F.ws + WS_H))
#define W_PROJ ((bf16*)(F.ws + WS_PROJ))
#define W_OA ((bf16*)(F.ws + WS_OA))
#define W_CB ((bf16*)(F.ws + WS_CB))
#define W_MERGED ((bf16*)(F.ws + WS_MERGED))
#define W_WT_in ((bf16*)(F.ws + WS_WIN))
#define W_WT_aup ((bf16*)(F.ws + WS_WMIX))
#define W_WT_bout ((bf16*)(F.ws + WS_WMIX + (size_t)D * 1024 * 2))
#define W_WT_o ((bf16*)(F.ws + WS_WMIX + (size_t)D * 1024 * 4))
#define W_WT_gu ((bf16*)(F.ws + WS_WGU))
#define W_WT_dn ((bf16*)(F.ws + WS_WDN))
#define W_WR ((bf16*)(F.ws + WS_WR))
#define W_HS ((bf16*)(F.ws + WS_HS))
#define W_ACT ((bf16*)(F.ws + WS_ACT))
#define W_Y ((bf16*)(F.ws + WS_Y))
#define W_mod ((const float*)(F.ws + WS_MOD))
#define W_ws F.ws

    if (IN(0)) { PHASE_FENCE(); p0_mod(F, A); p0_weights(F, A); if (BOTH(0)) GRID_BAR(); }
    if (IN(1)) { PHASE_FENCE(); p_norm_rows(F, A, ld_in(A, I_X), ld_in(A, I_GMIX), 0); if (BOTH(1)) GRID_BAR(); }
    if (IN(2)) { PHASE_FENCE();
        pg8::Gemm g{W_H, W_WT_in, M, NP, D}; pg8::StaticOrder S; S.init(M, NP, F.G, (int)blockIdx.x);
        pg8::EpiBf16<0> E{W_PROJ, NP, nullptr, 1024, 1024, attn_body::C2};
        pg8::gemm_phase<pg8::EpiBf16<0>, pg8::StaticOrder, PG8_ALIGN, PG8_SP2>(F.lds + RING_OFF, g, S, E);
        if (BOTH(2)) GRID_BAR();
    }
    if (IN(3)) { PHASE_FENCE(); p3_scores(F, A); p3_conv(F, A); if (BOTH(3)) GRID_BAR(); }
    if (IN(4)) { PHASE_FENCE(); p4_select(F, A); if (BOTH(4)) GRID_BAR(); }
    if (IN(5)) { PHASE_FENCE();
        static_assert(attn_body::ATTN_LDS_BYTES <= RING_BYTES, "attention body LDS vs frame");
        const attn_body::AttnTensors AT{(const attn_body::bf16*)(W_PROJ + C_Q), (const attn_body::bf16*)(W_PROJ + C_K), (const attn_body::bf16*)(W_PROJ + C_V), (attn_body::bf16*)W_OA, (const unsigned long long*)(W_ws + WS_MASK)};
        const attn_body::StaticOrder S((int)F.G, (int)blockIdx.x);
        attn_body::attn_phase<attn_body::StaticOrder>((char*)lds + RING_OFF, AT, S);
        if (BOTH(5)) GRID_BAR();
    }
    if (IN(6)) { PHASE_FENCE();
        pg8::Gemm g{W_OA, W_WT_aup, M, D, 1024}; pg8::StaticOrder S; S.init(M, D, F.G, (int)blockIdx.x);
        pg8::EpiGate E{W_MERGED, D, W_PROJ, NP, C_GA, 0};
        pg8::gemm_phase<pg8::EpiGate, pg8::StaticOrder, PG8_ALIGN, PG8_SP2>(F.lds + RING_OFF, g, S, E);
        if (BOTH(6)) GRID_BAR();
    }
    if (IN(7)) { PHASE_FENCE();
        pg8::Gemm g{W_CB, W_WT_bout, M, D, 1024}; pg8::StaticOrder S; S.init(M, D, F.G, (int)blockIdx.x);
        pg8::EpiGate E{W_MERGED, D, W_PROJ, NP, C_GB, 1};
        pg8::gemm_phase<pg8::EpiGate, pg8::StaticOrder, PG8_ALIGN, PG8_SP2>(F.lds + RING_OFF, g, S, E);
        if (BOTH(7)) GRID_BAR();
    }
    if (IN(8)) { PHASE_FENCE();
        pg8::Gemm g{W_MERGED, W_WT_o, M, D, D}; pg8::StaticOrder S; S.init(M, D, F.G, (int)blockIdx.x);
        pg8::EpiRes E{ld_in(A, I_X), A.out, W_mod + 2 * D, NMOD, D, SEQ};
        pg8::gemm_phase<pg8::EpiRes, pg8::StaticOrder, PG8_ALIGN, PG8_SP2>(F.lds + RING_OFF, g, S, E);
        if (BOTH(8)) GRID_BAR();
    }
    if (IN(9)) { PHASE_FENCE(); p_norm_rows(F, A, A.out, ld_in(A, I_GFFN), 1); if (BOTH(9)) GRID_BAR(); }
    if (IN(10)) { PHASE_FENCE();
        pg8::Gemm g{W_H, W_WR, M, 256, D}; pg8::StaticOrder S; S.init(M, 256, F.G, (int)blockIdx.x);
        pg8::EpiLogit E{(float*)(W_ws + WS_LOGIT)};
        pg8::gemm_phase<pg8::EpiLogit, pg8::StaticOrder, PG8_ALIGN, PG8_SP2>(F.lds + RING_OFF, g, S, E);
        if (BOTH(10)) GRID_BAR();
    }
    if (IN(11)) { PHASE_FENCE(); p7_route(F, A); if (BOTH(11)) GRID_BAR(); }
    if (IN(12)) { PHASE_FENCE(); p7_gather(F, A); if (BOTH(12)) GRID_BAR(); }
    if (IN(13)) { PHASE_FENCE();
        moe_table(F, A); const LAS int* tb = (const LAS int*)(F.lds + TILEE_OFF);
        pg8::Gemm g{W_HS, W_WT_gu, ROWCAP, NE * 1024, D}; pg8::MoeOrder S{tb, __builtin_amdgcn_readfirstlane(tb[192]), 4, F.G, (int)blockIdx.x};
        pg8::EpiAct E{W_ACT, (const float*)(W_ws + WS_ROWW2)};
        pg8::gemm_phase<pg8::EpiAct, pg8::MoeOrder, PG8_ALIGN, PG8_SP2>(F.lds + RING_OFF, g, S, E);
        if (BOTH(13)) GRID_BAR();
    }
    if (IN(14)) { PHASE_FENCE();
        moe_table(F, A); const LAS int* tb = (const LAS int*)(F.lds + TILEE_OFF);
        pg8::Gemm g{W_ACT, W_WT_dn, ROWCAP, NE * D, FF}; pg8::MoeOrder S{tb, __builtin_amdgcn_readfirstlane(tb[192]), 8, F.G, (int)blockIdx.x};
        pg8::EpiDown E{W_Y, (const int*)(W_ws + WS_ROWTOK2), M};
        pg8::gemm_phase<pg8::EpiDown, pg8::MoeOrder, PG8_ALIGN, PG8_SP2>(F.lds + RING_OFF, g, S, E);
        if (BOTH(14)) GRID_BAR();
    }
    if (IN(15)) { PHASE_FENCE(); p9_final(F, A); }
#undef W_H
#undef W_PROJ
#undef W_OA
#undef W_CB
#undef W_MERGED
#undef W_WT_in
#undef W_WT_aup
#undef W_WT_bout
#undef W_WT_o
#undef W_WT_gu
#undef W_WT_dn
#undef W_WR
#undef W_HS
#undef W_ACT
#undef W_Y
#undef W_mod
#undef W_ws
#undef IN
#undef BOTH
#undef GRID_BAR
}

extern "C" void kernel_launch(void* const* d_in, const int* in_sizes, int n_in, void* d_out, int out_size, void* d_ws, size_t ws_size, hipStream_t stream) {
    static int grid = 0;
    if (grid == 0) {
        if (n_in != 19 || in_sizes[0] != M * D || out_size != M * D || ws_size < WS_END) { fprintf(stderr, "kernel_launch: built for 19 inputs, x/out of %d floats, >= %zu bytes of workspace; got n_in %d, in0 %d, out %d, ws %zu; nothing launched\n", M * D, (size_t)WS_END, n_in, n_in > 0 ? in_sizes[0] : -1, out_size, ws_size); grid = -1; return; }
        int dev = 0, cus = 0, per_cu = 0;
        if (hipGetDevice(&dev) != hipSuccess || hipDeviceGetAttribute(&cus, hipDeviceAttributeMultiprocessorCount, dev) != hipSuccess) { fprintf(stderr, "kernel_launch: hipGetDevice / hipDeviceGetAttribute failed; nothing launched\n"); grid = -1; return; }
        if (hipFuncSetAttribute((const void*)mk_fwd, hipFuncAttributeMaxDynamicSharedMemorySize, LDS_BYTES) != hipSuccess) { fprintf(stderr, "kernel_launch: hipFuncSetAttribute failed\n"); grid = -1; return; }
        if (hipOccupancyMaxActiveBlocksPerMultiprocessor(&per_cu, (const void*)mk_fwd, NWAVES * 64, LDS_BYTES) != hipSuccess || per_cu < 1) { fprintf(stderr, "kernel_launch: occupancy query reports %d workgroups per CU; nothing launched\n", per_cu); (void)hipGetLastError(); grid = -1; return; }
        grid = cus;
    }
    if (grid < 0) return;
    if (hipMemsetAsync((char*)d_ws + WS_CTL, 0, CTL_ZERO_BYTES, stream) != hipSuccess) { fprintf(stderr, "kernel_launch: hipMemsetAsync of the control words failed; nothing launched\n"); return; }
    Args a{};
    for (int i = 0; i < 19; ++i) a.in[i] = (const float*)d_in[i];
    a.out = (float*)d_out; a.ws = (unsigned char*)d_ws;
    if (N_LAUNCHES == 1) { a.ph_lo = 0; a.ph_hi = NPHASE; hipLaunchKernelGGL(mk_fwd, dim3(grid), dim3(NWAVES * 64), LDS_BYTES, stream, a); }
    else for (int li = 0; li < NPHASE; ++li) { a.ph_lo = li; a.ph_hi = li + 1; hipLaunchKernelGGL(mk_fwd, dim3(grid), dim3(NWAVES * 64), LDS_BYTES, stream, a); }
    const hipError_t le = hipPeekAtLastError();
    if (le != hipSuccess) fprintf(stderr, "kernel_launch: launch failed: %s (grid %d x %d threads, %d B LDS)\n", hipGetErrorName(le), grid, NWAVES * 64, LDS_BYTES);
}
```

```cpp
#include <hip/hip_runtime.h>
#include <cstdio>
#include <cstdint>
namespace pg8 {
#define PG8_LAS __attribute__((address_space(3)))
typedef unsigned short bf16_t;
typedef short bf16x8 __attribute__((ext_vector_type(8)));
typedef float f32x4 __attribute__((ext_vector_type(4)));
typedef unsigned u32x4 __attribute__((ext_vector_type(4)));
constexpr int BM = 256, BK = 64, HALF = 128, HTB = HALF * BK * 2  , STAGE_BYTES = 8 * HTB, NXCD = 8, WGM = 8;

__host__ __device__ __forceinline__ int lds_byte(int r, int c) { const int st = (r >> 4) * 2 + (c >> 5), rr = r & 15, cc = c & 31, ob = rr * 64 + cc * 2; return st * 1024 + (ob ^ (((ob >> 9) & 1) << 5)); }
__host__ __device__ __forceinline__ void stage_rc(int b, int& R, int& C) { const int st = b / 1024, sb = b % 1024, swz = sb ^ (((sb >> 9) & 1) << 5); R = (st >> 1) * 16 + swz / 64; C = (st & 1) * 32 + (swz % 64) / 2; }
__host__ __device__ __forceinline__ int perm32(int rho) { const int n = rho >> 4, i = rho & 15; return 8 * (i >> 2) + 4 * n + (i & 3); }

struct Unit { int pm, pn; };
struct Gemm { const bf16_t* A; const bf16_t* Bt; int M, N, K; };

struct StaticOrder {
    int nM, nN, nwg, G, c, rep;
    __host__ __device__ void init(int M, int N, int G_, int c_) { nM = M / BM; nN = N / BM; nwg = nM * nN; G = G_; c = c_; rep = 1; }
    __host__ __device__ bool next(int i, Unit& u) const {
        const long L = (long)(i / rep) * G + c; if (L >= nwg) return false;
        int wgid = (int)L; { const int q = nwg / NXCD, r = nwg % NXCD, xcd = wgid % NXCD, off = wgid / NXCD; wgid = (xcd < r ? xcd * (q + 1) : r * (q + 1) + (xcd - r) * q) + off; }
        const int nig = WGM * nN, gid = wgid / nig, fm = gid * WGM, gsz = (nM - fm) < WGM ? (nM - fm) : WGM;
        u.pm = fm + ((wgid % nig) % gsz); u.pn = (wgid % nig) / gsz; return true;
    }
    __device__ __forceinline__ void a_ready(const Unit&) const {}
    __device__ __forceinline__ void done(const Unit&) const {}
};

__device__ __forceinline__ unsigned cvt_pk_bf16(float lo, float hi) { unsigned r; asm volatile("v_cvt_pk_bf16_f32 %0, %1, %2" : "=v"(r) : "v"(lo), "v"(hi)); return r; }
typedef float f32x2 __attribute__((ext_vector_type(2)));
__device__ __forceinline__ f32x2 gelu_pk(f32x2 v) {
    const f32x2 av = __builtin_elementwise_abs(v), d = av * 0.2316418882f + 1.0f;
    f32x2 t; t.x = __builtin_amdgcn_rcpf(d.x); t.y = __builtin_amdgcn_rcpf(d.y);
    f32x2 q = t * 0.5307027145f + (-0.7265760135f); q = q * t + 0.7107068705f; q = q * t + (-0.142248368f); q = q * t + 0.127414796f; q = q * t;
    const f32x2 s = (v * v) * (-0.72134752044f);
    f32x2 e; e.x = __builtin_amdgcn_exp2f(s.x); e.y = __builtin_amdgcn_exp2f(s.y);
    const f32x2 m = v * (q * e), r = v - m;
    f32x2 o; o.x = v.x < 0.f ? m.x : r.x; o.y = v.y < 0.f ? m.y : r.y; return o;
}

template <int ACT  > struct EpiBf16 {
    static constexpr bool PERM = true, AFTER_DRAIN = false; static_assert(ACT == 0 || ACT == 1, "EpiBf16: ACT is 0 (none) or 1 (gelu_pk)");
    bf16_t* O; int ldc; const float* bias; int split_cols; size_t split_stride; float scale0;
    __device__ __forceinline__ void operator()(const f32x4 (&acc)[2][2][4][2], const Unit& u, int wr, int wc, int fr, int fq) const {
        const int row0 = u.pm * BM + wr * 64 + fr; int colt = u.pn * BM; bf16_t* base = O;
        float sc = 1.f; if (split_cols) { const int t = colt / split_cols; base += (size_t)t * split_stride; colt -= t * split_cols; if (t == 0) sc = scale0; }
        const int col0 = colt + wc * 32 + 8 * fq, bcol0 = u.pn * BM + wc * 32 + 8 * fq;
        f32x4 bv[2][2];
#pragma unroll
        for (int bj = 0; bj < 2; ++bj)
#pragma unroll
            for (int n = 0; n < 2; ++n) bv[bj][n] = bias ? *(const f32x4*)(bias + bcol0 + bj * HALF + 4 * n) : (f32x4){0.f, 0.f, 0.f, 0.f};
#pragma unroll
        for (int ai = 0; ai < 2; ++ai)
#pragma unroll
            for (int m = 0; m < 4; ++m) { bf16_t* rowp = base + (size_t)(row0 + ai * HALF + m * 16) * ldc + col0;
#pragma unroll
                for (int bj = 0; bj < 2; ++bj) { f32x4 v0 = acc[ai][bj][m][0] + bv[bj][0], v1 = acc[ai][bj][m][1] + bv[bj][1];
                    if (ACT == 1) { f32x2 a = gelu_pk((f32x2){v0[0], v0[1]}), b = gelu_pk((f32x2){v0[2], v0[3]}), c = gelu_pk((f32x2){v1[0], v1[1]}), d = gelu_pk((f32x2){v1[2], v1[3]});
                        v0 = (f32x4){a.x, a.y, b.x, b.y}; v1 = (f32x4){c.x, c.y, d.x, d.y}; }
                    v0 = v0 * sc; v1 = v1 * sc; u32x4 w; w.x = cvt_pk_bf16(v0[0], v0[1]); w.y = cvt_pk_bf16(v0[2], v0[3]); w.z = cvt_pk_bf16(v1[0], v1[1]); w.w = cvt_pk_bf16(v1[2], v1[3]);
                    *(u32x4*)(rowp + bj * HALF) = w; } }
    }
};
__device__ __forceinline__ float bf_lo(unsigned w) { return __builtin_bit_cast(float, w << 16); }
__device__ __forceinline__ float bf_hi(unsigned w) { return __builtin_bit_cast(float, w & 0xffff0000u); }
__device__ __forceinline__ float sigmoid_f(float x) { return __builtin_amdgcn_rcpf(1.0f + __builtin_amdgcn_exp2f(-1.4426950408889634f * x)); }
struct EpiGate {
    static constexpr bool PERM = true, AFTER_DRAIN = false;
    bf16_t* O; int ldc; const bf16_t* Gt; int ldg; int goff; int add;
    __device__ __forceinline__ void operator()(const f32x4 (&acc)[2][2][4][2], const Unit& u, int wr, int wc, int fr, int fq) const {
        const int row0 = u.pm * BM + wr * 64 + fr, col0 = u.pn * BM + wc * 32 + 8 * fq;
#pragma unroll
        for (int ai = 0; ai < 2; ++ai)
#pragma unroll
            for (int m = 0; m < 4; ++m) { const size_t row = (size_t)(row0 + ai * HALF + m * 16);
#pragma unroll
                for (int bj = 0; bj < 2; ++bj) { const int col = col0 + bj * HALF;
                    const u32x4 g = *(const u32x4*)(Gt + row * ldg + goff + col);
                    const f32x4 v0 = acc[ai][bj][m][0], v1 = acc[ai][bj][m][1];
                    float r0 = sigmoid_f(bf_lo(g.x)) * v0[0], r1 = sigmoid_f(bf_hi(g.x)) * v0[1], r2 = sigmoid_f(bf_lo(g.y)) * v0[2], r3 = sigmoid_f(bf_hi(g.y)) * v0[3];
                    float r4 = sigmoid_f(bf_lo(g.z)) * v1[0], r5 = sigmoid_f(bf_hi(g.z)) * v1[1], r6 = sigmoid_f(bf_lo(g.w)) * v1[2], r7 = sigmoid_f(bf_hi(g.w)) * v1[3];
                    bf16_t* op = O + row * ldc + col;
                    if (add) { const u32x4 o = *(const u32x4*)op; r0 += bf_lo(o.x); r1 += bf_hi(o.x); r2 += bf_lo(o.y); r3 += bf_hi(o.y); r4 += bf_lo(o.z); r5 += bf_hi(o.z); r6 += bf_lo(o.w); r7 += bf_hi(o.w); }
                    u32x4 w; w.x = cvt_pk_bf16(r0, r1); w.y = cvt_pk_bf16(r2, r3); w.z = cvt_pk_bf16(r4, r5); w.w = cvt_pk_bf16(r6, r7);
                    *(u32x4*)op = w; } }
    }
};
struct EpiRes {
    static constexpr bool PERM = false, AFTER_DRAIN = false;
    const float* X; float* O; const float* gate0; int gate_bstride; int ldc; int rows_per_batch;
    __device__ __forceinline__ void operator()(const f32x4 (&acc)[2][2][4][2], const Unit& u, int wr, int wc, int fr, int fq) const {
        const int row0 = u.pm * BM + wr * 64 + fr, col0 = u.pn * BM + wc * 32 + 4 * fq;
        const float* gp = gate0 + (size_t)((u.pm * BM) / rows_per_batch) * gate_bstride;
#pragma unroll
        for (int bj = 0; bj < 2; ++bj)
#pragma unroll
            for (int n = 0; n < 2; ++n) { const int col = col0 + bj * HALF + n * 16; const f32x4 g = *(const f32x4*)(gp + col);
#pragma unroll
                for (int ai = 0; ai < 2; ++ai)
#pragma unroll
                    for (int m = 0; m < 4; ++m) { const size_t off = (size_t)(row0 + ai * HALF + m * 16) * ldc + col;
                        const f32x4 x = *(const f32x4*)(X + off); *(f32x4*)(O + off) = x + g * acc[ai][bj][m][n]; } }
    }
};
struct EpiLogit {
    static constexpr bool PERM = false, AFTER_DRAIN = false;
    float* O;
    __device__ __forceinline__ void operator()(const f32x4 (&acc)[2][2][4][2], const Unit& u, int wr, int wc, int fr, int fq) const {
        if (wc < 2) {
            const int row0 = u.pm * BM + wr * 64 + fr, col0 = wc * 32 + 4 * fq;
#pragma unroll
            for (int ai = 0; ai < 2; ++ai)
#pragma unroll
                for (int m = 0; m < 4; ++m)
#pragma unroll
                    for (int n = 0; n < 2; ++n) *(f32x4*)(O + (size_t)(row0 + ai * HALF + m * 16) * 64 + col0 + n * 16) = acc[ai][0][m][n];
        }
    }
};
struct EpiAct {
    static constexpr bool PERM = true, AFTER_DRAIN = false;
    bf16_t* ACT; const float* roww;
    __device__ __forceinline__ void operator()(const f32x4 (&acc)[2][2][4][2], const Unit& u, int wr, int wc, int fr, int fq) const {
        const int row0 = u.pm * BM + wr * 64 + fr, col0 = (u.pn & 3) * 128 + wc * 32 + 8 * fq;
#pragma unroll
        for (int ai = 0; ai < 2; ++ai)
#pragma unroll
            for (int m = 0; m < 4; ++m) { const size_t R = (size_t)(row0 + ai * HALF + m * 16); const float w = roww[R];
                const f32x4 g0 = acc[ai][0][m][0], g1 = acc[ai][0][m][1], u0 = acc[ai][1][m][0], u1 = acc[ai][1][m][1];
                float r[8];
#pragma unroll
                for (int i = 0; i < 4; ++i) { r[i] = g0[i] * sigmoid_f(g0[i]) * u0[i] * w; r[4 + i] = g1[i] * sigmoid_f(g1[i]) * u1[i] * w; }
                u32x4 o; o.x = cvt_pk_bf16(r[0], r[1]); o.y = cvt_pk_bf16(r[2], r[3]); o.z = cvt_pk_bf16(r[4], r[5]); o.w = cvt_pk_bf16(r[6], r[7]);
                *(u32x4*)(ACT + R * 512 + col0) = o; }
    }
};
struct EpiDown {
    static constexpr bool PERM = true, AFTER_DRAIN = false;
    bf16_t* Y; const int* rowtok; int ntok;
    __device__ __forceinline__ void operator()(const f32x4 (&acc)[2][2][4][2], const Unit& u, int wr, int wc, int fr, int fq) const {
        const int row0 = u.pm * BM + wr * 64 + fr, col0 = (u.pn & 7) * BM + wc * 32 + 8 * fq;
#pragma unroll
        for (int ai = 0; ai < 2; ++ai)
#pragma unroll
            for (int m = 0; m < 4; ++m) { const int tk = rowtok[row0 + ai * HALF + m * 16];
                if (tk >= 0) { bf16_t* yp = Y + ((size_t)(tk & 1) * ntok + (size_t)(tk >> 1)) * 2048 + col0;
#pragma unroll
                    for (int bj = 0; bj < 2; ++bj) { const f32x4 v0 = acc[ai][bj][m][0], v1 = acc[ai][bj][m][1];
                        u32x4 o; o.x = cvt_pk_bf16(v0[0], v0[1]); o.y = cvt_pk_bf16(v0[2], v0[3]); o.z = cvt_pk_bf16(v1[0], v1[1]); o.w = cvt_pk_bf16(v1[2], v1[3]);
                        *(u32x4*)(yp + bj * HALF) = o; } } }
    }
};
struct MoeOrder {
    const PG8_LAS int* tile_e; int ntiles, ncol, G, c, rep;
    __device__ __forceinline__ bool next(int i, Unit& u) const {
        const long L = (long)(i / rep) * G + c; if (L >= (long)ntiles * ncol) return false;
        const int rt = (int)(L / ncol), pl = (int)(L % ncol); u.pm = rt; u.pn = __builtin_amdgcn_readfirstlane(tile_e[rt]) * ncol + pl; return true;
    }
    __device__ __forceinline__ void a_ready(const Unit&) const {}
    __device__ __forceinline__ void done(const Unit&) const {}
};

template <class Epi, class Sched, bool ALIGN_EPI = false, bool SP2 = false>
__device__ __forceinline__ void gemm_phase(PG8_LAS unsigned char* lds, const Gemm g, const Sched& S, const Epi& E) {
    int tid_ = threadIdx.x; asm volatile("" : "+v"(tid_));
    const int tid = tid_, wid = __builtin_amdgcn_readfirstlane(tid >> 6), lane = tid & 63, wr = wid >> 2, wc = wid & 3, fr = lane & 15, fq = lane >> 4;
    const int K = g.K, nt = K / BK;
    unsigned voffA[2], voffB[2];
#pragma unroll
    for (int i = 0; i < 2; ++i) { int R, C; stage_rc(tid * 16 + i * 8192, R, C); const int Rb = Epi::PERM ? ((R & ~31) + perm32(R & 31)) : R;
        voffA[i] = (unsigned)(R * K + C) * 2u; voffB[i] = (unsigned)(Rb * K + C) * 2u; }
    const size_t kstep = (size_t)(BK * 2);
    const size_t hstep = (size_t)HALF * K * 2;
    const size_t tstep = 2 * hstep;
    const unsigned ldsw = (unsigned)wid * 1024u;
    const int aoff = lds_byte(wr * 64 + fr, fq * 8), boff = lds_byte(wc * 32 + fr, fq * 8);
#define PG8_SA(b, h) (((b) * 2 + (h)) * HTB)
#define PG8_SB(b, h) ((4 + (b) * 2 + (h)) * HTB)
#define PG8_STAGE(bufoff, gbase, voff) do { _Pragma("unroll") for (int _i = 0; _i < 2; ++_i) \
        __builtin_amdgcn_global_load_lds((const unsigned*)((const char*)(gbase) + (voff)[_i]), (PG8_LAS unsigned*)(lds + (bufoff) + ldsw + _i * 8192), 16, 0, 0); } while (0)
#define PG8_LDA(dst, b, h) do { _Pragma("unroll") for (int m = 0; m < 4; ++m) _Pragma("unroll") for (int k = 0; k < 2; ++k) dst[m][k] = *(const PG8_LAS bf16x8*)(lds + PG8_SA(b, h) + aoff + m * 2048 + k * 1024); } while (0)
#define PG8_LDB(dst, b, h) do { _Pragma("unroll") for (int n = 0; n < 2; ++n) _Pragma("unroll") for (int k = 0; k < 2; ++k) dst[n][k] = *(const PG8_LAS bf16x8*)(lds + PG8_SB(b, h) + boff + n * 2048 + k * 1024); } while (0)
#define PG8_MMA(ai, bj, At, Bt) do { __builtin_amdgcn_s_setprio(1); _Pragma("unroll") for (int m = 0; m < 4; ++m) _Pragma("unroll") for (int n = 0; n < 2; ++n) _Pragma("unroll") for (int k = 0; k < 2; ++k) \
        acc[ai][bj][m][n] = __builtin_amdgcn_mfma_f32_16x16x32_bf16(Bt[n][k], At[m][k], acc[ai][bj][m][n], 0, 0, 0); __builtin_amdgcn_s_setprio(0); } while (0)
#define PG8_WAIT_V(n) asm volatile("s_waitcnt vmcnt(" #n ")" ::: "memory")
#define PG8_WAIT_L(n) asm volatile("s_waitcnt lgkmcnt(" #n ")" ::: "memory")
#define PG8_BAR __builtin_amdgcn_s_barrier()
#define PG8_SCHED __builtin_amdgcn_sched_barrier(0)
    Unit cur, nxt; int ui = 0;
    if (!S.next(0, cur)) return;
    f32x4 acc[2][2][4][2];
#pragma unroll
    for (int a = 0; a < 2; ++a)
#pragma unroll
        for (int b = 0; b < 2; ++b)
#pragma unroll
            for (int m = 0; m < 4; ++m)
#pragma unroll
                for (int n = 0; n < 2; ++n) acc[a][b][m][n] = (f32x4){0.f, 0.f, 0.f, 0.f};
    bf16x8 At[4][2], B0[2][2], B1[2][2];
    const char* cA = (const char*)g.A + (size_t)cur.pm * tstep; const char* cB = (const char*)g.Bt + (size_t)cur.pn * tstep;
    S.a_ready(cur);
    if constexpr (SP2) {
        PG8_STAGE(PG8_SB(0, 0), cB, voffB); PG8_STAGE(PG8_SB(0, 1), cB + hstep, voffB); PG8_STAGE(PG8_SA(0, 0), cA, voffA); PG8_STAGE(PG8_SA(0, 1), cA + hstep, voffA);
        if (wr == 1) PG8_BAR;
        PG8_WAIT_V(2); PG8_BAR;
        PG8_STAGE(PG8_SB(1, 0), cB + kstep, voffB); PG8_STAGE(PG8_SA(1, 0), cA + kstep, voffA); PG8_STAGE(PG8_SB(1, 1), cB + hstep + kstep, voffB);
        PG8_WAIT_V(6); PG8_BAR;
    } else {
        PG8_STAGE(PG8_SB(0, 0), cB, voffB); PG8_STAGE(PG8_SA(0, 0), cA, voffA); PG8_STAGE(PG8_SB(0, 1), cB + hstep, voffB); PG8_STAGE(PG8_SA(0, 1), cA + hstep, voffA);
        if (wr == 1) PG8_BAR;
        PG8_WAIT_V(4); PG8_BAR;
        PG8_STAGE(PG8_SB(1, 0), cB + kstep, voffB); PG8_STAGE(PG8_SA(1, 0), cA + kstep, voffA); PG8_STAGE(PG8_SB(1, 1), cB + hstep + kstep, voffB);
        PG8_WAIT_V(6); PG8_BAR;
    }
    for (;;) {
        const bool has_next = S.next(ui + 1, nxt);
        const char* nA = has_next ? (const char*)g.A + (size_t)nxt.pm * tstep : cA; const char* nB = has_next ? (const char*)g.Bt + (size_t)nxt.pn * tstep : cB;
        for (int t = 0; t < nt; t += 2) {
            const bool last = (t == nt - 2);
            const char* a1 = cA + (size_t)(t + 1) * kstep;
            const char* a2 = last ? nA : cA + (size_t)(t + 2) * kstep; const char* b2 = last ? nB : cB + (size_t)(t + 2) * kstep;
            const char* a3 = a2 + kstep; const char* b3 = b2 + kstep;
            if (last && has_next) S.a_ready(nxt);
            if constexpr (SP2) {
            PG8_LDB(B0, 0, 0); PG8_LDB(B1, 0, 1); PG8_SCHED; PG8_LDA(At, 0, 0); PG8_STAGE(PG8_SA(1, 1), a1 + hstep, voffA);
            PG8_WAIT_V(8); PG8_WAIT_L(0); PG8_BAR; PG8_MMA(0, 0, At, B0); PG8_MMA(0, 1, At, B1); PG8_BAR; PG8_SCHED;
            PG8_LDA(At, 0, 1); PG8_STAGE(PG8_SB(0, 0), b2, voffB); PG8_STAGE(PG8_SB(0, 1), b2 + hstep, voffB); PG8_STAGE(PG8_SA(0, 0), a2, voffA);
            PG8_WAIT_V(8); PG8_WAIT_L(0); PG8_BAR; PG8_MMA(1, 0, At, B0); PG8_MMA(1, 1, At, B1); PG8_BAR; PG8_SCHED;
            PG8_LDB(B0, 1, 0); PG8_LDB(B1, 1, 1); PG8_SCHED; PG8_LDA(At, 1, 0); PG8_STAGE(PG8_SA(0, 1), a2 + hstep, voffA);
            PG8_WAIT_V(8); PG8_WAIT_L(0); PG8_BAR; PG8_MMA(0, 0, At, B0); PG8_MMA(0, 1, At, B1); PG8_BAR; PG8_SCHED;
            PG8_LDA(At, 1, 1); PG8_STAGE(PG8_SB(1, 0), b3, voffB); PG8_STAGE(PG8_SB(1, 1), b3 + hstep, voffB); PG8_STAGE(PG8_SA(1, 0), a3, voffA);
            PG8_WAIT_V(8); PG8_WAIT_L(0); PG8_BAR; PG8_MMA(1, 0, At, B0); PG8_MMA(1, 1, At, B1); PG8_BAR; PG8_SCHED;
            } else {
            PG8_LDB(B0, 0, 0); PG8_SCHED; PG8_LDA(At, 0, 0); PG8_STAGE(PG8_SA(1, 1), a1 + hstep, voffA);
            PG8_WAIT_L(8); PG8_BAR; PG8_WAIT_L(0); PG8_MMA(0, 0, At, B0); PG8_BAR; PG8_SCHED;
            PG8_LDB(B1, 0, 1); PG8_STAGE(PG8_SB(0, 0), b2, voffB);
            PG8_BAR; PG8_WAIT_L(0); PG8_MMA(0, 1, At, B1); PG8_BAR;
            PG8_LDA(At, 0, 1); PG8_STAGE(PG8_SA(0, 0), a2, voffA);
            PG8_BAR; PG8_WAIT_L(0); PG8_MMA(1, 0, At, B0); PG8_BAR; PG8_SCHED;
            PG8_STAGE(PG8_SB(0, 1), b2 + hstep, voffB);
            PG8_WAIT_V(6); PG8_BAR; PG8_MMA(1, 1, At, B1); PG8_BAR;
            PG8_LDB(B0, 1, 0); PG8_SCHED; PG8_LDA(At, 1, 0); PG8_STAGE(PG8_SA(0, 1), a2 + hstep, voffA);
            PG8_WAIT_L(8); PG8_BAR; PG8_WAIT_L(0); PG8_MMA(0, 0, At, B0); PG8_BAR; PG8_SCHED;
            PG8_LDB(B1, 1, 1); PG8_STAGE(PG8_SB(1, 0), b3, voffB);
            PG8_BAR; PG8_WAIT_L(0); PG8_MMA(0, 1, At, B1); PG8_BAR;
            PG8_LDA(At, 1, 1); PG8_STAGE(PG8_SA(1, 0), a3, voffA);
            PG8_BAR; PG8_WAIT_L(0); PG8_MMA(1, 0, At, B0); PG8_BAR; PG8_SCHED;
            PG8_STAGE(PG8_SB(1, 1), b3 + hstep, voffB);
            PG8_WAIT_V(6); PG8_BAR; PG8_MMA(1, 1, At, B1); PG8_BAR;
            }
        }
        if constexpr (ALIGN_EPI) { if (wr == 0) PG8_BAR; }
        if constexpr (!Epi::AFTER_DRAIN) { E(acc, cur, wr, wc, fr, fq); S.done(cur); }
        if (!has_next) break;
#pragma unroll
        for (int a = 0; a < 2; ++a)
#pragma unroll
            for (int b = 0; b < 2; ++b)
#pragma unroll
                for (int m = 0; m < 4; ++m)
#pragma unroll
                    for (int n = 0; n < 2; ++n) acc[a][b][m][n] = (f32x4){0.f, 0.f, 0.f, 0.f};
        cur = nxt; cA = nA; cB = nB; ++ui;
        if constexpr (ALIGN_EPI) { if (wr == 1) PG8_BAR; }
    }
    PG8_WAIT_V(0);
    if constexpr (!ALIGN_EPI) { if (wr == 0) PG8_BAR; }
    PG8_BAR;
    if constexpr (Epi::AFTER_DRAIN) { E.fused(acc, cur, wr, wc, fr, fq, lds, wid, lane); S.done(cur); }
#undef PG8_SA
#undef PG8_SB
#undef PG8_STAGE
#undef PG8_LDA
#undef PG8_LDB
#undef PG8_MMA
#undef PG8_WAIT_V
#undef PG8_WAIT_L
#undef PG8_BAR
#undef PG8_SCHED
}
}

#ifndef PG8_SP2
#define PG8_SP2 true
#endif
#ifndef PG8_ALIGN
#define PG8_ALIGN true
#endif
#include <hip/hip_bf16.h>
#include <cmath>
namespace attn_body {
using bf16=__hip_bfloat16;
using bf16x8=__attribute__((ext_vector_type(8)))short;
using s16x4=__attribute__((ext_vector_type(4)))short;
using f32x16=__attribute__((ext_vector_type(16)))float;
using u32x4=__attribute__((ext_vector_type(4)))unsigned;
constexpr int BATCH=2,NHEAD=16,SEQ=4096,D=64,DM=NHEAD*D,QP=9984,KP=9984,VP=9984,OP=1024,GQA=4;
constexpr int NW=8,QBLK=32,QB=QBLK*NW,KVBLK=64,NQB=SEQ/QB;
constexpr int ATTN_UNIT_ROWS=QB;
__device__ __forceinline__ int crow(int r,int hi){return (r&3)+8*(r>>2)+4*hi;}
#define SBAR() __builtin_amdgcn_sched_barrier(0)
__device__ __forceinline__ void cmask(f32x16&p0,f32x16&p1,int jb,int qrel,int hi){
  const float NEG=-INFINITY; int kb=64*jb+4*hi;
  #pragma unroll
  for(int r=0;r<16;++r){int kv=kb+(r&3)+8*(r>>2); if(kv>qrel)p0[r]=NEG; if(kv+32>qrel)p1[r]=NEG;}
}

constexpr int NSLOT=3, SLOTB=8192;
constexpr int LDS_K=0, LDS_V=NSLOT*SLOTB, LDS_WS=2*NSLOT*SLOTB, LDS_OST=LDS_WS+NW*64*4, LDS_MK=LDS_OST+NW*4096, LDS_BYTES=LDS_MK+NW*4096;
constexpr float C2=0.125f*1.4426950408889634f;
__device__ __forceinline__ void glds16(const void*gsrc,unsigned lds_dst){unsigned keep;
  asm volatile("s_mov_b32 %0, m0\n\ts_mov_b32 m0, %2\n\ts_nop 0\n\tglobal_load_lds_dwordx4 %1, off\n\ts_mov_b32 m0, %0":"=&s"(keep):"v"(gsrc),"s"(lds_dst):"memory");}
__device__ __forceinline__ float max3f(float a,float b,float c){float r;asm("v_max3_f32 %0, %1, %2, %3":"=v"(r):"v"(a),"v"(b),"v"(c));return r;}
__device__ __forceinline__ float max2f(float a,float b){float r;asm("v_max_f32_e32 %0, %1, %2":"=v"(r):"v"(a),"v"(b));return r;}
__device__ __forceinline__ float fadd_s(float a,float b){float r;asm("v_add_f32_e32 %0, %1, %2":"=v"(r):"v"(a),"v"(b));return r;}
__device__ __forceinline__ float fsub_s(float a,float b){float r;asm("v_sub_f32_e32 %0, %1, %2":"=v"(r):"v"(a),"v"(b));return r;}
typedef float f32x2_t __attribute__((ext_vector_type(2))); typedef __bf16 bf16x2_t __attribute__((ext_vector_type(2)));
__device__ __forceinline__ unsigned cvtpk_s(float lo,float hi){f32x2_t v={lo,hi};bf16x2_t b=__builtin_convertvector(v,bf16x2_t);return __builtin_bit_cast(unsigned,b);}
#define WAIT_BAR(N) asm volatile("s_waitcnt vmcnt(" #N ") lgkmcnt(0)\n\ts_barrier":::"memory")

__device__ __forceinline__ void qkt(f32x16&p0,f32x16&p1,const char*Kslot,const bf16x8*qr,const f32x16&negm,int r32,int hi){
  const char*kb=Kslot+hi*1024+r32*16;
  #pragma unroll
  for(int d0=0;d0<4;++d0){
    const bf16x8 b0=*reinterpret_cast<const bf16x8*>(kb+d0*2048);
    const bf16x8 b1=*reinterpret_cast<const bf16x8*>(kb+d0*2048+512);
    if(d0==0){p0=__builtin_amdgcn_mfma_f32_32x32x16_bf16(b0,qr[0],negm,0,0,0);p1=__builtin_amdgcn_mfma_f32_32x32x16_bf16(b1,qr[0],negm,0,0,0);}
    else{p0=__builtin_amdgcn_mfma_f32_32x32x16_bf16(b0,qr[d0],p0,0,0,0);p1=__builtin_amdgcn_mfma_f32_32x32x16_bf16(b1,qr[d0],p1,0,0,0);}}
}
typedef __attribute__((address_space(3))) const char* lds_cptr;
typedef short v4i16_t __attribute__((ext_vector_type(4)));
__device__ __forceinline__ void kload8(bf16x8*kf,lds_cptr kp){
  kf[0]=*(const __attribute__((address_space(3))) bf16x8*)(kp);      kf[1]=*(const __attribute__((address_space(3))) bf16x8*)(kp+512);
  kf[2]=*(const __attribute__((address_space(3))) bf16x8*)(kp+2048); kf[3]=*(const __attribute__((address_space(3))) bf16x8*)(kp+2560);
  kf[4]=*(const __attribute__((address_space(3))) bf16x8*)(kp+4096); kf[5]=*(const __attribute__((address_space(3))) bf16x8*)(kp+4608);
  kf[6]=*(const __attribute__((address_space(3))) bf16x8*)(kp+6144); kf[7]=*(const __attribute__((address_space(3))) bf16x8*)(kp+6656);
}
__device__ __forceinline__ void kload2(bf16x8*kf,lds_cptr kp,int j){ kf[2*j]=*(const __attribute__((address_space(3))) bf16x8*)(kp+j*2048); kf[2*j+1]=*(const __attribute__((address_space(3))) bf16x8*)(kp+j*2048+512); }
__device__ __forceinline__ s16x4 vtr(lds_cptr p){ return __builtin_bit_cast(s16x4,__builtin_amdgcn_ds_read_tr16_b64_v4i16((__attribute__((address_space(3))) v4i16_t*)p)); }
template<int BIT> __device__ __forceinline__ float mand_asm(float x,unsigned m){ int t; asm("v_bfe_i32 %0, %1, %2, 1":"=v"(t):"v"(m),"i"(BIT)); float y; asm("v_and_b32 %0, %1, %2":"=v"(y):"v"(t),"v"(x)); return y; }
__device__ __forceinline__ float rowmax(const f32x16&p0,const f32x16&p1){
  float a=max3f(p0[0],p0[1],p1[0]),b=max3f(p0[2],p0[3],p1[1]);a=max3f(a,p1[2],p1[3]);
  #pragma unroll
  for(int r=4;r<16;r+=4){a=max3f(a,p0[r],p0[r+1]);b=max3f(b,p0[r+2],p0[r+3]);a=max3f(a,p1[r],p1[r+1]);b=max3f(b,p1[r+2],p1[r+3]);}
  const float m=max2f(a,b);
  auto rr=__builtin_amdgcn_permlane32_swap(__float_as_uint(m),__float_as_uint(m),false,false);
  return max2f(__uint_as_float(rr[0]),__uint_as_float(rr[1]));
}
__device__ __forceinline__ void pv(f32x16*o,int vb,bf16x8 pa0,bf16x8 pa1,bf16x8 pa2,bf16x8 pa3){
  #pragma unroll
  for(int d0=0;d0<2;++d0){s16x4 lo[4],hi[4];
    #pragma unroll
    for(int ks=0;ks<4;++ks){
      asm volatile("ds_read_b64_tr_b16 %0,%1 offset:%c2":"=&v"(lo[ks]):"v"(vb),"i"(d0*4096+ks*1024):"memory");
      asm volatile("ds_read_b64_tr_b16 %0,%1 offset:%c2":"=&v"(hi[ks]):"v"(vb),"i"(d0*4096+ks*1024+512):"memory");}
    asm volatile("s_waitcnt lgkmcnt(0)":::"memory");SBAR();
    #define PK(k) (bf16x8){lo[k][0],lo[k][1],lo[k][2],lo[k][3],hi[k][0],hi[k][1],hi[k][2],hi[k][3]}
    o[d0]=__builtin_amdgcn_mfma_f32_32x32x16_bf16(pa0,PK(0),o[d0],0,0,0);
    o[d0]=__builtin_amdgcn_mfma_f32_32x32x16_bf16(pa1,PK(1),o[d0],0,0,0);
    o[d0]=__builtin_amdgcn_mfma_f32_32x32x16_bf16(pa2,PK(2),o[d0],0,0,0);
    o[d0]=__builtin_amdgcn_mfma_f32_32x32x16_bf16(pa3,PK(3),o[d0],0,0,0);
    #undef PK
  }
}

#ifndef ATTN_STORE16
#define ATTN_STORE16(p,v) (*(u32x4*)(p)=(v))
#endif
template<int THRL> __device__ __forceinline__ void attn_unit(int b,int h,int qb,const bf16*Q,const bf16*__restrict__ K,const bf16*__restrict__ V,bf16*O,const unsigned long long*__restrict__ MK,char*shm){
  int tid_=threadIdx.x; asm volatile("":"+v"(tid_)); const int tid=tid_,lane=tid&63,r32=lane&31,hi=lane>>5; const int wid=__builtin_amdgcn_readfirstlane(tid>>6);
  const long rowbase=(long)b*SEQ; const int q0=qb*QB;
  const bf16*Qw=Q+(rowbase+q0+wid*QBLK)*QP+h*D;
  const bf16*Kh=K+rowbase*KP+(h/GQA)*D,*Vh=V+rowbase*VP+(h/GQA)*D;
  const unsigned lds0=(unsigned)(uintptr_t)shm;
  float*wsf=(float*)(shm+LDS_WS)+wid*64;
  const bf16*ksrc=Kh+(long)lane*KP+wid*8;
  const bf16*vsrc=Vh+(long)(16*(wid&3)+(lane>>2))*VP+(wid>>2)*32+(lane&3)*8;
  const unsigned kdst=lds0+LDS_K+wid*1024, vdst=lds0+LDS_V+wid*1024;
  #define DMA_K(t,slot) glds16(ksrc+(long)(t)*KVBLK*KP,(unsigned)__builtin_amdgcn_readfirstlane(kdst+(slot)))
  #define DMA_V(t,slot) glds16(vsrc+(long)(t)*KVBLK*VP,(unsigned)__builtin_amdgcn_readfirstlane(vdst+(slot)))
  const int vb0=(int)(lds0+LDS_V)+((lane>>4)&1)*32+(lane&3)*8+(4*hi+((lane&15)>>2))*64;
  const char*Kbase=shm+LDS_K; bf16x8 kf[8];
  const lds_cptr shm3=(lds_cptr)shm; const lds_cptr kp0=shm3+LDS_K+hi*1024+r32*16; const lds_cptr vp0=shm3+LDS_V+((lane>>4)&1)*32+(lane&3)*8+(4*hi+((lane&15)>>2))*64;
  const int NT=(q0+QB)/KVBLK;
  DMA_K(0,0);DMA_V(0,0);DMA_K(1,SLOTB);
  bf16x8 qr[4];
  #pragma unroll
  for(int d0=0;d0<4;++d0)qr[d0]=*reinterpret_cast<const bf16x8*>(&Qw[(long)r32*QP+d0*16+hi*8]);
  float mhat=0.f,l_reg=0.f;f32x16 o[2];o[0]=f32x16{};o[1]=f32x16{};const f32x16 negm=f32x16{};
  const int qrel=wid*QBLK+r32; (void)qrel;
  const unsigned long long*MKw=MK+((size_t)(rowbase+q0+wid*QBLK))*64;
  typedef __attribute__((address_space(3))) unsigned long long lds_u64;
  lds_u64*mks=(lds_u64*)((lds_cptr)shm+LDS_MK+wid*4096);
  #define MK_REFILL(t0) do{ _Pragma("unroll") for(int i_=0;i_<4;++i_){ const int idx_=i_*64+lane, q_=idx_>>3, pr_=idx_&7; \
      const u32x4 w_=*(const u32x4*)(MKw+(size_t)q_*64+(t0)+2*pr_); \
      mks[(2*pr_)*32+q_]=((unsigned long long)w_.y<<32)|w_.x; mks[(2*pr_+1)*32+q_]=((unsigned long long)w_.w<<32)|w_.z; } }while(0)
  #define MK_LOAD(t,ML,MH) do{ if(((t)&15)==0){ MK_REFILL(t); } const unsigned long long mw_=mks[((t)&15)*32+r32]; ML=(unsigned)mw_>>(4*hi); MH=(unsigned)(mw_>>32)>>(4*hi); }while(0)
  #define MKB(r) (((r)&3)+8*((r)>>2))
  #define MAND(x,M,r) __builtin_bit_cast(float,__builtin_bit_cast(unsigned,(x))&(unsigned)__builtin_amdgcn_sbfe((int)(M),MKB(r),1))
  unsigned mlo,mhi;
  #define CMASK(P0,P1,t) do{}while(0)
  bool resc=false;
  #define START(P0,P1) do{ const float rm=rowmax(P0,P1); resc=false; \
    { const float dl=rm; mhat=fadd_s(mhat,dl); \
      _Pragma("unroll") for(int r=0;r<16;++r){P0[r]=fsub_s(P0[r],dl);P1[r]=fsub_s(P1[r],dl);} \
      } \
    _Pragma("unroll") for(int r=0;r<16;++r)P0[r]=MAND(__builtin_amdgcn_exp2f(P0[r]),mlo,r); }while(0)
  #define RESC() do{ if(resc){ asm volatile("s_waitcnt lgkmcnt(0)":::"memory"); \
      _Pragma("unroll") for(int d_=0;d_<2;++d_) _Pragma("unroll") for(int r=0;r<16;++r)o[d_][r]*=wsf[crow(r,hi)]; } }while(0)
  f32x16 pA0,pA1,pB0,pB1;
  int sl_prev=0,sl_cur=0,sl_next=SLOTB;
  #define ROT() do{sl_prev=sl_cur;sl_cur=sl_next;sl_next=(sl_next==(NSLOT-1)*SLOTB)?0:sl_next+SLOTB;}while(0)
  DMA_K(2,2*SLOTB);
  WAIT_BAR(3);
  qkt(pA0,pA1,Kbase,qr,negm,r32,hi);asm volatile("s_nop 15\n\ts_nop 7":"+v"(pA0),"+v"(pA1));CMASK(pA0,pA1,0);
  MK_LOAD(0,mlo,mhi);
  START(pA0,pA1);
  _Pragma("unroll") for(int r=0;r<16;++r)pA1[r]=MAND(__builtin_amdgcn_exp2f(pA1[r]),mhi,r);
  WAIT_BAR(0);
  DMA_K(3,0);DMA_V(1,SLOTB);
  ROT();
  kload8(kf,kp0+sl_cur);
  WAIT_BAR(2);
  s16x4 vlo[8],vhi[8]; u32x4 pw0,pw1,pw2,pw3;
  #define PKW(P,B) cvtpk_s(P[B],P[B+1])
  #define PAF(k) __builtin_bit_cast(bf16x8,pw##k)
  #define VFR(i) (bf16x8){vlo[i][0],vlo[i][1],vlo[i][2],vlo[i][3],vhi[i][0],vhi[i][1],vhi[i][2],vhi[i][3]}
  #define PIN(x) asm volatile("":"+v"(x))
  #define MX3(a,b,c) __builtin_fmaxf(__builtin_fmaxf((a),(b)),(c))
  #define GAPA(MF,A0,A1,A2,A3,W0,W1,PW) do{ MF; sacc+=A0; sacc+=A1; sacc+=A2; sacc+=A3; PIN(sacc); W0; W1; PIN(PW); SBAR(); }while(0)
  #define EX(v) __builtin_amdgcn_exp2f(v)
  #define MANDA(x,M,r) mand_asm<MKB(r)>((x),(M))
  #define GAPB(MF,X,B,M) do{ MF; X[B]=MANDA(EX(X[B]),M,B); X[B+1]=MANDA(EX(X[B+1]),M,B+1); X[B+2]=MANDA(EX(X[B+2]),M,B+2); X[B+3]=MANDA(EX(X[B+3]),M,B+3); PIN(X); SBAR(); }while(0)
  #define VRD(i) do{ vlo[i]=vtr(vp_+(((i)>>2)*4096+((i)&3)*1024)); vhi[i]=vtr(vp_+(((i)>>2)*4096+((i)&3)*1024+512)); }while(0)
  #define KRD(G,j) do{ if(G){ kload2(kf,kp0+sl_next,j); SBAR(); } }while(0)
  #define STEP(C0,C1,P0,P1,t,GK,GV,GL) do{ SBAR(); MK_LOAD(t,mlo,mhi); SBAR(); \
    const lds_cptr vp_=vp0+sl_prev; \
    VRD(0); SBAR(); float sacc=(P0[0]+P0[1]); \
    GAPA(C0=__builtin_amdgcn_mfma_f32_32x32x16_bf16(kf[0],qr[0],negm,0,0,0), P0[2],P0[3],P0[4],P0[5],     pw0[0]=PKW(P0,0), pw0[1]=PKW(P0,2), pw0); \
    VRD(4); SBAR(); GAPA(C1=__builtin_amdgcn_mfma_f32_32x32x16_bf16(kf[1],qr[0],negm,0,0,0), P0[6],P0[7],P0[8],P0[9],     pw0[2]=PKW(P0,4), pw0[3]=PKW(P0,6), pw0); \
    VRD(1); SBAR(); GAPA(C0=__builtin_amdgcn_mfma_f32_32x32x16_bf16(kf[2],qr[1],C0,0,0,0),   P0[10],P0[11],P0[12],P0[13], pw1[0]=PKW(P0,8), pw1[1]=PKW(P0,10), pw1); \
    VRD(5); SBAR(); GAPA(C1=__builtin_amdgcn_mfma_f32_32x32x16_bf16(kf[3],qr[1],C1,0,0,0),   P0[14],P0[15],P1[0],P1[1],   pw1[2]=PKW(P0,12),pw1[3]=PKW(P0,14), pw1); \
    VRD(2); SBAR(); GAPA(C0=__builtin_amdgcn_mfma_f32_32x32x16_bf16(kf[4],qr[2],C0,0,0,0),   P1[2],P1[3],P1[4],P1[5],     pw2[0]=PKW(P1,0), pw2[1]=PKW(P1,2), pw2); \
    VRD(6); SBAR(); GAPA(C1=__builtin_amdgcn_mfma_f32_32x32x16_bf16(kf[5],qr[2],C1,0,0,0),   P1[6],P1[7],P1[8],P1[9],     pw2[2]=PKW(P1,4), pw2[3]=PKW(P1,6), pw2); \
    VRD(3); SBAR(); GAPA(C0=__builtin_amdgcn_mfma_f32_32x32x16_bf16(kf[6],qr[3],C0,0,0,0),   P1[10],P1[11],P1[12],P1[13], pw3[0]=PKW(P1,8), pw3[1]=PKW(P1,10), pw3); \
    VRD(7); SBAR(); GAPA(C1=__builtin_amdgcn_mfma_f32_32x32x16_bf16(kf[7],qr[3],C1,0,0,0),   P1[14],P1[15],0.f,0.f,       pw3[2]=PKW(P1,12),pw3[3]=PKW(P1,14), pw3); \
    l_reg+=sacc; \
    if(GK){DMA_K((t)+3,sl_cur);} if(GV){DMA_V((t)+1,sl_next);} \
    { const float nm_=-mhat; _Pragma("unroll") for(int r=0;r<16;++r){C0[r]+=nm_;C1[r]+=nm_;} } \
    { float a=MX3(C0[0],C0[1],C1[0]),b=MX3(C0[2],C0[3],C1[1]); a=MX3(a,C1[2],C1[3]); \
      _Pragma("unroll") for(int r=4;r<16;r+=4){a=MX3(a,C0[r],C0[r+1]);b=MX3(b,C0[r+2],C0[r+3]);a=MX3(a,C1[r],C1[r+1]);b=MX3(b,C1[r+2],C1[r+3]);} \
      float rm=__builtin_fmaxf(a,b); { auto rr=__builtin_amdgcn_permlane32_swap(__float_as_uint(rm),__float_as_uint(rm),false,false); rm=__builtin_fmaxf(__uint_as_float(rr[0]),__uint_as_float(rr[1])); } \
      resc=false; \
      if(__builtin_expect(__any(rm>(float)THRL),0)){ const float dl=__builtin_fmaxf(rm,0.f); mhat+=dl; \
        _Pragma("unroll") for(int r=0;r<16;++r){C0[r]-=dl;C1[r]-=dl;} \
        const float f=__builtin_amdgcn_exp2f(-dl); l_reg*=f; if(hi==0)wsf[r32]=f; resc=true; } } \
    SBAR(); \
    GAPB(o[0]=__builtin_amdgcn_mfma_f32_32x32x16_bf16(PAF(0),VFR(0),o[0],0,0,0), C0,0,mlo); \
    GAPB(o[1]=__builtin_amdgcn_mfma_f32_32x32x16_bf16(PAF(0),VFR(4),o[1],0,0,0), C0,4,mlo); \
    KRD(GL,0); GAPB(o[0]=__builtin_amdgcn_mfma_f32_32x32x16_bf16(PAF(1),VFR(1),o[0],0,0,0), C0,8,mlo); \
    KRD(GL,1); GAPB(o[1]=__builtin_amdgcn_mfma_f32_32x32x16_bf16(PAF(1),VFR(5),o[1],0,0,0), C0,12,mlo); \
    KRD(GL,2); GAPB(o[0]=__builtin_amdgcn_mfma_f32_32x32x16_bf16(PAF(2),VFR(2),o[0],0,0,0), C1,0,mhi); \
    KRD(GL,3); GAPB(o[1]=__builtin_amdgcn_mfma_f32_32x32x16_bf16(PAF(2),VFR(6),o[1],0,0,0), C1,4,mhi); \
    GAPB(o[0]=__builtin_amdgcn_mfma_f32_32x32x16_bf16(PAF(3),VFR(3),o[0],0,0,0), C1,8,mhi); \
    GAPB(o[1]=__builtin_amdgcn_mfma_f32_32x32x16_bf16(PAF(3),VFR(7),o[1],0,0,0), C1,12,mhi); \
    }while(0)
  int t=1;
  #undef CMASK
  #define CMASK(P0,P1,t) do{}while(0)
  for(;t+5<NT;t+=2){
    STEP(pB0,pB1,pA0,pA1,t,true,true,true);     WAIT_BAR(2); RESC(); ROT();
    STEP(pA0,pA1,pB0,pB1,t+1,true,true,true);   WAIT_BAR(2); RESC(); ROT();
  }
  #undef CMASK
  #define CMASK(P0,P1,t) do{}while(0)
  #define ENDW(tt) do{ if((tt)+3<NT){WAIT_BAR(2);} else if((tt)+2<NT){WAIT_BAR(1);} else {WAIT_BAR(0);} }while(0)
  for(;t+1<NT;t+=2){
    STEP(pB0,pB1,pA0,pA1,t,(t+3<NT),(t+1<NT),(t+1<NT));       ENDW(t);   RESC(); ROT();
    STEP(pA0,pA1,pB0,pB1,t+1,(t+4<NT),(t+2<NT),(t+2<NT));     ENDW(t+1); RESC(); ROT();
  }
  STEP(pB0,pB1,pA0,pA1,NT-1,false,false,false); RESC();
  { float sacc=pB0[0]+pB0[1]; _Pragma("unroll") for(int r=2;r<16;++r)sacc+=pB0[r]; _Pragma("unroll") for(int r=0;r<16;++r)sacc+=pB1[r]; l_reg+=sacc;
    pw0=(u32x4){PKW(pB0,0),PKW(pB0,2),PKW(pB0,4),PKW(pB0,6)};pw1=(u32x4){PKW(pB0,8),PKW(pB0,10),PKW(pB0,12),PKW(pB0,14)};pw2=(u32x4){PKW(pB1,0),PKW(pB1,2),PKW(pB1,4),PKW(pB1,6)};pw3=(u32x4){PKW(pB1,8),PKW(pB1,10),PKW(pB1,12),PKW(pB1,14)};
    SBAR(); pv(o,vb0+sl_cur,PAF(0),PAF(1),PAF(2),PAF(3)); }
  #undef PKW
  #undef PAF
  #undef VFR
  #undef PIN
  #undef MX3
  #undef GAPA
  #undef GAPB
  #undef EX
  #undef VRD
  #undef KRD
  #undef STEP
  #undef ENDW
  {auto rr=__builtin_amdgcn_permlane32_swap(__float_as_uint(l_reg),__float_as_uint(l_reg),false,false);l_reg=__uint_as_float(rr[0])+__uint_as_float(rr[1]);}
  if(hi==0)wsf[32+r32]=l_reg;asm volatile("s_waitcnt lgkmcnt(0)":::"memory");
  float rli[16];
  #pragma unroll
  for(int r=0;r<16;++r)rli[r]=__builtin_amdgcn_rcpf(wsf[32+crow(r,hi)]);
  bf16*Ow=O+(rowbase+q0+wid*QBLK)*OP+h*D;
  { bf16*stg=(bf16*)(shm+LDS_OST)+wid*2048;
    #pragma unroll
    for(int r=0;r<16;++r){const int orow=crow(r,hi);
      #pragma unroll
      for(int d0=0;d0<2;++d0)stg[orow*64+d0*32+r32]=__float2bfloat16(o[d0][r]*rli[r]);}
    asm volatile("s_waitcnt lgkmcnt(0)":::"memory");
    #pragma unroll
    for(int i=0;i<4;++i){const int row=i*8+(lane>>3),ch=lane&7; const u32x4 v=*(const u32x4*)(stg+row*64+ch*8); ATTN_STORE16(Ow+(long)row*OP+ch*8,v);} }
  asm volatile("s_waitcnt lgkmcnt(0)\n\ts_barrier":::"memory");
  #undef DMA_K
  #undef MK_REFILL
  #undef MK_LOAD
  #undef MKB
  #undef MAND
  #undef DMA_V
  #undef CMASK
  #undef START
  #undef RESC
  #undef ROT
}
constexpr int ATTN_LDS_BYTES=LDS_BYTES;
struct AttnTensors { const bf16* Q; const bf16* K; const bf16* V; bf16* O; const unsigned long long* MK; };
struct AttnUnit { int bh; int qb; };
struct StaticOrder {
  int vcu;
  __device__ __forceinline__ explicit StaticOrder(int grid,int block):vcu((grid%8==0)?(block%8)*(grid/8)+block/8:block),G(grid){}
  int G,rep=1;
  __device__ __forceinline__ bool next(int i,AttnUnit&u)const{ const int L=(i/rep)*G+vcu; if(L>=512)return false; const int s=L&7; u.bh=(L&255)>>3; u.qb=(L<256)?s:15-s; return true; }
  __device__ __forceinline__ void a_ready(const AttnUnit&)const{}
  __device__ __forceinline__ void done(const AttnUnit&)const{}
};
template<class Sched,int THRL=8> __device__ __forceinline__ void attn_phase(char*lds,const AttnTensors&T,const Sched&S){
  AttnUnit u;
  for(int i=0;S.next(i,u);++i){ S.a_ready(u); attn_unit<THRL>(u.bh/NHEAD,u.bh%NHEAD,u.qb,T.Q,T.K,T.V,T.O,T.MK,lds); S.done(u); }
}
#undef SBAR
#undef WAIT_BAR
}
constexpr int NWAVES = 8;
#ifndef MK_N_LAUNCHES
#define MK_N_LAUNCHES 1
#endif
constexpr int N_LAUNCHES = MK_N_LAUNCHES;

constexpr int D = 2048, BATCH = 2, SEQ = 4096, M = BATCH * SEQ;
constexpr int NHEAD = 16, HD = 64, NKV = 4, IDXH = 16, IDXD = 64, TOPK = 256;
constexpr int NE = 32, EPG = 8, NGRP = 4, FF = 512;
constexpr int NPROJ = 9808, NP = 9984;
constexpr int C_Q = 0, C_K = 1024, C_V = 1280, C_IQ = 1536, C_IK = 2560, C_IW = 2624, C_BG = 2640, C_CG = 3664, C_XC = 4688, C_GA = 5712, C_GB = 7760;
constexpr int NMOD = 6 * D;
constexpr float EPS = 1e-6f;
constexpr int ROWCAP = 24576;
constexpr int MAXTILES = ROWCAP / 256;

constexpr size_t MiB = 1u << 20;
constexpr size_t WS_CTL = 0, CTL_ZERO_BYTES = 65536;
constexpr size_t WS_MOD = 1 * MiB;
constexpr size_t WS_ROWTOK = 2 * MiB;
constexpr size_t WS_ROWW = 3 * MiB;
constexpr size_t WS_ROWTOK2 = 4 * MiB;
constexpr size_t WS_ROWW2 = 4 * MiB + 512 * 1024;
constexpr size_t WS_LOGIT = 5 * MiB;
constexpr size_t WS_MASK = 8 * MiB;
constexpr size_t WS_WMIX = 12 * MiB;
constexpr size_t WS_WR = 28 * MiB;
constexpr size_t WS_WIN = 32 * MiB;
constexpr size_t WS_OA = 32 * MiB, WS_CB = 48 * MiB;
constexpr size_t WS_WGU = 72 * MiB;
constexpr size_t WS_WDN = 200 * MiB;
constexpr size_t WS_H = 264 * MiB;
constexpr size_t WS_PROJ = 296 * MiB;
constexpr size_t WS_HS = 296 * MiB;
constexpr size_t WS_ACT = 392 * MiB;
constexpr size_t WS_SCORE = 452 * MiB;
constexpr size_t WS_MERGED = 452 * MiB;
constexpr size_t WS_Y = 484 * MiB;
constexpr size_t WS_END = 580 * MiB;
static_assert(WS_WIN + (size_t)NP * D * 2 <= WS_WGU && WS_PROJ + (size_t)M * NP * 2 <= WS_SCORE && WS_ACT + (size_t)ROWCAP * FF * 2 <= WS_SCORE && WS_Y + (size_t)2 * M * D * 2 <= WS_END, "d_ws map");
constexpr int CW_CNT = 64;
constexpr int CW_BAR = 4096;

constexpr int RING_OFF = 0, RING_BYTES = 131072;
constexpr int LDSCTL_OFF = RING_BYTES, MISC_OFF = LDSCTL_OFF + 320;
constexpr int TILEE_OFF = RING_BYTES + 1024;
constexpr int LDS_BYTES = 147456;
static_assert(MISC_OFF + 128 <= TILEE_OFF && TILEE_OFF + 1024 <= LDS_BYTES, "LDS map");

#define GAS __attribute__((address_space(1)))
#define LAS __attribute__((address_space(3)))
typedef unsigned short bf16;
typedef unsigned v4u __attribute__((ext_vector_type(4)));
typedef float f32x4 __attribute__((ext_vector_type(4)));
typedef short bf16x8 __attribute__((ext_vector_type(8)));
typedef GAS unsigned gu32;
typedef GAS unsigned long long gu64;
#define RLX_AGENT __ATOMIC_RELAXED, __HIP_MEMORY_SCOPE_AGENT
#define LDS_WAIT() asm volatile("s_waitcnt lgkmcnt(0)" ::: "memory")
#define VM_WAIT() asm volatile("s_waitcnt vmcnt(0)" ::: "memory")
__device__ __forceinline__ unsigned long long rt() { return __builtin_amdgcn_s_memrealtime(); }
__device__ __forceinline__ unsigned f2bf(float f) { unsigned u = __builtin_bit_cast(unsigned, f); return (u + 0x7fffu + ((u >> 16) & 1u)) >> 16; }
__device__ __forceinline__ unsigned pk2(float lo, float hi) { return f2bf(lo) | (f2bf(hi) << 16); }

#define XB_TMO      128
#define XB_XCNT(j)  (256  + 64 * (j))
#define XB_XSUB(j)  (1280 + 64 * (j))
#define XB_XGEN(j)  (2304 + 64 * (j))
#define XB_TOP      3328
#define XB_TOPGEN   3392
#define XCD_BAR_WORDS 3456
#define XB_SPIN_CAP (1u << 18)

__device__ __forceinline__ unsigned xb_ld(unsigned* p)              { return __hip_atomic_load(p, __ATOMIC_RELAXED, __HIP_MEMORY_SCOPE_AGENT); }
__device__ __forceinline__ unsigned xb_add(unsigned* p, unsigned v) { return __hip_atomic_fetch_add(p, v, __ATOMIC_RELAXED, __HIP_MEMORY_SCOPE_AGENT); }
__device__ __forceinline__ unsigned xb_xcc_id() { return (unsigned)__builtin_amdgcn_s_getreg((3 << 11) | 20) & 0xFu; }
#define XB_SPIN(cond, bar) do { unsigned _sp = 0; while (cond) { __builtin_amdgcn_s_sleep(1); \
    if ((++_sp & 255u) == 0u) { if (xb_ld(&(bar)[XB_TMO])) break; if (_sp > XB_SPIN_CAP) { atomicAdd(&(bar)[XB_TMO], 1u); break; } } } } while (0)

struct XcdBarrier {
    unsigned* bar; unsigned x;
    volatile LAS unsigned* st;
};

__device__ __forceinline__ XcdBarrier xcd_barrier_post(unsigned* bar, volatile LAS unsigned* st) {
    XcdBarrier b; b.bar = bar; b.x = xb_xcc_id(); b.st = st;
    if (threadIdx.x == 0) (void)xb_add(&bar[XB_XCNT(b.x)], 1u);
    return b;
}
__device__ __forceinline__ void xcd_barrier_complete(unsigned* bar, unsigned x, unsigned& nloc, unsigned& nx) {
    const unsigned G = gridDim.x * gridDim.y * gridDim.z;
    unsigned sum, cnt, mine, sp = 0u;
    for (;;) {
        sum = 0u; cnt = 0u; mine = 0u;
#pragma unroll
        for (unsigned j = 0; j < 16; ++j) { const unsigned c = xb_ld(&bar[XB_XCNT(j)]); sum += c; cnt += (c > 0u) ? 1u : 0u; mine = (j == x) ? c : mine; }
        if (sum == G) break;
        __builtin_amdgcn_s_sleep(1);
        if ((++sp & 255u) == 0u) { if (xb_ld(&bar[XB_TMO])) break; if (sp > XB_SPIN_CAP) { atomicAdd(&bar[XB_TMO], 1u); break; } }
    }
    nloc = mine > 0u ? mine : 1u; nx = cnt > 0u ? cnt : 1u;
}

__device__ __forceinline__ void xcd_barrier(const XcdBarrier& b) {
    asm volatile("s_waitcnt vmcnt(0)" ::: "memory");
    __syncthreads();
    if (threadIdx.x == 0) {
        unsigned* bar = b.bar; unsigned bx = b.x;
        asm volatile("" : "+s"(bar), "+s"(bx));
        __builtin_amdgcn_s_waitcnt(0);
        unsigned nloc = b.st[0], nx = b.st[1];
        if (nloc == 0u) { xcd_barrier_complete(bar, bx, nloc, nx); b.st[0] = nloc; b.st[1] = nx; }
        const unsigned old = xb_add(&bar[XB_XSUB(bx)], 1u);
        const unsigned gen = old / nloc;
        if (old + 1u == (gen + 1u) * nloc) {
            __builtin_amdgcn_fence(__ATOMIC_RELEASE, "agent");
            asm volatile("s_waitcnt vmcnt(0)" ::: "memory");
            const unsigned og = xb_add(&bar[XB_TOP], 1u);
            const unsigned tg = og / nx;
            if (og + 1u == (tg + 1u) * nx) xb_add(&bar[XB_TOPGEN], 1u);
            else XB_SPIN(xb_ld(&bar[XB_TOPGEN]) == tg, bar);
            __builtin_amdgcn_fence(__ATOMIC_ACQUIRE, "agent");
            xb_add(&bar[XB_XGEN(bx)], 1u);
            asm volatile("s_waitcnt vmcnt(0)" ::: "memory");
        } else {
            XB_SPIN(xb_ld(&bar[XB_XGEN(bx)]) == gen, bar);
            __builtin_amdgcn_fence(__ATOMIC_ACQUIRE, "agent");
            asm volatile("s_waitcnt vmcnt(0)" ::: "memory");
        }
    }
    __syncthreads();
}
struct Frame {
    LAS unsigned char* lds;
    volatile LAS unsigned* MISC;
    gu32* ctl;
    int tid, lane, wave;
    int vcu, G;
    unsigned char* ws;
};
struct Args { const float* in[19]; float* out; unsigned char* ws; int ph_lo, ph_hi, rep_mask, pad; };
__device__ __forceinline__ const float* ld_in(const Args& a, int i) { asm volatile("" : "+s"(i)); return a.in[i]; }
__device__ __forceinline__ unsigned char* ld_ws(const Args& a) { int i = 0; asm volatile("" : "+s"(i)); return (&a.ws)[i]; }
enum { I_X = 0, I_C, I_WADA, I_BADA, I_GMIX, I_WIN, I_CONVW, I_WAUP, I_WBOUT, I_WO, I_GFFN, I_WRG, I_BRG, I_WRE, I_BRE, I_WEG, I_WEU, I_WED, I_GFIN };

__device__ __forceinline__ float wave_sum(float v) {
#pragma unroll
    for (int o = 1; o < 64; o <<= 1) v += __shfl_xor(v, o);
    return v;
}
__device__ __forceinline__ float bfu_lo(unsigned w) { return __builtin_bit_cast(float, w << 16); }
__device__ __forceinline__ float bfu_hi(unsigned w) { return __builtin_bit_cast(float, w & 0xffff0000u); }

__device__ __forceinline__ void p0_mod(Frame& F, const Args& A) {
    LAS float* sc = (LAS float*)(F.lds);
    LAS float* red = (LAS float*)(F.lds + 16384);
    const float* c = ld_in(A, I_C); const float* W = ld_in(A, I_WADA); const float* bias = ld_in(A, I_BADA);
    float* mod = (float*)(F.ws + WS_MOD);
    for (int i = F.tid; i < 2 * D; i += NWAVES * 64) { const float v = c[i]; sc[i] = v / (1.0f + __expf(-v)); }
    __syncthreads();
    const int cq = F.tid % 12, rr = F.tid / 12;
    for (int cg = F.vcu; cg < NMOD / 48; cg += F.G) {
        f32x4 a0 = {0.f, 0.f, 0.f, 0.f}, a1 = {0.f, 0.f, 0.f, 0.f};
        if (rr < 42) {
            const float* wp = W + (size_t)cg * 48 + cq * 4;
#pragma unroll 8
            for (int k = rr; k < D; k += 42) { const f32x4 w = *(const f32x4*)(wp + (size_t)k * NMOD); a0 += sc[k] * w; a1 += sc[D + k] * w; }
#pragma unroll
            for (int i = 0; i < 4; ++i) { red[rr * 96 + cq * 4 + i] = a0[i]; red[rr * 96 + 48 + cq * 4 + i] = a1[i]; }
        }
        __syncthreads();
        if (F.tid < 96) { const int b = F.tid / 48, col = F.tid % 48; float s = 0.f;
            for (int r = 0; r < 42; ++r) s += red[r * 96 + F.tid];
            mod[(size_t)b * NMOD + cg * 48 + col] = s + bias[cg * 48 + col]; }
        __syncthreads();
    }
}
__device__ __forceinline__ void p0_transpose_item(const float* W, int N, bf16* WT, int wt_pitch, int dst_row0, LAS float* scr, int kb, int nb, int lane) {
    const int k0 = 64 * kb, n0 = 32 * nb; const int cq = lane & 7, rr = lane >> 3; const bool cv = n0 + 4 * cq < N;
    f32x4 v[8];
#pragma unroll
    for (int i = 0; i < 8; ++i) v[i] = cv ? *(const GAS f32x4*)(W + (size_t)(k0 + rr + 8 * i) * N + n0 + 4 * cq) : (f32x4){0.f, 0.f, 0.f, 0.f};
#pragma unroll
    for (int i = 0; i < 8; ++i) { LAS float* d = scr + (rr + 8 * i) * 33 + 4 * cq; d[0] = v[i].x; d[1] = v[i].y; d[2] = v[i].z; d[3] = v[i].w; }
    LDS_WAIT(); asm volatile("" ::: "memory");
    const int c = lane & 7;
#pragma unroll
    for (int j = 0; j < 4; ++j) { const int n = (lane >> 3) + 8 * j; const LAS float* s = scr + (8 * c) * 33 + n;
        v4u o; o.x = pk2(s[0 * 33], s[1 * 33]); o.y = pk2(s[2 * 33], s[3 * 33]); o.z = pk2(s[4 * 33], s[5 * 33]); o.w = pk2(s[6 * 33], s[7 * 33]);
        if (n0 + n < N) *(GAS v4u*)(WT + (size_t)(dst_row0 + n) * wt_pitch + k0 + 8 * c) = o; }
    LDS_WAIT(); asm volatile("" ::: "memory");
}
__device__ __forceinline__ void p0_weights(Frame& F, const Args& A, int rep) {
    LAS float* scr = (LAS float*)(F.lds + 32768 + F.wave * 8704);
    const int gw = F.vcu * NWAVES + F.wave, NGW = F.G * NWAVES;
    bf16* WT_in = (bf16*)(F.ws + WS_WIN); bf16* WT_aup = (bf16*)(F.ws + WS_WMIX); bf16* WT_bout = WT_aup + (size_t)D * 1024; bf16* WT_o = WT_bout + (size_t)D * 1024;
    bf16* WT_gu = (bf16*)(F.ws + WS_WGU); bf16* WT_dn = (bf16*)(F.ws + WS_WDN);
    constexpr int NB_IN = (NPROJ + 31) / 32;
    constexpr int I_IN = 32 * NB_IN, I_A = 16 * 64, I_B = 16 * 64, I_O = 32 * 64, I_G = NE * 32 * 16, I_U = I_G, I_D = NE * 8 * 64;
    constexpr int NITEMS = I_IN + I_A + I_B + I_O + I_G + I_U + I_D;
    for (int it = gw; it < NITEMS * rep; it += NGW) {
        int r = it >= NITEMS ? it - NITEMS : it;
        if (r < I_IN) { const int kb = r / NB_IN, nb = r % NB_IN; p0_transpose_item(ld_in(A, I_WIN), NPROJ, WT_in, D, 32 * nb, scr, kb, nb, F.lane); continue; } r -= I_IN;
        if (r < I_A) { const int kb = r / 64, nb = r % 64; p0_transpose_item(ld_in(A, I_WAUP), D, WT_aup, 1024, 32 * nb, scr, kb, nb, F.lane); continue; } r -= I_A;
        if (r < I_B) { const int kb = r / 64, nb = r % 64; p0_transpose_item(ld_in(A, I_WBOUT), D, WT_bout, 1024, 32 * nb, scr, kb, nb, F.lane); continue; } r -= I_B;
        if (r < I_O) { const int kb = r / 64, nb = r % 64; p0_transpose_item(ld_in(A, I_WO), D, WT_o, D, 32 * nb, scr, kb, nb, F.lane); continue; } r -= I_O;
        if (r < I_G + I_U) { const int up = r >= I_G; if (up) r -= I_G; const int e = r / 512, q = r % 512, kb = q / 16, nb = q % 16, n0 = 32 * nb;
            p0_transpose_item(ld_in(A, up ? I_WEU : I_WEG) + (size_t)e * D * FF, FF, WT_gu, D, e * 1024 + (n0 >> 7) * 256 + up * 128 + (n0 & 127), scr, kb, nb, F.lane); continue; } r -= I_G + I_U;
        { const int e = r / 512, q = r % 512, kb = q / 64, nb = q % 64;
            p0_transpose_item(ld_in(A, I_WED) + (size_t)e * FF * D, D, WT_dn, FF, e * D + 32 * nb, scr, kb, nb, F.lane); }
    }
    bf16* WR = (bf16*)(F.ws + WS_WR); const float* wrg = ld_in(A, I_WRG); const float* wre = ld_in(A, I_WRE);
    for (int i = F.vcu * (NWAVES * 64) + F.tid; i < 64 * D; i += F.G * NWAVES * 64) { const int n = i / D, k = i % D;
        const float v = n < 4 ? wrg[k * 4 + n] : (n < 36 ? wre[k * 32 + (n - 4)] : 0.f); WR[i] = (bf16)f2bf(v); }
}
__device__ __forceinline__ void row_norm_mod_bf16(const float* xrow, const float* g, const float* sc, const float* sh, bf16* orow, int lane) {
    const GAS f32x4* xr = (const GAS f32x4*)xrow + lane; f32x4 v[8]; float s = 0.f;
#pragma unroll
    for (int j = 0; j < 8; ++j) { v[j] = xr[64 * j]; s += (v[j].x * v[j].x + v[j].y * v[j].y) + (v[j].z * v[j].z + v[j].w * v[j].w); }
    const float r = 1.0f / sqrtf(wave_sum(s) * (1.0f / D) + EPS);
    GAS unsigned long long* o8 = (GAS unsigned long long*)orow + lane;
#pragma unroll
    for (int j = 0; j < 8; ++j) { const f32x4 gg = ((const GAS f32x4*)g)[lane + 64 * j], ss = ((const GAS f32x4*)sc)[lane + 64 * j], hh = ((const GAS f32x4*)sh)[lane + 64 * j];
        const f32x4 o = (v[j] * r) * gg * (1.0f + ss) + hh;
        o8[64 * j] = (unsigned long long)pk2(o.x, o.y) | ((unsigned long long)pk2(o.z, o.w) << 32); }
}
__device__ __forceinline__ void p_norm_rows(Frame& F, const Args& A, const float* X, const float* g, int which, int rep) {
    const int gw = F.vcu * NWAVES + F.wave, NGW = F.G * NWAVES;
    const float* mod = (const float*)(F.ws + WS_MOD); bf16* H = (bf16*)(F.ws + WS_H);
    for (int mm = gw; mm < M * rep; mm += NGW) { const int m = mm & (M - 1); const float* mb = mod + (size_t)(m / SEQ) * NMOD + which * 3 * D;
        row_norm_mod_bf16(X + (size_t)m * D, g, mb + D, mb, H + (size_t)m * D, F.lane); }
}
__device__ __forceinline__ void p4_select_row(const float* srow, unsigned long long* mrow, int t, int lane) {
    unsigned key[64];
    const int ng = (t >> 9) + 1;
#pragma unroll
    for (int j = 0; j < 64; ++j) {
        unsigned k = 0u;
        if ((j >> 3) < ng) { const int idx = j * 64 + lane; if (idx <= t) { const unsigned u = __builtin_bit_cast(unsigned, srow[idx]); k = (u & 0x80000000u) ? ~u : (u | 0x80000000u); } }
        key[j] = k;
    }
    unsigned thr = 1u;
    if (t >= TOPK) {
        unsigned prefix = 0u;
        for (int bit = 31; bit >= 0; --bit) {
            const unsigned cand = prefix | (1u << bit); unsigned c = 0u;
#pragma unroll
            for (int g = 0; g < 8; ++g) { if (g < ng) {
#pragma unroll
                for (int j = 8 * g; j < 8 * g + 8; ++j) c += key[j] >= cand ? 1u : 0u; } }
            unsigned cnt = 0u;
#pragma unroll
            for (int q = 0; q < 7; ++q) cnt += (unsigned)__popcll(__ballot((c >> q) & 1u)) << q;
            if (cnt >= (unsigned)TOPK) { prefix = cand; if (cnt == (unsigned)TOPK) break; }
        }
        thr = prefix;
    }
    unsigned mlo = 0u, mhi = 0u;
#define P4_WL1(j) { const unsigned long long bm_ = __ballot(key[j] >= thr); const unsigned bl_ = (unsigned)bm_, bh_ = (unsigned)(bm_ >> 32); \
        asm volatile("s_nop 3\n\tv_writelane_b32 %0, %1, %2" : "+v"(mlo) : "s"(bl_), "i"(j)); asm volatile("s_nop 3\n\tv_writelane_b32 %0, %1, %2" : "+v"(mhi) : "s"(bh_), "i"(j)); }
#define P4_WL4(j) P4_WL1(j) P4_WL1((j) + 1) P4_WL1((j) + 2) P4_WL1((j) + 3)
#define P4_WL16(j) P4_WL4(j) P4_WL4((j) + 4) P4_WL4((j) + 8) P4_WL4((j) + 12)
    P4_WL16(0) P4_WL16(16) P4_WL16(32) P4_WL16(48)
#undef P4_WL16
#undef P4_WL4
#undef P4_WL1
    mrow[lane] = ((unsigned long long)mhi << 32) | mlo;
}
__device__ __forceinline__ void p4_select_own(Frame& F, const Args& A, int pair) {
    const float* S = (const float*)(F.ws + WS_SCORE); unsigned long long* MK = (unsigned long long*)(F.ws + WS_MASK);
    const int b = pair >> 7, p = pair & 127; int lane = F.lane; asm volatile("" : "+v"(lane));
#pragma unroll 1
    for (int z = 0; z < 4; ++z) { const int qb = (z & 1) ? 255 - p : p; const int t = qb * 16 + 2 * F.wave + (z >> 1); const size_t row = (size_t)b * SEQ + t;
        p4_select_row(S + row * SEQ, MK + row * 64, t, lane); }
}
__device__ __forceinline__ void p3_scores(Frame& F, const Args& A, int rep) {
    const bf16* P = (const bf16*)(F.ws + WS_PROJ); float* S = (float*)(F.ws + WS_SCORE);
    const int c16 = F.lane & 15, kq = F.lane >> 4;
    for (int pp = F.vcu; pp < 256 * rep; pp += F.G) { const int pair = pp & 255;
        const int b = pair >> 7, p = pair & 127;
#pragma unroll 1
        for (int z = 0; z < 2; ++z) {
            const int qb = z == 0 ? p : 255 - p;
            const size_t qrow = (size_t)b * SEQ + qb * 16 + c16;
            const bf16* qp = P + qrow * NP;
            bf16x8 bq[IDXH][2]; float w[IDXH];
#pragma unroll
            for (int h = 0; h < IDXH; ++h)
#pragma unroll
                for (int ks = 0; ks < 2; ++ks) bq[h][ks] = *(const bf16x8*)(qp + C_IQ + h * 64 + ks * 32 + kq * 8);
            { const v4u w0 = *(const v4u*)(qp + C_IW), w1 = *(const v4u*)(qp + C_IW + 8);
                w[0] = bfu_lo(w0.x); w[1] = bfu_hi(w0.x); w[2] = bfu_lo(w0.y); w[3] = bfu_hi(w0.y); w[4] = bfu_lo(w0.z); w[5] = bfu_hi(w0.z); w[6] = bfu_lo(w0.w); w[7] = bfu_hi(w0.w);
                w[8] = bfu_lo(w1.x); w[9] = bfu_hi(w1.x); w[10] = bfu_lo(w1.y); w[11] = bfu_hi(w1.y); w[12] = bfu_lo(w1.z); w[13] = bfu_hi(w1.z); w[14] = bfu_lo(w1.w); w[15] = bfu_hi(w1.w); }
            float* srow = S + qrow * SEQ + kq * 4;
            const bf16* kbase = P + ((size_t)b * SEQ + c16) * NP + C_IK + kq * 8;
            int kt = F.wave;
            bf16x8 a0 = {0, 0, 0, 0, 0, 0, 0, 0}, a1 = a0;
            if (kt <= qb) { const bf16* kp = kbase + (size_t)kt * 16 * NP; a0 = *(const bf16x8*)kp; a1 = *(const bf16x8*)(kp + 32); }
            for (; kt <= qb; kt += 8) {
                bf16x8 n0 = a0, n1 = a1;
                if (kt + 8 <= qb) { const bf16* kp = kbase + (size_t)(kt + 8) * 16 * NP; n0 = *(const bf16x8*)kp; n1 = *(const bf16x8*)(kp + 32); }
                f32x4 sc = {0.f, 0.f, 0.f, 0.f};
#pragma unroll
                for (int h = 0; h < IDXH; ++h) {
                    f32x4 acc = {0.f, 0.f, 0.f, 0.f};
                    acc = __builtin_amdgcn_mfma_f32_16x16x32_bf16(a0, bq[h][0], acc, 0, 0, 0);
                    acc = __builtin_amdgcn_mfma_f32_16x16x32_bf16(a1, bq[h][1], acc, 0, 0, 0);
#pragma unroll
                    for (int i = 0; i < 4; ++i) sc[i] += w[h] * fmaxf(acc[i], 0.f);
                }
                *(f32x4*)(srow + kt * 16) = sc;
                a0 = n0; a1 = n1;
            }
        }
        __syncthreads();
        p4_select_own(F, A, pair);
        __syncthreads();
    }
}
__device__ __forceinline__ void p3_conv(Frame& F, const Args& A, int rep) {
    const bf16* P = (const bf16*)(F.ws + WS_PROJ); bf16* CB = (bf16*)(F.ws + WS_CB); const float* cw = ld_in(A, I_CONVW);
    const int nthr = F.G * NWAVES * 64;
    for (int ii = F.vcu * (NWAVES * 64) + F.tid; ii < M * 128 * rep; ii += nthr) { const int idx = ii & (M * 128 - 1);
        const int t = idx >> 7, ch = (idx & 127) * 8, tl = t & (SEQ - 1);
        float acc[8] = {0.f, 0.f, 0.f, 0.f, 0.f, 0.f, 0.f, 0.f};
#pragma unroll
        for (int j = 0; j < 3; ++j) { if (tl - 2 + j >= 0) { const bf16* rp = P + (size_t)(t - 2 + j) * NP;
            const v4u cg = *(const v4u*)(rp + C_CG + ch), xc = *(const v4u*)(rp + C_XC + ch);
            const f32x4 w0 = *(const f32x4*)(cw + j * 1024 + ch), w1 = *(const f32x4*)(cw + j * 1024 + ch + 4);
            acc[0] += w0.x * (bfu_lo(cg.x) * bfu_lo(xc.x)); acc[1] += w0.y * (bfu_hi(cg.x) * bfu_hi(xc.x)); acc[2] += w0.z * (bfu_lo(cg.y) * bfu_lo(xc.y)); acc[3] += w0.w * (bfu_hi(cg.y) * bfu_hi(xc.y));
            acc[4] += w1.x * (bfu_lo(cg.z) * bfu_lo(xc.z)); acc[5] += w1.y * (bfu_hi(cg.z) * bfu_hi(xc.z)); acc[6] += w1.z * (bfu_lo(cg.w) * bfu_lo(xc.w)); acc[7] += w1.w * (bfu_hi(cg.w) * bfu_hi(xc.w)); } }
        const v4u bg = *(const v4u*)(P + (size_t)t * NP + C_BG + ch);
        v4u o; o.x = pk2(bfu_lo(bg.x) * acc[0], bfu_hi(bg.x) * acc[1]); o.y = pk2(bfu_lo(bg.y) * acc[2], bfu_hi(bg.y) * acc[3]);
        o.z = pk2(bfu_lo(bg.z) * acc[4], bfu_hi(bg.z) * acc[5]); o.w = pk2(bfu_lo(bg.w) * acc[6], bfu_hi(bg.w) * acc[7]);
        *(v4u*)(CB + (size_t)t * 1024 + ch) = o;
    }
}
__device__ __forceinline__ void p7_norm_route(Frame& F, const Args& A) {
    const float* mod = (const float*)(F.ws + WS_MOD); bf16* H = (bf16*)(F.ws + WS_H); const bf16* WR = (const bf16*)(F.ws + WS_WR);
    const float* X2 = A.out; const float* gffn = ld_in(A, I_GFFN); const float* brg = ld_in(A, I_BRG); const float* bre = ld_in(A, I_BRE);
    int* rowtok = (int*)(F.ws + WS_ROWTOK); float* roww = (float*)(F.ws + WS_ROWW);
    LAS float* part = (LAS float*)(F.lds);
    const int grp = F.wave >> 2, q = F.wave & 3, c16 = F.lane & 15, kq = F.lane >> 4;
    for (int blk = F.vcu; blk < M / 32; blk += F.G) {
        const int row0 = blk * 32 + grp * 16;
#pragma unroll 1
        for (int i = 0; i < 4; ++i) { const int m = row0 + q * 4 + i; const float* mb = mod + (size_t)(m / SEQ) * NMOD + 3 * D;
            row_norm_mod_bf16(X2 + (size_t)m * D, gffn, mb + D, mb, H + (size_t)m * D, F.lane); }
        __syncthreads();
        f32x4 acc[3] = {{0.f, 0.f, 0.f, 0.f}, {0.f, 0.f, 0.f, 0.f}, {0.f, 0.f, 0.f, 0.f}};
        const bf16* ap = H + (size_t)(row0 + c16) * D + q * 512 + kq * 8; const bf16* bp = WR + (size_t)c16 * D + q * 512 + kq * 8;
#pragma unroll 4
        for (int ks = 0; ks < 16; ++ks) { const bf16x8 a = *(const bf16x8*)(ap + ks * 32);
#pragma unroll
            for (int n = 0; n < 3; ++n) { const bf16x8 bfr = *(const bf16x8*)(bp + (size_t)n * 16 * D + ks * 32); acc[n] = __builtin_amdgcn_mfma_f32_16x16x32_bf16(a, bfr, acc[n], 0, 0, 0); } }
#pragma unroll
        for (int n = 0; n < 3; ++n)
#pragma unroll
            for (int i = 0; i < 4; ++i) part[(F.wave * 16 + kq * 4 + i) * 48 + n * 16 + c16] = acc[n][i];
        __syncthreads();
        if (F.tid < 32) { const int g2 = F.tid >> 4, r = F.tid & 15, t = blk * 32 + F.tid;
            float lg[36];
#pragma unroll
            for (int c = 0; c < 36; ++c) lg[c] = (part[((g2 * 4 + 0) * 16 + r) * 48 + c] + part[((g2 * 4 + 1) * 16 + r) * 48 + c]) + (part[((g2 * 4 + 2) * 16 + r) * 48 + c] + part[((g2 * 4 + 3) * 16 + r) * 48 + c]);
            float gl[NGRP]; int g = 0;
#pragma unroll
            for (int i = 0; i < NGRP; ++i) gl[i] = lg[i] + brg[i];
#pragma unroll
            for (int i = 1; i < NGRP; ++i) if (gl[i] > gl[g]) g = i;
            float den = 0.f;
#pragma unroll
            for (int i = 0; i < NGRP; ++i) den += __expf(gl[i] - gl[g]);
            const float pg = 1.0f / den;
            float v0 = -INFINITY, v1 = -INFINITY; int i0 = 0, i1 = 0;
#pragma unroll
            for (int gg = 0; gg < NGRP; ++gg) { if (gg == g) {
#pragma unroll
                for (int j = 0; j < EPG; ++j) { const float v = lg[4 + gg * EPG + j] + bre[gg * EPG + j];
                    if (v > v0) { v1 = v0; i1 = i0; v0 = v; i0 = j; } else if (v > v1) { v1 = v; i1 = j; } } } }
            const float e1 = __expf(v1 - v0), p0 = 1.0f / (1.0f + e1), p1 = e1 * p0;
            const int ea = g * EPG + i0, eb = g * EPG + i1;
            const unsigned pa = __hip_atomic_fetch_add(F.ctl + CW_CNT + 64 * ea, 1u, __ATOMIC_RELAXED, __HIP_MEMORY_SCOPE_AGENT);
            const unsigned pb = __hip_atomic_fetch_add(F.ctl + CW_CNT + 64 * eb, 1u, __ATOMIC_RELAXED, __HIP_MEMORY_SCOPE_AGENT);
            rowtok[(size_t)ea * M + pa] = t * 2 + 0; roww[(size_t)ea * M + pa] = pg * p0;
            rowtok[(size_t)eb * M + pb] = t * 2 + 1; roww[(size_t)eb * M + pb] = pg * p1;
        }
        __syncthreads();
    }
}
__device__ __forceinline__ void moe_table(Frame& F, const Args& A) {
    LAS int* tb = (LAS int*)(F.lds + TILEE_OFF);
    if (F.tid < NE) tb[200 + F.tid] = (int)__hip_atomic_load(F.ctl + CW_CNT + 64 * F.tid, __ATOMIC_RELAXED, __HIP_MEMORY_SCOPE_AGENT);
    __syncthreads();
    if (F.tid == 0) { int base = 0, nt = 0;
        for (int e = 0; e < NE; ++e) { const int c = tb[200 + e]; const int tl = (c + 255) >> 8;
            tb[128 + e] = base; for (int i = 0; i < tl; ++i) tb[nt + i] = e; nt += tl; base += tl * 256; }
        tb[192] = nt; }
    __syncthreads();
}
__device__ __forceinline__ void p7_gather(Frame& F, const Args& A, int rep) {
    moe_table(F, A);
    const LAS int* tb = (const LAS int*)(F.lds + TILEE_OFF);
    const int nrows = tb[192] * 256; const int gw = F.vcu * NWAVES + F.wave, NGW = F.G * NWAVES;
    const bf16* H = (const bf16*)(F.ws + WS_H); bf16* HS = (bf16*)(F.ws + WS_HS);
    const int* rowtok = (const int*)(F.ws + WS_ROWTOK); const float* roww = (const float*)(F.ws + WS_ROWW);
    int* rowtok2 = (int*)(F.ws + WS_ROWTOK2); float* roww2 = (float*)(F.ws + WS_ROWW2);
    for (int RR = gw; RR < nrows * rep; RR += NGW) { const int R = RR >= nrows ? RR - nrows : RR;
        const int e = tb[R >> 8]; const int i = R - tb[128 + e];
        const int cnt = tb[200 + e];
        if (i < cnt) { const int tk = rowtok[(size_t)e * M + i]; const float w = roww[(size_t)e * M + i];
            const GAS v4u* src = (const GAS v4u*)(H + (size_t)(tk >> 1) * D) + F.lane; GAS v4u* dst = (GAS v4u*)(HS + (size_t)R * D) + F.lane;
#pragma unroll
            for (int j = 0; j < 4; ++j) dst[64 * j] = src[64 * j];
            if (F.lane == 0) { rowtok2[R] = tk; roww2[R] = w; } }
        else { GAS v4u* dst = (GAS v4u*)(HS + (size_t)R * D) + F.lane; const v4u z = {0u, 0u, 0u, 0u};
#pragma unroll
            for (int j = 0; j < 4; ++j) dst[64 * j] = z;
            if (F.lane == 0) { rowtok2[R] = -1; roww2[R] = 0.f; } }
    }
}
__device__ __forceinline__ void p9_final(Frame& F, const Args& A) {
    const int gw = F.vcu * NWAVES + F.wave, NGW = F.G * NWAVES;
    const float* mod = (const float*)(F.ws + WS_MOD); const bf16* Y = (const bf16*)(F.ws + WS_Y); const float* gf = ld_in(A, I_GFIN);
    for (int m = gw; m < M; m += NGW) {
        const float* g2 = mod + (size_t)(m / SEQ) * NMOD + 5 * D;
        GAS f32x4* xr = (GAS f32x4*)(A.out + (size_t)m * D) + F.lane;
        const GAS unsigned long long* y0 = (const GAS unsigned long long*)(Y + (size_t)m * D) + F.lane; const GAS unsigned long long* y1 = (const GAS unsigned long long*)(Y + ((size_t)M + m) * D) + F.lane;
        f32x4 v[8]; float s = 0.f;
#pragma unroll
        for (int j = 0; j < 8; ++j) { const f32x4 x = xr[64 * j]; const f32x4 gg = ((const GAS f32x4*)g2)[F.lane + 64 * j]; const unsigned long long a = y0[64 * j], bq = y1[64 * j];
            const unsigned al = (unsigned)a, ah = (unsigned)(a >> 32), bl = (unsigned)bq, bh = (unsigned)(bq >> 32);
            f32x4 ys; ys.x = bfu_lo(al) + bfu_lo(bl); ys.y = bfu_hi(al) + bfu_hi(bl); ys.z = bfu_lo(ah) + bfu_lo(bh); ys.w = bfu_hi(ah) + bfu_hi(bh);
            v[j] = x + gg * ys; s += (v[j].x * v[j].x + v[j].y * v[j].y) + (v[j].z * v[j].z + v[j].w * v[j].w); }
        const float r = 1.0f / sqrtf(wave_sum(s) * (1.0f / D) + EPS);
#pragma unroll
        for (int j = 0; j < 8; ++j) { const f32x4 gg = ((const GAS f32x4*)gf)[F.lane + 64 * j]; xr[64 * j] = (v[j] * r) * gg; }
    }
}

#ifndef SELFCHECK
#define SELFCHECK 0
#endif
#if SELFCHECK
constexpr size_t WS_CHK = 1 * MiB + 512 * 1024;
__device__ __forceinline__ float bf2f(bf16 v) { return __builtin_bit_cast(float, (unsigned)v << 16); }
__device__ __forceinline__ void p5_check(Frame& F, const Args& A) {
    if (F.wave >= 4) return;
    LAS float* sc = (LAS float*)(F.lds + F.wave * 32768);
    LAS float* iq = sc + 4096;
    LAS float* qv = iq + 1024;
    const bf16* P = (const bf16*)(F.ws + WS_PROJ); const float* S = (const float*)(F.ws + WS_SCORE); const bf16* OAp = (const bf16*)(F.ws + WS_OA);
    unsigned* res = (unsigned*)(F.ws + WS_CHK);
    const int lane = F.lane, sid = F.vcu * 4 + F.wave;
    const int b = sid & 1, h = (sid >> 1) & 15, tsel = sid >> 5;
    const int t = (tsel * 128 + ((h * 37 + b * 11) & 127)) & (SEQ - 1);
    const size_t row = (size_t)b * SEQ + t; const bf16* pr = P + row * NP;
    for (int i = lane; i < 1024; i += 64) iq[i] = bf2f(pr[C_IQ + i]);
    qv[lane] = bf2f(pr[C_Q + h * 64 + lane]);
    if (lane < 16) qv[64 + lane] = bf2f(pr[C_IW + lane]);
    for (int s = lane; s < SEQ; s += 64) sc[s] = s <= t ? S[row * SEQ + s] : -INFINITY;
    LDS_WAIT(); asm volatile("" ::: "memory");
    float e1 = 0.f;
#pragma unroll 1
    for (int s = lane * 8 + (sid & 7); s <= t; s += 512) {
        const bf16* kp = P + ((size_t)b * SEQ + s) * NP + C_IK; float kk[64];
#pragma unroll
        for (int d = 0; d < 64; ++d) kk[d] = bf2f(kp[d]);
        float tot = 0.f, mag = 0.f;
#pragma unroll 1
        for (int hh = 0; hh < 16; ++hh) { float dot = 0.f;
#pragma unroll
            for (int d = 0; d < 64; ++d) dot += iq[hh * 64 + d] * kk[d];
            const float r = fmaxf(dot, 0.f), w = qv[64 + hh]; tot += w * r; mag += fabsf(w) * r; }
        e1 = fmaxf(e1, fabsf(tot - sc[s]) / (mag + 1e-6f));
    }
    float own[64]; int cnt[64];
#pragma unroll
    for (int j = 0; j < 64; ++j) { own[j] = sc[lane + 64 * j]; cnt[j] = 0; }
#pragma clang loop vectorize(disable) interleave(disable) unroll(disable)
    for (int s2 = 0; s2 <= t; ++s2) { const float v = sc[s2];
#pragma unroll
        for (int j = 0; j < 64; ++j) cnt[j] += v > own[j] ? 1 : 0; }
#pragma unroll
    for (int j = 0; j < 64; ++j) sc[lane + 64 * j] = (lane + 64 * j <= t && cnt[j] < TOPK) ? 1.0f : 0.0f;
    LDS_WAIT(); asm volatile("" ::: "memory");
    const int g = h >> 2; float mx = -INFINITY;
#pragma unroll 1
    for (int j = 0; j < 64; ++j) { const int s = lane + 64 * j; float l = -INFINITY;
        if (sc[s] != 0.f) { const bf16* kp = P + ((size_t)b * SEQ + s) * NP + C_K + g * 64; float dot = 0.f;
            for (int d = 0; d < 64; ++d) dot += qv[d] * bf2f(kp[d]);
            l = dot; }
        sc[s] = l; mx = fmaxf(mx, l); }
#pragma unroll
    for (int o = 1; o < 64; o <<= 1) mx = fmaxf(mx, __shfl_xor(mx, o));
    float lsum = 0.f;
    LDS_WAIT(); asm volatile("" ::: "memory");
#pragma unroll 1
    for (int j = 0; j < 64; ++j) { const int s = lane + 64 * j; const float l = sc[s]; const float p = l == -INFINITY ? 0.f : __builtin_amdgcn_exp2f(l - mx); lsum += p; sc[s] = p; }
    lsum = wave_sum(lsum);
    LDS_WAIT(); asm volatile("" ::: "memory");
    float o = 0.f;
#pragma unroll 1
    for (int s = 0; s <= t; ++s) { const float p = sc[s]; if (p != 0.f) o += p * bf2f(P[((size_t)b * SEQ + s) * NP + C_V + g * 64 + lane]); }
    o /= lsum;
    float om = fabsf(o);
#pragma unroll
    for (int x = 1; x < 64; x <<= 1) om = fmaxf(om, __shfl_xor(om, x));
    float e2 = fabsf(o - bf2f(OAp[row * 1024 + h * 64 + lane])) / (om + 1e-20f);
#pragma unroll
    for (int x = 1; x < 64; x <<= 1) { e1 = fmaxf(e1, __shfl_xor(e1, x)); e2 = fmaxf(e2, __shfl_xor(e2, x)); }
    if (lane == 0) { atomicMax(res, __builtin_bit_cast(unsigned, e1)); atomicMax(res + 1, __builtin_bit_cast(unsigned, e2)); }
}
#endif
constexpr int NPHASE = 12;
#ifndef REP_MASK
#define REP_MASK 0x000
#endif
#define NREP(k) (1 + ((rep_mask_ >> (k)) & 1))
__global__ void __launch_bounds__(NWAVES * 64, 2) mk_fwd(Args args) {
    extern __shared__ __attribute__((aligned(16))) unsigned char lds[];
    Frame F;
    F.lds = (LAS unsigned char*)lds;
    F.MISC = (volatile LAS unsigned*)(F.lds + MISC_OFF);
    F.tid = threadIdx.x; F.lane = F.tid & 63; F.wave = __builtin_amdgcn_readfirstlane(F.tid >> 6);
    F.G = gridDim.x; { const int bx = blockIdx.x; F.vcu = (F.G % 8 == 0) ? (bx % 8) * (F.G / 8) + bx / 8 : bx; }
    F.ws = args.ws; F.ctl = (gu32*)(args.ws + WS_CTL);
    const Args& A = args;
    for (int u = F.tid; u < (LDS_BYTES - LDSCTL_OFF) / 4; u += NWAVES * 64) ((LAS unsigned*)(F.lds + LDSCTL_OFF))[u] = 0u;
    __syncthreads();
    XcdBarrier bar; bar.bar = (unsigned*)(F.ctl + CW_BAR); bar.x = 0; bar.st = nullptr;
    if (N_LAUNCHES == 1) bar = xcd_barrier_post((unsigned*)(F.ctl + CW_BAR), F.MISC + 8);
#define GRID_BAR() do { if (N_LAUNCHES == 1) { xcd_barrier(bar); } } while (0)
    const int lo = args.ph_lo, hi = args.ph_hi, rep_mask_ = args.rep_mask;
#ifndef PHMASK
#define PHMASK 0xFFFF
#endif
#define IN(k) (((PHMASK >> (k)) & 1) && lo <= (k) && (k) < hi)
#define BOTH(k) (IN(k) && IN((k) + 1))
#define PHASE_FENCE() do { asm volatile("" : "+v"(F.tid), "+v"(F.lane)); F.ws = ld_ws(A); F.ctl = (gu32*)(F.ws + WS_CTL); } while (0)

#define W_H ((bf16*)(F.ws + WS_H))
#define W_PROJ ((bf16*)(F.ws + WS_PROJ))
#define W_OA ((bf16*)(F.ws + WS_OA))
#define W_CB ((bf16*)(F.ws + WS_CB))
#define W_MERGED ((bf16*)(F.ws + WS_MERGED))
#define W_WT_in ((bf16*)(F.ws + WS_WIN))
#define W_WT_aup ((bf16*)(F.ws + WS_WMIX))
#define W_WT_bout ((bf16*)(F.ws + WS_WMIX + (size_t)D * 1024 * 2))
#define W_WT_o ((bf16*)(F.ws + WS_WMIX + (size_t)D * 1024 * 4))
#define W_WT_gu ((bf16*)(F.ws + WS_WGU))
#define W_WT_dn ((bf16*)(F.ws + WS_WDN))
#define W_WR ((bf16*)(F.ws + WS_WR))
#define W_HS ((bf16*)(F.ws + WS_HS))
#define W_ACT ((bf16*)(F.ws + WS_ACT))
#define W_Y ((bf16*)(F.ws + WS_Y))
#define W_mod ((const float*)(F.ws + WS_MOD))
#define W_ws F.ws

    if (IN(0)) { PHASE_FENCE(); p0_mod(F, A); p0_weights(F, A, NREP(0)); if (BOTH(0)) GRID_BAR(); }
    if (IN(1)) { PHASE_FENCE(); p_norm_rows(F, A, ld_in(A, I_X), ld_in(A, I_GMIX), 0, NREP(1)); if (BOTH(1)) GRID_BAR(); }
    if (IN(2)) { PHASE_FENCE();
        pg8::Gemm g{W_H, W_WT_in, M, NP, D}; pg8::StaticOrder S; S.init(M, NP, F.G, (int)blockIdx.x); S.rep = NREP(2);
        pg8::EpiBf16<0> E{W_PROJ, NP, nullptr, 1024, 1024, attn_body::C2};
        pg8::gemm_phase<pg8::EpiBf16<0>, pg8::StaticOrder, PG8_ALIGN, PG8_SP2>(F.lds + RING_OFF, g, S, E);
        if (BOTH(2)) GRID_BAR();
    }
    if (IN(3)) { PHASE_FENCE(); p3_scores(F, A, NREP(3)); p3_conv(F, A, NREP(3)); if (BOTH(3)) GRID_BAR(); }
    if (IN(4)) { PHASE_FENCE();
        static_assert(attn_body::ATTN_LDS_BYTES <= RING_BYTES, "attention body LDS vs frame");
        const attn_body::AttnTensors AT{(const attn_body::bf16*)(W_PROJ + C_Q), (const attn_body::bf16*)(W_PROJ + C_K), (const attn_body::bf16*)(W_PROJ + C_V), (attn_body::bf16*)W_OA, (const unsigned long long*)(W_ws + WS_MASK)};
        attn_body::StaticOrder S((int)F.G, (int)blockIdx.x); S.rep = NREP(4);
        attn_body::attn_phase<attn_body::StaticOrder>((char*)lds + RING_OFF, AT, S);
#if SELFCHECK
        GRID_BAR(); if (blockIdx.x == 0 && F.tid < 2) ((unsigned*)(F.ws + WS_CHK))[F.tid] = 0u; GRID_BAR(); __syncthreads(); p5_check(F, A); __syncthreads();
#endif
        if (BOTH(4)) GRID_BAR();
    }
    if (IN(5)) { PHASE_FENCE();
        { pg8::Gemm g{W_OA, W_WT_aup, M, D, 1024}; pg8::StaticOrder S; S.init(M, D, F.G, (int)blockIdx.x); S.rep = NREP(5);
          pg8::EpiGate E{W_MERGED, D, W_PROJ, NP, C_GA, 0};
          pg8::gemm_phase<pg8::EpiGate, pg8::StaticOrder, PG8_ALIGN, PG8_SP2>(F.lds + RING_OFF, g, S, E); }
        asm volatile("s_waitcnt vmcnt(0)" ::: "memory"); __syncthreads();
        { pg8::Gemm g{W_CB, W_WT_bout, M, D, 1024}; pg8::StaticOrder S; S.init(M, D, F.G, (int)blockIdx.x);
          pg8::EpiGate E{W_MERGED, D, W_PROJ, NP, C_GB, 1};
          pg8::gemm_phase<pg8::EpiGate, pg8::StaticOrder, PG8_ALIGN, PG8_SP2>(F.lds + RING_OFF, g, S, E); }
        if (BOTH(5)) GRID_BAR();
    }
    if (IN(6)) { PHASE_FENCE();
        pg8::Gemm g{W_MERGED, W_WT_o, M, D, D}; pg8::StaticOrder S; S.init(M, D, F.G, (int)blockIdx.x); S.rep = NREP(6);
        pg8::EpiRes E{ld_in(A, I_X), A.out, W_mod + 2 * D, NMOD, D, SEQ};
        pg8::gemm_phase<pg8::EpiRes, pg8::StaticOrder, PG8_ALIGN, PG8_SP2>(F.lds + RING_OFF, g, S, E);
        if (BOTH(6)) GRID_BAR();
    }
    if (IN(7)) { PHASE_FENCE(); p7_norm_route(F, A); if (BOTH(7)) GRID_BAR(); }
    if (IN(8)) { PHASE_FENCE(); p7_gather(F, A, NREP(8)); if (BOTH(8)) GRID_BAR(); }
    if (IN(9)) { PHASE_FENCE();
        moe_table(F, A); const LAS int* tb = (const LAS int*)(F.lds + TILEE_OFF);
        pg8::Gemm g{W_HS, W_WT_gu, ROWCAP, NE * 1024, D}; pg8::MoeOrder S{tb, __builtin_amdgcn_readfirstlane(tb[192]), 4, F.G, (int)blockIdx.x, NREP(9)};
        pg8::EpiAct E{W_ACT, (const float*)(W_ws + WS_ROWW2)};
        pg8::gemm_phase<pg8::EpiAct, pg8::MoeOrder, PG8_ALIGN, PG8_SP2>(F.lds + RING_OFF, g, S, E);
        if (BOTH(9)) GRID_BAR();
    }
    if (IN(10)) { PHASE_FENCE();
        moe_table(F, A); const LAS int* tb = (const LAS int*)(F.lds + TILEE_OFF);
        pg8::Gemm g{W_ACT, W_WT_dn, ROWCAP, NE * D, FF}; pg8::MoeOrder S{tb, __builtin_amdgcn_readfirstlane(tb[192]), 8, F.G, (int)blockIdx.x, NREP(10)};
        pg8::EpiDown E{W_Y, (const int*)(W_ws + WS_ROWTOK2), M};
        pg8::gemm_phase<pg8::EpiDown, pg8::MoeOrder, PG8_ALIGN, PG8_SP2>(F.lds + RING_OFF, g, S, E);
        if (BOTH(10)) GRID_BAR();
    }
    if (IN(11)) { PHASE_FENCE(); p9_final(F, A);
#if SELFCHECK
        GRID_BAR();
        { const unsigned* res = (const unsigned*)(F.ws + WS_CHK); const float e1 = __builtin_bit_cast(float, __hip_atomic_load(res, __ATOMIC_RELAXED, __HIP_MEMORY_SCOPE_AGENT)), e2 = __builtin_bit_cast(float, __hip_atomic_load(res + 1, __ATOMIC_RELAXED, __HIP_MEMORY_SCOPE_AGENT));
          const float dl = 1.0f + fminf(10.f * e2, 3.f); float* op = A.out;
          for (size_t i = (size_t)F.vcu * (NWAVES * 64) + F.tid; i < (size_t)M * D; i += (size_t)F.G * NWAVES * 64) { float v = op[i] * dl; if (i == 0) v += 20.f + fminf(1e6f * e1, 80.f); op[i] = v; } }
#endif
    }
#undef W_H
#undef W_PROJ
#undef W_OA
#undef W_CB
#undef W_MERGED
#undef W_WT_in
#undef W_WT_aup
#undef W_WT_bout
#undef W_WT_o
#undef W_WT_gu
#undef W_WT_dn
#undef W_WR
#undef W_HS
#undef W_ACT
#undef W_Y
#undef W_mod
#undef W_ws
#undef IN
#undef BOTH
#undef GRID_BAR
}

extern "C" void kernel_launch(void* const* d_in, const int* in_sizes, int n_in, void* d_out, int out_size, void* d_ws, size_t ws_size, hipStream_t stream) {
    static int grid = 0;
    if (grid == 0) {
        if (n_in != 19 || in_sizes[0] != M * D || out_size != M * D || ws_size < WS_END) { fprintf(stderr, "kernel_launch: built for 19 inputs, x/out of %d floats, >= %zu bytes of workspace; got n_in %d, in0 %d, out %d, ws %zu; nothing launched\n", M * D, (size_t)WS_END, n_in, n_in > 0 ? in_sizes[0] : -1, out_size, ws_size); grid = -1; return; }
        int dev = 0, cus = 0, per_cu = 0;
        if (hipGetDevice(&dev) != hipSuccess || hipDeviceGetAttribute(&cus, hipDeviceAttributeMultiprocessorCount, dev) != hipSuccess) { fprintf(stderr, "kernel_launch: hipGetDevice / hipDeviceGetAttribute failed; nothing launched\n"); grid = -1; return; }
        if (hipFuncSetAttribute((const void*)mk_fwd, hipFuncAttributeMaxDynamicSharedMemorySize, LDS_BYTES) != hipSuccess) { fprintf(stderr, "kernel_launch: hipFuncSetAttribute failed\n"); grid = -1; return; }
        if (hipOccupancyMaxActiveBlocksPerMultiprocessor(&per_cu, (const void*)mk_fwd, NWAVES * 64, LDS_BYTES) != hipSuccess || per_cu < 1) { fprintf(stderr, "kernel_launch: occupancy query reports %d workgroups per CU; nothing launched\n", per_cu); (void)hipGetLastError(); grid = -1; return; }
        grid = cus;
    }
    if (grid < 0) return;
    if (hipMemsetAsync((char*)d_ws + WS_CTL, 0, CTL_ZERO_BYTES, stream) != hipSuccess) { fprintf(stderr, "kernel_launch: hipMemsetAsync of the control words failed; nothing launched\n"); return; }
    Args a{};
    for (int i = 0; i < 19; ++i) a.in[i] = (const float*)d_in[i];
    a.out = (float*)d_out; a.ws = (unsigned char*)d_ws;
    a.rep_mask = REP_MASK; a.pad = 0;
    if (N_LAUNCHES == 1) { a.ph_lo = 0; a.ph_hi = NPHASE; hipLaunchKernelGGL(mk_fwd, dim3(grid), dim3(NWAVES * 64), LDS_BYTES, stream, a); }
    else for (int li = 0; li < NPHASE; ++li) { a.ph_lo = li; a.ph_hi = li + 1; hipLaunchKernelGGL(mk_fwd, dim3(grid), dim3(NWAVES * 64), LDS_BYTES, stream, a); }
    const hipError_t le = hipPeekAtLastError();
    if (le != hipSuccess) fprintf(stderr, "kernel_launch: launch failed: %s (grid %d x %d threads, %d B LDS)\n", hipGetErrorName(le), grid, NWAVES * 64, LDS_BYTES);
}
```

```cpp
#include <hip/hip_runtime.h>
#include <cstdio>
#include <cstdint>
namespace pg8 {
#define PG8_LAS __attribute__((address_space(3)))
typedef unsigned short bf16_t;
typedef short bf16x8 __attribute__((ext_vector_type(8)));
typedef float f32x4 __attribute__((ext_vector_type(4)));
typedef unsigned u32x4 __attribute__((ext_vector_type(4)));
constexpr int BM = 256, BK = 64, HALF = 128, HTB = HALF * BK * 2  , STAGE_BYTES = 8 * HTB, NXCD = 8, WGM = 8;

__host__ __device__ __forceinline__ int lds_byte(int r, int c) { const int st = (r >> 4) * 2 + (c >> 5), rr = r & 15, cc = c & 31, ob = rr * 64 + cc * 2; return st * 1024 + (ob ^ (((ob >> 9) & 1) << 5)); }
__host__ __device__ __forceinline__ void stage_rc(int b, int& R, int& C) { const int st = b / 1024, sb = b % 1024, swz = sb ^ (((sb >> 9) & 1) << 5); R = (st >> 1) * 16 + swz / 64; C = (st & 1) * 32 + (swz % 64) / 2; }
__host__ __device__ __forceinline__ int perm32(int rho) { const int n = rho >> 4, i = rho & 15; return 8 * (i >> 2) + 4 * n + (i & 3); }

struct Unit { int pm, pn; };
struct Gemm { const bf16_t* A; const bf16_t* Bt; int M, N, K; };

struct StaticOrder {
    int nM, nN, nwg, G, c, rep;
    __host__ __device__ void init(int M, int N, int G_, int c_) { nM = M / BM; nN = N / BM; nwg = nM * nN; G = G_; c = c_; rep = 1; }
    __host__ __device__ bool next(int i, Unit& u) const {
        const long L = (long)(i / rep) * G + c; if (L >= nwg) return false;
        int wgid = (int)L; { const int q = nwg / NXCD, r = nwg % NXCD, xcd = wgid % NXCD, off = wgid / NXCD; wgid = (xcd < r ? xcd * (q + 1) : r * (q + 1) + (xcd - r) * q) + off; }
        const int nig = WGM * nN, gid = wgid / nig, fm = gid * WGM, gsz = (nM - fm) < WGM ? (nM - fm) : WGM;
        u.pm = fm + ((wgid % nig) % gsz); u.pn = (wgid % nig) / gsz; return true;
    }
    __device__ __forceinline__ void a_ready(const Unit&) const {}
    __device__ __forceinline__ void done(const Unit&) const {}
};

__device__ __forceinline__ unsigned cvt_pk_bf16(float lo, float hi) { unsigned r; asm volatile("v_cvt_pk_bf16_f32 %0, %1, %2" : "=v"(r) : "v"(lo), "v"(hi)); return r; }
typedef float f32x2 __attribute__((ext_vector_type(2)));
__device__ __forceinline__ f32x2 gelu_pk(f32x2 v) {
    const f32x2 av = __builtin_elementwise_abs(v), d = av * 0.2316418882f + 1.0f;
    f32x2 t; t.x = __builtin_amdgcn_rcpf(d.x); t.y = __builtin_amdgcn_rcpf(d.y);
    f32x2 q = t * 0.5307027145f + (-0.7265760135f); q = q * t + 0.7107068705f; q = q * t + (-0.142248368f); q = q * t + 0.127414796f; q = q * t;
    const f32x2 s = (v * v) * (-0.72134752044f);
    f32x2 e; e.x = __builtin_amdgcn_exp2f(s.x); e.y = __builtin_amdgcn_exp2f(s.y);
    const f32x2 m = v * (q * e), r = v - m;
    f32x2 o; o.x = v.x < 0.f ? m.x : r.x; o.y = v.y < 0.f ? m.y : r.y; return o;
}

template <int ACT  > struct EpiBf16 {
    static constexpr bool PERM = true, AFTER_DRAIN = false; static_assert(ACT == 0 || ACT == 1, "EpiBf16: ACT is 0 (none) or 1 (gelu_pk)");
    bf16_t* O; int ldc; const float* bias; int split_cols; size_t split_stride; float scale0;
    __device__ __forceinline__ void operator()(const f32x4 (&acc)[2][2][4][2], const Unit& u, int wr, int wc, int fr, int fq) const {
        const int row0 = u.pm * BM + wr * 64 + fr; int colt = u.pn * BM; bf16_t* base = O;
        float sc = 1.f; if (split_cols) { const int t = colt / split_cols; base += (size_t)t * split_stride; colt -= t * split_cols; if (t == 0) sc = scale0; }
        const int col0 = colt + wc * 32 + 8 * fq, bcol0 = u.pn * BM + wc * 32 + 8 * fq;
        f32x4 bv[2][2];
#pragma unroll
        for (int bj = 0; bj < 2; ++bj)
#pragma unroll
            for (int n = 0; n < 2; ++n) bv[bj][n] = bias ? *(const f32x4*)(bias + bcol0 + bj * HALF + 4 * n) : (f32x4){0.f, 0.f, 0.f, 0.f};
#pragma unroll
        for (int ai = 0; ai < 2; ++ai)
#pragma unroll
            for (int m = 0; m < 4; ++m) { bf16_t* rowp = base + (size_t)(row0 + ai * HALF + m * 16) * ldc + col0;
#pragma unroll
                for (int bj = 0; bj < 2; ++bj) { f32x4 v0 = acc[ai][bj][m][0] + bv[bj][0], v1 = acc[ai][bj][m][1] + bv[bj][1];
                    if (ACT == 1) { f32x2 a = gelu_pk((f32x2){v0[0], v0[1]}), b = gelu_pk((f32x2){v0[2], v0[3]}), c = gelu_pk((f32x2){v1[0], v1[1]}), d = gelu_pk((f32x2){v1[2], v1[3]});
                        v0 = (f32x4){a.x, a.y, b.x, b.y}; v1 = (f32x4){c.x, c.y, d.x, d.y}; }
                    v0 = v0 * sc; v1 = v1 * sc; u32x4 w; w.x = cvt_pk_bf16(v0[0], v0[1]); w.y = cvt_pk_bf16(v0[2], v0[3]); w.z = cvt_pk_bf16(v1[0], v1[1]); w.w = cvt_pk_bf16(v1[2], v1[3]);
                    *(u32x4*)(rowp + bj * HALF) = w; } }
    }
};
__device__ __forceinline__ float bf_lo(unsigned w) { return __builtin_bit_cast(float, w << 16); }
__device__ __forceinline__ float bf_hi(unsigned w) { return __builtin_bit_cast(float, w & 0xffff0000u); }
__device__ __forceinline__ float sigmoid_f(float x) { return __builtin_amdgcn_rcpf(1.0f + __builtin_amdgcn_exp2f(-1.4426950408889634f * x)); }
struct EpiGate {
    static constexpr bool PERM = true, AFTER_DRAIN = false;
    bf16_t* O; int ldc; const bf16_t* Gt; int ldg; int goff; int add;
    __device__ __forceinline__ void operator()(const f32x4 (&acc)[2][2][4][2], const Unit& u, int wr, int wc, int fr, int fq) const {
        const int row0 = u.pm * BM + wr * 64 + fr, col0 = u.pn * BM + wc * 32 + 8 * fq;
#pragma unroll
        for (int ai = 0; ai < 2; ++ai)
#pragma unroll
            for (int m = 0; m < 4; ++m) { const size_t row = (size_t)(row0 + ai * HALF + m * 16);
#pragma unroll
                for (int bj = 0; bj < 2; ++bj) { const int col = col0 + bj * HALF;
                    const u32x4 g = *(const u32x4*)(Gt + row * ldg + goff + col);
                    const f32x4 v0 = acc[ai][bj][m][0], v1 = acc[ai][bj][m][1];
                    float r0 = sigmoid_f(bf_lo(g.x)) * v0[0], r1 = sigmoid_f(bf_hi(g.x)) * v0[1], r2 = sigmoid_f(bf_lo(g.y)) * v0[2], r3 = sigmoid_f(bf_hi(g.y)) * v0[3];
                    float r4 = sigmoid_f(bf_lo(g.z)) * v1[0], r5 = sigmoid_f(bf_hi(g.z)) * v1[1], r6 = sigmoid_f(bf_lo(g.w)) * v1[2], r7 = sigmoid_f(bf_hi(g.w)) * v1[3];
                    bf16_t* op = O + row * ldc + col;
                    if (add) { const u32x4 o = *(const u32x4*)op; r0 += bf_lo(o.x); r1 += bf_hi(o.x); r2 += bf_lo(o.y); r3 += bf_hi(o.y); r4 += bf_lo(o.z); r5 += bf_hi(o.z); r6 += bf_lo(o.w); r7 += bf_hi(o.w); }
                    u32x4 w; w.x = cvt_pk_bf16(r0, r1); w.y = cvt_pk_bf16(r2, r3); w.z = cvt_pk_bf16(r4, r5); w.w = cvt_pk_bf16(r6, r7);
                    *(u32x4*)op = w; } }
    }
};
struct EpiRes {
    static constexpr bool PERM = false, AFTER_DRAIN = false;
    const float* X; float* O; const float* gate0; int gate_bstride; int ldc; int rows_per_batch;
    __device__ __forceinline__ void operator()(const f32x4 (&acc)[2][2][4][2], const Unit& u, int wr, int wc, int fr, int fq) const {
        const int row0 = u.pm * BM + wr * 64 + fr, col0 = u.pn * BM + wc * 32 + 4 * fq;
        const float* gp = gate0 + (size_t)((u.pm * BM) / rows_per_batch) * gate_bstride;
#pragma unroll
        for (int bj = 0; bj < 2; ++bj)
#pragma unroll
            for (int n = 0; n < 2; ++n) { const int col = col0 + bj * HALF + n * 16; const f32x4 g = *(const f32x4*)(gp + col);
#pragma unroll
                for (int ai = 0; ai < 2; ++ai)
#pragma unroll
                    for (int m = 0; m < 4; ++m) { const size_t off = (size_t)(row0 + ai * HALF + m * 16) * ldc + col;
                        const f32x4 x = *(const f32x4*)(X + off); *(f32x4*)(O + off) = x + g * acc[ai][bj][m][n]; } }
    }
};
struct EpiLogit {
    static constexpr bool PERM = false, AFTER_DRAIN = false;
    float* O;
    __device__ __forceinline__ void operator()(const f32x4 (&acc)[2][2][4][2], const Unit& u, int wr, int wc, int fr, int fq) const {
        if (wc < 2) {
            const int row0 = u.pm * BM + wr * 64 + fr, col0 = wc * 32 + 4 * fq;
#pragma unroll
            for (int ai = 0; ai < 2; ++ai)
#pragma unroll
                for (int m = 0; m < 4; ++m)
#pragma unroll
                    for (int n = 0; n < 2; ++n) *(f32x4*)(O + (size_t)(row0 + ai * HALF + m * 16) * 64 + col0 + n * 16) = acc[ai][0][m][n];
        }
    }
};
struct EpiAct {
    static constexpr bool PERM = true, AFTER_DRAIN = false;
    bf16_t* ACT; const float* roww; const PG8_LAS int* tb; int ntok;
    __device__ __forceinline__ void operator()(const f32x4 (&acc)[2][2][4][2], const Unit& u, int wr, int wc, int fr, int fq) const {
        const int row0 = u.pm * BM + wr * 64 + fr, col0 = (u.pn & 3) * 128 + wc * 32 + 8 * fq;
        const int e = tb[u.pm], ebase = tb[128 + e], ecnt = tb[200 + e];
#pragma unroll
        for (int ai = 0; ai < 2; ++ai)
#pragma unroll
            for (int m = 0; m < 4; ++m) { const size_t R = (size_t)(row0 + ai * HALF + m * 16); const int li = (int)R - ebase; const float w = li < ecnt ? roww[(size_t)e * ntok + li] : 0.f;
                const f32x4 g0 = acc[ai][0][m][0], g1 = acc[ai][0][m][1], u0 = acc[ai][1][m][0], u1 = acc[ai][1][m][1];
                float r[8];
#pragma unroll
                for (int i = 0; i < 4; ++i) { r[i] = g0[i] * sigmoid_f(g0[i]) * u0[i] * w; r[4 + i] = g1[i] * sigmoid_f(g1[i]) * u1[i] * w; }
                u32x4 o; o.x = cvt_pk_bf16(r[0], r[1]); o.y = cvt_pk_bf16(r[2], r[3]); o.z = cvt_pk_bf16(r[4], r[5]); o.w = cvt_pk_bf16(r[6], r[7]);
                *(u32x4*)(ACT + R * 512 + col0) = o; }
    }
};
struct EpiDown {
    static constexpr bool PERM = true, AFTER_DRAIN = false;
    bf16_t* Y; const int* rowtok; int ntok; const PG8_LAS int* tb;
    __device__ __forceinline__ void operator()(const f32x4 (&acc)[2][2][4][2], const Unit& u, int wr, int wc, int fr, int fq) const {
        const int row0 = u.pm * BM + wr * 64 + fr, col0 = (u.pn & 7) * BM + wc * 32 + 8 * fq;
        const int e = tb[u.pm], ebase = tb[128 + e], ecnt = tb[200 + e];
#pragma unroll
        for (int ai = 0; ai < 2; ++ai)
#pragma unroll
            for (int m = 0; m < 4; ++m) { const int li = row0 + ai * HALF + m * 16 - ebase; const int tk = li < ecnt ? rowtok[(size_t)e * ntok + li] : -1;
                if (tk >= 0) { bf16_t* yp = Y + ((size_t)(tk & 1) * ntok + (size_t)(tk >> 1)) * 2048 + col0;
#pragma unroll
                    for (int bj = 0; bj < 2; ++bj) { const f32x4 v0 = acc[ai][bj][m][0], v1 = acc[ai][bj][m][1];
                        u32x4 o; o.x = cvt_pk_bf16(v0[0], v0[1]); o.y = cvt_pk_bf16(v0[2], v0[3]); o.z = cvt_pk_bf16(v1[0], v1[1]); o.w = cvt_pk_bf16(v1[2], v1[3]);
                        *(u32x4*)(yp + bj * HALF) = o; } } }
    }
};
struct MoeOrder {
    const PG8_LAS int* tile_e; int ntiles, ncol, G, c, rep;
    __device__ __forceinline__ bool next(int i, Unit& u) const {
        const long L = (long)(i / rep) * G + c; if (L >= (long)ntiles * ncol) return false;
        const int rt = (int)(L / ncol), pl = (int)(L % ncol); u.pm = rt; u.pn = __builtin_amdgcn_readfirstlane(tile_e[rt]) * ncol + pl; return true;
    }
    __device__ __forceinline__ void a_ready(const Unit&) const {}
    __device__ __forceinline__ void done(const Unit&) const {}
};

struct GatherTab { const int* rowtok; const PG8_LAS int* tb; int ntok;
    __device__ __forceinline__ int tok(int pm, int r) const { const int e = tb[pm], i = pm * 256 + r - tb[128 + e]; return i < tb[200 + e] ? (rowtok[(size_t)e * ntok + i] >> 1) : 0; } };
template <class Epi, class Sched, bool ALIGN_EPI = false, bool SP2 = false, bool GATHER = false>
__device__ __forceinline__ void gemm_phase(PG8_LAS unsigned char* lds, const Gemm g, const Sched& S, const Epi& E, const GatherTab gt = GatherTab{nullptr, nullptr, 0}) {
    int tid_ = threadIdx.x; asm volatile("" : "+v"(tid_));
    const int tid = tid_, wid = __builtin_amdgcn_readfirstlane(tid >> 6), lane = tid & 63, wr = wid >> 2, wc = wid & 3, fr = lane & 15, fq = lane >> 4;
    const int K = g.K, nt = K / BK;
    unsigned voffA[2], voffB[2];
#pragma unroll
    for (int i = 0; i < 2; ++i) { int R, C; stage_rc(tid * 16 + i * 8192, R, C); const int Rb = Epi::PERM ? ((R & ~31) + perm32(R & 31)) : R;
        voffA[i] = (unsigned)(R * K + C) * 2u; voffB[i] = (unsigned)(Rb * K + C) * 2u; }
    unsigned vAc[2][2], vAn[2][2];
    int RA[2], CA[2];
#pragma unroll
    for (int i = 0; i < 2; ++i) stage_rc(tid * 16 + i * 8192, RA[i], CA[i]);
#define PG8_GVOFF(dst, unit) do { _Pragma("unroll") for (int h_ = 0; h_ < 2; ++h_) _Pragma("unroll") for (int i_ = 0; i_ < 2; ++i_) \
        dst[h_][i_] = (unsigned)((size_t)gt.tok((unit).pm, h_ * HALF + RA[i_]) * K + CA[i_]) * 2u; } while (0)
    const size_t kstep = (size_t)(BK * 2);
    const size_t hstep = (size_t)HALF * K * 2;
    const size_t tstep = 2 * hstep;
    const unsigned ldsw = (unsigned)wid * 1024u;
    const int aoff = lds_byte(wr * 64 + fr, fq * 8), boff = lds_byte(wc * 32 + fr, fq * 8);
#define PG8_SA(b, h) (((b) * 2 + (h)) * HTB)
#define PG8_SB(b, h) ((4 + (b) * 2 + (h)) * HTB)
#define PG8_STAGE(bufoff, gbase, voff) do { _Pragma("unroll") for (int _i = 0; _i < 2; ++_i) \
        __builtin_amdgcn_global_load_lds((const unsigned*)((const char*)(gbase) + (voff)[_i]), (PG8_LAS unsigned*)(lds + (bufoff) + ldsw + _i * 8192), 16, 0, 0); } while (0)
#define PG8_STAGE_A(bufoff, gbase, h, nx) do { if constexpr (GATHER) { if (nx) PG8_STAGE(bufoff, gbase, vAn[h]); else PG8_STAGE(bufoff, gbase, vAc[h]); } else { PG8_STAGE(bufoff, (gbase) + (h) * hstep, voffA); } } while (0)
#define PG8_LDA(dst, b, h) do { _Pragma("unroll") for (int m = 0; m < 4; ++m) _Pragma("unroll") for (int k = 0; k < 2; ++k) dst[m][k] = *(const PG8_LAS bf16x8*)(lds + PG8_SA(b, h) + aoff + m * 2048 + k * 1024); } while (0)
#define PG8_LDB(dst, b, h) do { _Pragma("unroll") for (int n = 0; n < 2; ++n) _Pragma("unroll") for (int k = 0; k < 2; ++k) dst[n][k] = *(const PG8_LAS bf16x8*)(lds + PG8_SB(b, h) + boff + n * 2048 + k * 1024); } while (0)
#define PG8_MMA(ai, bj, At, Bt) do { __builtin_amdgcn_s_setprio(1); _Pragma("unroll") for (int m = 0; m < 4; ++m) _Pragma("unroll") for (int n = 0; n < 2; ++n) _Pragma("unroll") for (int k = 0; k < 2; ++k) \
        acc[ai][bj][m][n] = __builtin_amdgcn_mfma_f32_16x16x32_bf16(Bt[n][k], At[m][k], acc[ai][bj][m][n], 0, 0, 0); __builtin_amdgcn_s_setprio(0); } while (0)
#define PG8_WAIT_V(n) asm volatile("s_waitcnt vmcnt(" #n ")" ::: "memory")
#define PG8_WAIT_L(n) asm volatile("s_waitcnt lgkmcnt(" #n ")" ::: "memory")
#define PG8_BAR __builtin_amdgcn_s_barrier()
#define PG8_SCHED __builtin_amdgcn_sched_barrier(0)
    Unit cur, nxt; int ui = 0;
    if (!S.next(0, cur)) return;
    f32x4 acc[2][2][4][2];
#pragma unroll
    for (int a = 0; a < 2; ++a)
#pragma unroll
        for (int b = 0; b < 2; ++b)
#pragma unroll
            for (int m = 0; m < 4; ++m)
#pragma unroll
                for (int n = 0; n < 2; ++n) acc[a][b][m][n] = (f32x4){0.f, 0.f, 0.f, 0.f};
    bf16x8 At[4][2], B0[2][2], B1[2][2];
    const char* cA = (const char*)g.A + (GATHER ? (size_t)0 : (size_t)cur.pm * tstep); const char* cB = (const char*)g.Bt + (size_t)cur.pn * tstep;
    if constexpr (GATHER) { PG8_GVOFF(vAc, cur); }
    S.a_ready(cur);
    if constexpr (SP2) {
        PG8_STAGE(PG8_SB(0, 0), cB, voffB); PG8_STAGE(PG8_SB(0, 1), cB + hstep, voffB); PG8_STAGE_A(PG8_SA(0, 0), cA, 0, false); PG8_STAGE_A(PG8_SA(0, 1), cA, 1, false);
        if (wr == 1) PG8_BAR;
        PG8_WAIT_V(2); PG8_BAR;
        PG8_STAGE(PG8_SB(1, 0), cB + kstep, voffB); PG8_STAGE_A(PG8_SA(1, 0), cA + kstep, 0, false); PG8_STAGE(PG8_SB(1, 1), cB + hstep + kstep, voffB);
        PG8_WAIT_V(6); PG8_BAR;
    } else {
        PG8_STAGE(PG8_SB(0, 0), cB, voffB); PG8_STAGE_A(PG8_SA(0, 0), cA, 0, false); PG8_STAGE(PG8_SB(0, 1), cB + hstep, voffB); PG8_STAGE_A(PG8_SA(0, 1), cA, 1, false);
        if (wr == 1) PG8_BAR;
        PG8_WAIT_V(4); PG8_BAR;
        PG8_STAGE(PG8_SB(1, 0), cB + kstep, voffB); PG8_STAGE_A(PG8_SA(1, 0), cA + kstep, 0, false); PG8_STAGE(PG8_SB(1, 1), cB + hstep + kstep, voffB);
        PG8_WAIT_V(6); PG8_BAR;
    }
    for (;;) {
        const bool has_next = S.next(ui + 1, nxt);
        if constexpr (GATHER) { if (has_next) { PG8_GVOFF(vAn, nxt); } else { _Pragma("unroll") for (int h_ = 0; h_ < 2; ++h_) _Pragma("unroll") for (int i_ = 0; i_ < 2; ++i_) vAn[h_][i_] = vAc[h_][i_]; } }
        const char* nA = has_next ? (const char*)g.A + (GATHER ? (size_t)0 : (size_t)nxt.pm * tstep) : cA; const char* nB = has_next ? (const char*)g.Bt + (size_t)nxt.pn * tstep : cB;
        for (int t = 0; t < nt; t += 2) {
            const bool last = (t == nt - 2);
            const char* a1 = cA + (size_t)(t + 1) * kstep;
            const char* a2 = last ? nA : cA + (size_t)(t + 2) * kstep; const char* b2 = last ? nB : cB + (size_t)(t + 2) * kstep;
            const char* a3 = a2 + kstep; const char* b3 = b2 + kstep;
            if (last && has_next) S.a_ready(nxt);
            if constexpr (SP2) {
            PG8_LDB(B0, 0, 0); PG8_LDB(B1, 0, 1); PG8_SCHED; PG8_LDA(At, 0, 0); PG8_STAGE_A(PG8_SA(1, 1), a1, 1, false);
            PG8_WAIT_V(8); PG8_WAIT_L(0); PG8_BAR; PG8_MMA(0, 0, At, B0); PG8_MMA(0, 1, At, B1); PG8_BAR; PG8_SCHED;
            PG8_LDA(At, 0, 1); PG8_STAGE(PG8_SB(0, 0), b2, voffB); PG8_STAGE(PG8_SB(0, 1), b2 + hstep, voffB); PG8_STAGE_A(PG8_SA(0, 0), a2, 0, last);
            PG8_WAIT_V(8); PG8_WAIT_L(0); PG8_BAR; PG8_MMA(1, 0, At, B0); PG8_MMA(1, 1, At, B1); PG8_BAR; PG8_SCHED;
            PG8_LDB(B0, 1, 0); PG8_LDB(B1, 1, 1); PG8_SCHED; PG8_LDA(At, 1, 0); PG8_STAGE_A(PG8_SA(0, 1), a2, 1, last);
            PG8_WAIT_V(8); PG8_WAIT_L(0); PG8_BAR; PG8_MMA(0, 0, At, B0); PG8_MMA(0, 1, At, B1); PG8_BAR; PG8_SCHED;
            PG8_LDA(At, 1, 1); PG8_STAGE(PG8_SB(1, 0), b3, voffB); PG8_STAGE(PG8_SB(1, 1), b3 + hstep, voffB); PG8_STAGE_A(PG8_SA(1, 0), a3, 0, last);
            PG8_WAIT_V(8); PG8_WAIT_L(0); PG8_BAR; PG8_MMA(1, 0, At, B0); PG8_MMA(1, 1, At, B1); PG8_BAR; PG8_SCHED;
            } else {
            PG8_LDB(B0, 0, 0); PG8_SCHED; PG8_LDA(At, 0, 0); PG8_STAGE_A(PG8_SA(1, 1), a1, 1, false);
            PG8_WAIT_L(8); PG8_BAR; PG8_WAIT_L(0); PG8_MMA(0, 0, At, B0); PG8_BAR; PG8_SCHED;
            PG8_LDB(B1, 0, 1); PG8_STAGE(PG8_SB(0, 0), b2, voffB);
            PG8_BAR; PG8_WAIT_L(0); PG8_MMA(0, 1, At, B1); PG8_BAR;
            PG8_LDA(At, 0, 1); PG8_STAGE_A(PG8_SA(0, 0), a2, 0, last);
            PG8_BAR; PG8_WAIT_L(0); PG8_MMA(1, 0, At, B0); PG8_BAR; PG8_SCHED;
            PG8_STAGE(PG8_SB(0, 1), b2 + hstep, voffB);
            PG8_WAIT_V(6); PG8_BAR; PG8_MMA(1, 1, At, B1); PG8_BAR;
            PG8_LDB(B0, 1, 0); PG8_SCHED; PG8_LDA(At, 1, 0); PG8_STAGE_A(PG8_SA(0, 1), a2, 1, last);
            PG8_WAIT_L(8); PG8_BAR; PG8_WAIT_L(0); PG8_MMA(0, 0, At, B0); PG8_BAR; PG8_SCHED;
            PG8_LDB(B1, 1, 1); PG8_STAGE(PG8_SB(1, 0), b3, voffB);
            PG8_BAR; PG8_WAIT_L(0); PG8_MMA(0, 1, At, B1); PG8_BAR;
            PG8_LDA(At, 1, 1); PG8_STAGE_A(PG8_SA(1, 0), a3, 0, last);
            PG8_BAR; PG8_WAIT_L(0); PG8_MMA(1, 0, At, B0); PG8_BAR; PG8_SCHED;
            PG8_STAGE(PG8_SB(1, 1), b3 + hstep, voffB);
            PG8_WAIT_V(6); PG8_BAR; PG8_MMA(1, 1, At, B1); PG8_BAR;
            }
        }
        if constexpr (ALIGN_EPI) { if (wr == 0) PG8_BAR; }
        if constexpr (!Epi::AFTER_DRAIN) { E(acc, cur, wr, wc, fr, fq); S.done(cur); }
        if (!has_next) break;
#pragma unroll
        for (int a = 0; a < 2; ++a)
#pragma unroll
            for (int b = 0; b < 2; ++b)
#pragma unroll
                for (int m = 0; m < 4; ++m)
#pragma unroll
                    for (int n = 0; n < 2; ++n) acc[a][b][m][n] = (f32x4){0.f, 0.f, 0.f, 0.f};
        cur = nxt; cA = nA; cB = nB; ++ui;
        if constexpr (GATHER) { _Pragma("unroll") for (int h_ = 0; h_ < 2; ++h_) _Pragma("unroll") for (int i_ = 0; i_ < 2; ++i_) vAc[h_][i_] = vAn[h_][i_]; }
        if constexpr (ALIGN_EPI) { if (wr == 1) PG8_BAR; }
    }
    PG8_WAIT_V(0);
    if constexpr (!ALIGN_EPI) { if (wr == 0) PG8_BAR; }
    PG8_BAR;
    if constexpr (Epi::AFTER_DRAIN) { E.fused(acc, cur, wr, wc, fr, fq, lds, wid, lane); S.done(cur); }
#undef PG8_SA
#undef PG8_SB
#undef PG8_STAGE
#undef PG8_LDA
#undef PG8_STAGE_A
#undef PG8_GVOFF
#undef PG8_LDB
#undef PG8_MMA
#undef PG8_WAIT_V
#undef PG8_WAIT_L
#undef PG8_BAR
#undef PG8_SCHED
}
}

#ifndef PG8_SP2
#define PG8_SP2 true
#endif
#ifndef PG8_ALIGN
#define PG8_ALIGN true
#endif
#include <hip/hip_bf16.h>
#include <cmath>
namespace attn_body {
using bf16=__hip_bfloat16;
using bf16x8=__attribute__((ext_vector_type(8)))short;
using s16x4=__attribute__((ext_vector_type(4)))short;
using f32x16=__attribute__((ext_vector_type(16)))float;
using u32x4=__attribute__((ext_vector_type(4)))unsigned;
constexpr int BATCH=2,NHEAD=16,SEQ=4096,D=64,DM=NHEAD*D,QP=9984,KP=9984,VP=9984,OP=1024,GQA=4;
constexpr int NW=8,QBLK=32,QB=QBLK*NW,KVBLK=64,NQB=SEQ/QB;
constexpr int ATTN_UNIT_ROWS=QB;
__device__ __forceinline__ int crow(int r,int hi){return (r&3)+8*(r>>2)+4*hi;}
#define SBAR() __builtin_amdgcn_sched_barrier(0)
__device__ __forceinline__ void cmask(f32x16&p0,f32x16&p1,int jb,int qrel,int hi){
  const float NEG=-INFINITY; int kb=64*jb+4*hi;
  #pragma unroll
  for(int r=0;r<16;++r){int kv=kb+(r&3)+8*(r>>2); if(kv>qrel)p0[r]=NEG; if(kv+32>qrel)p1[r]=NEG;}
}

constexpr int NSLOT=3, SLOTB=8192;
constexpr int LDS_K=0, LDS_V=NSLOT*SLOTB, LDS_WS=2*NSLOT*SLOTB, LDS_OST=LDS_WS+NW*64*4, LDS_MK=LDS_OST+NW*4096, LDS_BYTES=LDS_MK+NW*4096;
constexpr float C2=0.125f*1.4426950408889634f;
__device__ __forceinline__ void glds16(const void*gsrc,unsigned lds_dst){unsigned keep;
  asm volatile("s_mov_b32 %0, m0\n\ts_mov_b32 m0, %2\n\ts_nop 0\n\tglobal_load_lds_dwordx4 %1, off\n\ts_mov_b32 m0, %0":"=&s"(keep):"v"(gsrc),"s"(lds_dst):"memory");}
__device__ __forceinline__ float max3f(float a,float b,float c){float r;asm("v_max3_f32 %0, %1, %2, %3":"=v"(r):"v"(a),"v"(b),"v"(c));return r;}
__device__ __forceinline__ float max2f(float a,float b){float r;asm("v_max_f32_e32 %0, %1, %2":"=v"(r):"v"(a),"v"(b));return r;}
__device__ __forceinline__ float fadd_s(float a,float b){float r;asm("v_add_f32_e32 %0, %1, %2":"=v"(r):"v"(a),"v"(b));return r;}
__device__ __forceinline__ float fsub_s(float a,float b){float r;asm("v_sub_f32_e32 %0, %1, %2":"=v"(r):"v"(a),"v"(b));return r;}
typedef float f32x2_t __attribute__((ext_vector_type(2))); typedef __bf16 bf16x2_t __attribute__((ext_vector_type(2)));
__device__ __forceinline__ unsigned cvtpk_s(float lo,float hi){f32x2_t v={lo,hi};bf16x2_t b=__builtin_convertvector(v,bf16x2_t);return __builtin_bit_cast(unsigned,b);}
#define WAIT_BAR(N) asm volatile("s_waitcnt vmcnt(" #N ") lgkmcnt(0)\n\ts_barrier":::"memory")

__device__ __forceinline__ void qkt(f32x16&p0,f32x16&p1,const char*Kslot,const bf16x8*qr,const f32x16&negm,int r32,int hi){
  const char*kb=Kslot+hi*1024+r32*16;
  #pragma unroll
  for(int d0=0;d0<4;++d0){
    const bf16x8 b0=*reinterpret_cast<const bf16x8*>(kb+d0*2048);
    const bf16x8 b1=*reinterpret_cast<const bf16x8*>(kb+d0*2048+512);
    if(d0==0){p0=__builtin_amdgcn_mfma_f32_32x32x16_bf16(b0,qr[0],negm,0,0,0);p1=__builtin_amdgcn_mfma_f32_32x32x16_bf16(b1,qr[0],negm,0,0,0);}
    else{p0=__builtin_amdgcn_mfma_f32_32x32x16_bf16(b0,qr[d0],p0,0,0,0);p1=__builtin_amdgcn_mfma_f32_32x32x16_bf16(b1,qr[d0],p1,0,0,0);}}
}
typedef __attribute__((address_space(3))) const char* lds_cptr;
typedef short v4i16_t __attribute__((ext_vector_type(4)));
__device__ __forceinline__ void kload8(bf16x8*kf,lds_cptr kp){
  kf[0]=*(const __attribute__((address_space(3))) bf16x8*)(kp);      kf[1]=*(const __attribute__((address_space(3))) bf16x8*)(kp+512);
  kf[2]=*(const __attribute__((address_space(3))) bf16x8*)(kp+2048); kf[3]=*(const __attribute__((address_space(3))) bf16x8*)(kp+2560);
  kf[4]=*(const __attribute__((address_space(3))) bf16x8*)(kp+4096); kf[5]=*(const __attribute__((address_space(3))) bf16x8*)(kp+4608);
  kf[6]=*(const __attribute__((address_space(3))) bf16x8*)(kp+6144); kf[7]=*(const __attribute__((address_space(3))) bf16x8*)(kp+6656);
}
__device__ __forceinline__ void kload2(bf16x8*kf,lds_cptr kp,int j){ kf[2*j]=*(const __attribute__((address_space(3))) bf16x8*)(kp+j*2048); kf[2*j+1]=*(const __attribute__((address_space(3))) bf16x8*)(kp+j*2048+512); }
__device__ __forceinline__ s16x4 vtr(lds_cptr p){ return __builtin_bit_cast(s16x4,__builtin_amdgcn_ds_read_tr16_b64_v4i16((__attribute__((address_space(3))) v4i16_t*)p)); }
template<int BIT> __device__ __forceinline__ float mand_asm(float x,unsigned m){ int t; asm("v_bfe_i32 %0, %1, %2, 1":"=v"(t):"v"(m),"i"(BIT)); float y; asm("v_and_b32 %0, %1, %2":"=v"(y):"v"(t),"v"(x)); return y; }
__device__ __forceinline__ float rowmax(const f32x16&p0,const f32x16&p1){
  float a=max3f(p0[0],p0[1],p1[0]),b=max3f(p0[2],p0[3],p1[1]);a=max3f(a,p1[2],p1[3]);
  #pragma unroll
  for(int r=4;r<16;r+=4){a=max3f(a,p0[r],p0[r+1]);b=max3f(b,p0[r+2],p0[r+3]);a=max3f(a,p1[r],p1[r+1]);b=max3f(b,p1[r+2],p1[r+3]);}
  const float m=max2f(a,b);
  auto rr=__builtin_amdgcn_permlane32_swap(__float_as_uint(m),__float_as_uint(m),false,false);
  return max2f(__uint_as_float(rr[0]),__uint_as_float(rr[1]));
}
__device__ __forceinline__ void pv(f32x16*o,int vb,bf16x8 pa0,bf16x8 pa1,bf16x8 pa2,bf16x8 pa3){
  #pragma unroll
  for(int d0=0;d0<2;++d0){s16x4 lo[4],hi[4];
    #pragma unroll
    for(int ks=0;ks<4;++ks){
      asm volatile("ds_read_b64_tr_b16 %0,%1 offset:%c2":"=&v"(lo[ks]):"v"(vb),"i"(d0*4096+ks*1024):"memory");
      asm volatile("ds_read_b64_tr_b16 %0,%1 offset:%c2":"=&v"(hi[ks]):"v"(vb),"i"(d0*4096+ks*1024+512):"memory");}
    asm volatile("s_waitcnt lgkmcnt(0)":::"memory");SBAR();
    #define PK(k) (bf16x8){lo[k][0],lo[k][1],lo[k][2],lo[k][3],hi[k][0],hi[k][1],hi[k][2],hi[k][3]}
    o[d0]=__builtin_amdgcn_mfma_f32_32x32x16_bf16(pa0,PK(0),o[d0],0,0,0);
    o[d0]=__builtin_amdgcn_mfma_f32_32x32x16_bf16(pa1,PK(1),o[d0],0,0,0);
    o[d0]=__builtin_amdgcn_mfma_f32_32x32x16_bf16(pa2,PK(2),o[d0],0,0,0);
    o[d0]=__builtin_amdgcn_mfma_f32_32x32x16_bf16(pa3,PK(3),o[d0],0,0,0);
    #undef PK
  }
}

#ifndef ATTN_STORE16
#define ATTN_STORE16(p,v) (*(u32x4*)(p)=(v))
#endif
template<int THRL> __device__ __forceinline__ void attn_unit(int b,int h,int qb,const bf16*Q,const bf16*__restrict__ K,const bf16*__restrict__ V,bf16*O,const unsigned long long*__restrict__ MK,char*shm){
  int tid_=threadIdx.x; asm volatile("":"+v"(tid_)); const int tid=tid_,lane=tid&63,r32=lane&31,hi=lane>>5; const int wid=__builtin_amdgcn_readfirstlane(tid>>6);
  const long rowbase=(long)b*SEQ; const int q0=qb*QB;
  const bf16*Qw=Q+(rowbase+q0+wid*QBLK)*QP+h*D;
  const bf16*Kh=K+rowbase*KP+(h/GQA)*D,*Vh=V+rowbase*VP+(h/GQA)*D;
  const unsigned lds0=(unsigned)(uintptr_t)shm;
  float*wsf=(float*)(shm+LDS_WS)+wid*64;
  const bf16*ksrc=Kh+(long)lane*KP+wid*8;
  const bf16*vsrc=Vh+(long)(16*(wid&3)+(lane>>2))*VP+(wid>>2)*32+(lane&3)*8;
  const unsigned kdst=lds0+LDS_K+wid*1024, vdst=lds0+LDS_V+wid*1024;
  #define DMA_K(t,slot) glds16(ksrc+(long)(t)*KVBLK*KP,(unsigned)__builtin_amdgcn_readfirstlane(kdst+(slot)))
  #define DMA_V(t,slot) glds16(vsrc+(long)(t)*KVBLK*VP,(unsigned)__builtin_amdgcn_readfirstlane(vdst+(slot)))
  const int vb0=(int)(lds0+LDS_V)+((lane>>4)&1)*32+(lane&3)*8+(4*hi+((lane&15)>>2))*64;
  const char*Kbase=shm+LDS_K; bf16x8 kf[8];
  const lds_cptr shm3=(lds_cptr)shm; const lds_cptr kp0=shm3+LDS_K+hi*1024+r32*16; const lds_cptr vp0=shm3+LDS_V+((lane>>4)&1)*32+(lane&3)*8+(4*hi+((lane&15)>>2))*64;
  const int NT=(q0+QB)/KVBLK;
  DMA_K(0,0);DMA_V(0,0);DMA_K(1,SLOTB);
  bf16x8 qr[4];
  #pragma unroll
  for(int d0=0;d0<4;++d0)qr[d0]=*reinterpret_cast<const bf16x8*>(&Qw[(long)r32*QP+d0*16+hi*8]);
  float mhat=0.f,l_reg=0.f;f32x16 o[2];o[0]=f32x16{};o[1]=f32x16{};const f32x16 negm=f32x16{};
  const int qrel=wid*QBLK+r32; (void)qrel;
  const unsigned long long*MKw=MK+((size_t)(rowbase+q0+wid*QBLK))*64;
  typedef __attribute__((address_space(3))) unsigned long long lds_u64;
  lds_u64*mks=(lds_u64*)((lds_cptr)shm+LDS_MK+wid*4096);
  #define MK_REFILL(t0) do{ _Pragma("unroll") for(int i_=0;i_<4;++i_){ const int idx_=i_*64+lane, q_=idx_>>3, pr_=idx_&7; \
      const u32x4 w_=*(const u32x4*)(MKw+(size_t)q_*64+(t0)+2*pr_); \
      mks[(2*pr_)*32+q_]=((unsigned long long)w_.y<<32)|w_.x; mks[(2*pr_+1)*32+q_]=((unsigned long long)w_.w<<32)|w_.z; } }while(0)
  #define MK_LOAD(t,ML,MH) do{ if(((t)&15)==0){ MK_REFILL(t); } const unsigned long long mw_=mks[((t)&15)*32+r32]; ML=(unsigned)mw_>>(4*hi); MH=(unsigned)(mw_>>32)>>(4*hi); }while(0)
  #define MKB(r) (((r)&3)+8*((r)>>2))
  #define MAND(x,M,r) __builtin_bit_cast(float,__builtin_bit_cast(unsigned,(x))&(unsigned)__builtin_amdgcn_sbfe((int)(M),MKB(r),1))
  unsigned mlo,mhi;
  #define CMASK(P0,P1,t) do{}while(0)
  bool resc=false;
  #define START(P0,P1) do{ const float rm=rowmax(P0,P1); resc=false; \
    { const float dl=rm; mhat=fadd_s(mhat,dl); \
      _Pragma("unroll") for(int r=0;r<16;++r){P0[r]=fsub_s(P0[r],dl);P1[r]=fsub_s(P1[r],dl);} \
      } \
    _Pragma("unroll") for(int r=0;r<16;++r)P0[r]=MAND(__builtin_amdgcn_exp2f(P0[r]),mlo,r); }while(0)
  #define RESC() do{ if(resc){ asm volatile("s_waitcnt lgkmcnt(0)":::"memory"); \
      _Pragma("unroll") for(int d_=0;d_<2;++d_) _Pragma("unroll") for(int r=0;r<16;++r)o[d_][r]*=wsf[crow(r,hi)]; } }while(0)
  f32x16 pA0,pA1,pB0,pB1;
  int sl_prev=0,sl_cur=0,sl_next=SLOTB;
  #define ROT() do{sl_prev=sl_cur;sl_cur=sl_next;sl_next=(sl_next==(NSLOT-1)*SLOTB)?0:sl_next+SLOTB;}while(0)
  DMA_K(2,2*SLOTB);
  WAIT_BAR(3);
  qkt(pA0,pA1,Kbase,qr,negm,r32,hi);asm volatile("s_nop 15\n\ts_nop 7":"+v"(pA0),"+v"(pA1));CMASK(pA0,pA1,0);
  MK_LOAD(0,mlo,mhi);
  START(pA0,pA1);
  _Pragma("unroll") for(int r=0;r<16;++r)pA1[r]=MAND(__builtin_amdgcn_exp2f(pA1[r]),mhi,r);
  WAIT_BAR(0);
  DMA_K(3,0);DMA_V(1,SLOTB);
  ROT();
  kload8(kf,kp0+sl_cur);
  WAIT_BAR(2);
  s16x4 vlo[8],vhi[8]; u32x4 pw0,pw1,pw2,pw3;
  #define PKW(P,B) cvtpk_s(P[B],P[B+1])
  #define PAF(k) __builtin_bit_cast(bf16x8,pw##k)
  #define VFR(i) (bf16x8){vlo[i][0],vlo[i][1],vlo[i][2],vlo[i][3],vhi[i][0],vhi[i][1],vhi[i][2],vhi[i][3]}
  #define PIN(x) asm volatile("":"+v"(x))
  #define MX3(a,b,c) __builtin_fmaxf(__builtin_fmaxf((a),(b)),(c))
  #define GAPA(MF,A0,A1,A2,A3,W0,W1,PW) do{ MF; sacc+=A0; sacc+=A1; sacc+=A2; sacc+=A3; PIN(sacc); W0; W1; PIN(PW); SBAR(); }while(0)
  #define EX(v) __builtin_amdgcn_exp2f(v)
  #define MANDA(x,M,r) mand_asm<MKB(r)>((x),(M))
  #define GAPB(MF,X,B,M) do{ MF; X[B]=MANDA(EX(X[B]),M,B); X[B+1]=MANDA(EX(X[B+1]),M,B+1); X[B+2]=MANDA(EX(X[B+2]),M,B+2); X[B+3]=MANDA(EX(X[B+3]),M,B+3); PIN(X); SBAR(); }while(0)
  #define VRD(i) do{ vlo[i]=vtr(vp_+(((i)>>2)*4096+((i)&3)*1024)); vhi[i]=vtr(vp_+(((i)>>2)*4096+((i)&3)*1024+512)); }while(0)
  #define KRD(G,j) do{ if(G){ kload2(kf,kp0+sl_next,j); SBAR(); } }while(0)
  #define STEP(C0,C1,P0,P1,t,GK,GV,GL) do{ SBAR(); MK_LOAD(t,mlo,mhi); SBAR(); \
    const lds_cptr vp_=vp0+sl_prev; \
    VRD(0); SBAR(); float sacc=(P0[0]+P0[1]); \
    GAPA(C0=__builtin_amdgcn_mfma_f32_32x32x16_bf16(kf[0],qr[0],negm,0,0,0), P0[2],P0[3],P0[4],P0[5],     pw0[0]=PKW(P0,0), pw0[1]=PKW(P0,2), pw0); \
    VRD(4); SBAR(); GAPA(C1=__builtin_amdgcn_mfma_f32_32x32x16_bf16(kf[1],qr[0],negm,0,0,0), P0[6],P0[7],P0[8],P0[9],     pw0[2]=PKW(P0,4), pw0[3]=PKW(P0,6), pw0); \
    VRD(1); SBAR(); GAPA(C0=__builtin_amdgcn_mfma_f32_32x32x16_bf16(kf[2],qr[1],C0,0,0,0),   P0[10],P0[11],P0[12],P0[13], pw1[0]=PKW(P0,8), pw1[1]=PKW(P0,10), pw1); \
    VRD(5); SBAR(); GAPA(C1=__builtin_amdgcn_mfma_f32_32x32x16_bf16(kf[3],qr[1],C1,0,0,0),   P0[14],P0[15],P1[0],P1[1],   pw1[2]=PKW(P0,12),pw1[3]=PKW(P0,14), pw1); \
    VRD(2); SBAR(); GAPA(C0=__builtin_amdgcn_mfma_f32_32x32x16_bf16(kf[4],qr[2],C0,0,0,0),   P1[2],P1[3],P1[4],P1[5],     pw2[0]=PKW(P1,0), pw2[1]=PKW(P1,2), pw2); \
    VRD(6); SBAR(); GAPA(C1=__builtin_amdgcn_mfma_f32_32x32x16_bf16(kf[5],qr[2],C1,0,0,0),   P1[6],P1[7],P1[8],P1[9],     pw2[2]=PKW(P1,4), pw2[3]=PKW(P1,6), pw2); \
    VRD(3); SBAR(); GAPA(C0=__builtin_amdgcn_mfma_f32_32x32x16_bf16(kf[6],qr[3],C0,0,0,0),   P1[10],P1[11],P1[12],P1[13], pw3[0]=PKW(P1,8), pw3[1]=PKW(P1,10), pw3); \
    VRD(7); SBAR(); GAPA(C1=__builtin_amdgcn_mfma_f32_32x32x16_bf16(kf[7],qr[3],C1,0,0,0),   P1[14],P1[15],0.f,0.f,       pw3[2]=PKW(P1,12),pw3[3]=PKW(P1,14), pw3); \
    l_reg+=sacc; \
    if(GK){DMA_K((t)+3,sl_cur);} if(GV){DMA_V((t)+1,sl_next);} \
    { const float nm_=-mhat; _Pragma("unroll") for(int r=0;r<16;++r){C0[r]+=nm_;C1[r]+=nm_;} } \
    { float a=MX3(C0[0],C0[1],C1[0]),b=MX3(C0[2],C0[3],C1[1]); a=MX3(a,C1[2],C1[3]); \
      _Pragma("unroll") for(int r=4;r<16;r+=4){a=MX3(a,C0[r],C0[r+1]);b=MX3(b,C0[r+2],C0[r+3]);a=MX3(a,C1[r],C1[r+1]);b=MX3(b,C1[r+2],C1[r+3]);} \
      float rm=__builtin_fmaxf(a,b); { auto rr=__builtin_amdgcn_permlane32_swap(__float_as_uint(rm),__float_as_uint(rm),false,false); rm=__builtin_fmaxf(__uint_as_float(rr[0]),__uint_as_float(rr[1])); } \
      resc=false; \
      if(__builtin_expect(__any(rm>(float)THRL),0)){ const float dl=__builtin_fmaxf(rm,0.f); mhat+=dl; \
        _Pragma("unroll") for(int r=0;r<16;++r){C0[r]-=dl;C1[r]-=dl;} \
        const float f=__builtin_amdgcn_exp2f(-dl); l_reg*=f; if(hi==0)wsf[r32]=f; resc=true; } } \
    SBAR(); \
    GAPB(o[0]=__builtin_amdgcn_mfma_f32_32x32x16_bf16(PAF(0),VFR(0),o[0],0,0,0), C0,0,mlo); \
    GAPB(o[1]=__builtin_amdgcn_mfma_f32_32x32x16_bf16(PAF(0),VFR(4),o[1],0,0,0), C0,4,mlo); \
    KRD(GL,0); GAPB(o[0]=__builtin_amdgcn_mfma_f32_32x32x16_bf16(PAF(1),VFR(1),o[0],0,0,0), C0,8,mlo); \
    KRD(GL,1); GAPB(o[1]=__builtin_amdgcn_mfma_f32_32x32x16_bf16(PAF(1),VFR(5),o[1],0,0,0), C0,12,mlo); \
    KRD(GL,2); GAPB(o[0]=__builtin_amdgcn_mfma_f32_32x32x16_bf16(PAF(2),VFR(2),o[0],0,0,0), C1,0,mhi); \
    KRD(GL,3); GAPB(o[1]=__builtin_amdgcn_mfma_f32_32x32x16_bf16(PAF(2),VFR(6),o[1],0,0,0), C1,4,mhi); \
    GAPB(o[0]=__builtin_amdgcn_mfma_f32_32x32x16_bf16(PAF(3),VFR(3),o[0],0,0,0), C1,8,mhi); \
    GAPB(o[1]=__builtin_amdgcn_mfma_f32_32x32x16_bf16(PAF(3),VFR(7),o[1],0,0,0), C1,12,mhi); \
    }while(0)
  int t=1;
  #undef CMASK
  #define CMASK(P0,P1,t) do{}while(0)
  for(;t+5<NT;t+=2){
    STEP(pB0,pB1,pA0,pA1,t,true,true,true);     WAIT_BAR(2); RESC(); ROT();
    STEP(pA0,pA1,pB0,pB1,t+1,true,true,true);   WAIT_BAR(2); RESC(); ROT();
  }
  #undef CMASK
  #define CMASK(P0,P1,t) do{}while(0)
  #define ENDW(tt) do{ if((tt)+3<NT){WAIT_BAR(2);} else if((tt)+2<NT){WAIT_BAR(1);} else {WAIT_BAR(0);} }while(0)
  for(;t+1<NT;t+=2){
    STEP(pB0,pB1,pA0,pA1,t,(t+3<NT),(t+1<NT),(t+1<NT));       ENDW(t);   RESC(); ROT();
    STEP(pA0,pA1,pB0,pB1,t+1,(t+4<NT),(t+2<NT),(t+2<NT));     ENDW(t+1); RESC(); ROT();
  }
  STEP(pB0,pB1,pA0,pA1,NT-1,false,false,false); RESC();
  { float sacc=pB0[0]+pB0[1]; _Pragma("unroll") for(int r=2;r<16;++r)sacc+=pB0[r]; _Pragma("unroll") for(int r=0;r<16;++r)sacc+=pB1[r]; l_reg+=sacc;
    pw0=(u32x4){PKW(pB0,0),PKW(pB0,2),PKW(pB0,4),PKW(pB0,6)};pw1=(u32x4){PKW(pB0,8),PKW(pB0,10),PKW(pB0,12),PKW(pB0,14)};pw2=(u32x4){PKW(pB1,0),PKW(pB1,2),PKW(pB1,4),PKW(pB1,6)};pw3=(u32x4){PKW(pB1,8),PKW(pB1,10),PKW(pB1,12),PKW(pB1,14)};
    SBAR(); pv(o,vb0+sl_cur,PAF(0),PAF(1),PAF(2),PAF(3)); }
  #undef PKW
  #undef PAF
  #undef VFR
  #undef PIN
  #undef MX3
  #undef GAPA
  #undef GAPB
  #undef EX
  #undef VRD
  #undef KRD
  #undef STEP
  #undef ENDW
  {auto rr=__builtin_amdgcn_permlane32_swap(__float_as_uint(l_reg),__float_as_uint(l_reg),false,false);l_reg=__uint_as_float(rr[0])+__uint_as_float(rr[1]);}
  if(hi==0)wsf[32+r32]=l_reg;asm volatile("s_waitcnt lgkmcnt(0)":::"memory");
  float rli[16];
  #pragma unroll
  for(int r=0;r<16;++r)rli[r]=__builtin_amdgcn_rcpf(wsf[32+crow(r,hi)]);
  bf16*Ow=O+(rowbase+q0+wid*QBLK)*OP+h*D;
  { bf16*stg=(bf16*)(shm+LDS_OST)+wid*2048;
    #pragma unroll
    for(int r=0;r<16;++r){const int orow=crow(r,hi);
      #pragma unroll
      for(int d0=0;d0<2;++d0)stg[orow*64+d0*32+r32]=__float2bfloat16(o[d0][r]*rli[r]);}
    asm volatile("s_waitcnt lgkmcnt(0)":::"memory");
    #pragma unroll
    for(int i=0;i<4;++i){const int row=i*8+(lane>>3),ch=lane&7; const u32x4 v=*(const u32x4*)(stg+row*64+ch*8); ATTN_STORE16(Ow+(long)row*OP+ch*8,v);} }
  asm volatile("s_waitcnt lgkmcnt(0)\n\ts_barrier":::"memory");
  #undef DMA_K
  #undef MK_REFILL
  #undef MK_LOAD
  #undef MKB
  #undef MAND
  #undef DMA_V
  #undef CMASK
  #undef START
  #undef RESC
  #undef ROT
}
constexpr int ATTN_LDS_BYTES=LDS_BYTES;
struct AttnTensors { const bf16* Q; const bf16* K; const bf16* V; bf16* O; const unsigned long long* MK; };
struct AttnUnit { int bh; int qb; };
struct StaticOrder {
  int vcu;
  __device__ __forceinline__ explicit StaticOrder(int grid,int block):vcu((grid%8==0)?(block%8)*(grid/8)+block/8:block),G(grid){}
  int G,rep=1;
  __device__ __forceinline__ bool next(int i,AttnUnit&u)const{ const int L=(i/rep)*G+vcu; if(L>=512)return false; const int s=L&7; u.bh=(L&255)>>3; u.qb=(L<256)?s:15-s; return true; }
  __device__ __forceinline__ void a_ready(const AttnUnit&)const{}
  __device__ __forceinline__ void done(const AttnUnit&)const{}
};
template<class Sched,int THRL=8> __device__ __forceinline__ void attn_phase(char*lds,const AttnTensors&T,const Sched&S){
  AttnUnit u;
  for(int i=0;S.next(i,u);++i){ S.a_ready(u); attn_unit<THRL>(u.bh/NHEAD,u.bh%NHEAD,u.qb,T.Q,T.K,T.V,T.O,T.MK,lds); S.done(u); }
}
#undef SBAR
#undef WAIT_BAR
}
constexpr int NWAVES = 8;
#ifndef MK_N_LAUNCHES
#define MK_N_LAUNCHES 1
#endif
constexpr int N_LAUNCHES = MK_N_LAUNCHES;

constexpr int D = 2048, BATCH = 2, SEQ = 4096, M = BATCH * SEQ;
constexpr int NHEAD = 16, HD = 64, NKV = 4, IDXH = 16, IDXD = 64, TOPK = 256;
constexpr int NE = 32, EPG = 8, NGRP = 4, FF = 512;
constexpr int NPROJ = 9808, NP = 9984;
constexpr int C_Q = 0, C_K = 1024, C_V = 1280, C_IQ = 1536, C_IK = 2560, C_IW = 2624, C_BG = 2640, C_CG = 3664, C_XC = 4688, C_GA = 5712, C_GB = 7760;
constexpr int NMOD = 6 * D;
constexpr float EPS = 1e-6f;
constexpr int ROWCAP = 24576;
constexpr int MAXTILES = ROWCAP / 256;

constexpr size_t MiB = 1u << 20;
constexpr size_t WS_CTL = 0, CTL_ZERO_BYTES = 65536;
constexpr size_t WS_MOD = 1 * MiB;
constexpr size_t WS_ROWTOK = 2 * MiB;
constexpr size_t WS_ROWW = 3 * MiB;
constexpr size_t WS_ROWTOK2 = 4 * MiB;
constexpr size_t WS_ROWW2 = 4 * MiB + 512 * 1024;
constexpr size_t WS_LOGIT = 5 * MiB;
constexpr size_t WS_MASK = 8 * MiB;
constexpr size_t WS_WMIX = 12 * MiB;
constexpr size_t WS_WR = 28 * MiB;
constexpr size_t WS_WIN = 32 * MiB;
constexpr size_t WS_OA = 32 * MiB, WS_CB = 48 * MiB;
constexpr size_t WS_WGU = 72 * MiB;
constexpr size_t WS_WDN = 200 * MiB;
constexpr size_t WS_H = 264 * MiB;
constexpr size_t WS_PROJ = 296 * MiB;
constexpr size_t WS_HS = 296 * MiB;
constexpr size_t WS_ACT = 392 * MiB;
constexpr size_t WS_SCORE = 452 * MiB;
constexpr size_t WS_MERGED = 452 * MiB;
constexpr size_t WS_Y = 484 * MiB;
constexpr size_t WS_END = 580 * MiB;
static_assert(WS_WIN + (size_t)NP * D * 2 <= WS_WGU && WS_PROJ + (size_t)M * NP * 2 <= WS_SCORE && WS_ACT + (size_t)ROWCAP * FF * 2 <= WS_SCORE && WS_Y + (size_t)2 * M * D * 2 <= WS_END, "d_ws map");
constexpr int CW_CNT = 64;
constexpr int CW_BAR = 4096;

constexpr int RING_OFF = 0, RING_BYTES = 131072;
constexpr int LDSCTL_OFF = RING_BYTES, MISC_OFF = LDSCTL_OFF + 320;
constexpr int TILEE_OFF = RING_BYTES + 1024;
constexpr int LDS_BYTES = 147456;
static_assert(MISC_OFF + 128 <= TILEE_OFF && TILEE_OFF + 1024 <= LDS_BYTES, "LDS map");

#define GAS __attribute__((address_space(1)))
#define LAS __attribute__((address_space(3)))
typedef unsigned short bf16;
typedef unsigned v4u __attribute__((ext_vector_type(4)));
typedef float f32x4 __attribute__((ext_vector_type(4)));
typedef short bf16x8 __attribute__((ext_vector_type(8)));
typedef GAS unsigned gu32;
typedef GAS unsigned long long gu64;
#define RLX_AGENT __ATOMIC_RELAXED, __HIP_MEMORY_SCOPE_AGENT
#define LDS_WAIT() asm volatile("s_waitcnt lgkmcnt(0)" ::: "memory")
#define VM_WAIT() asm volatile("s_waitcnt vmcnt(0)" ::: "memory")
__device__ __forceinline__ unsigned long long rt() { return __builtin_amdgcn_s_memrealtime(); }
__device__ __forceinline__ unsigned f2bf(float f) { unsigned u = __builtin_bit_cast(unsigned, f); return (u + 0x7fffu + ((u >> 16) & 1u)) >> 16; }
__device__ __forceinline__ unsigned pk2(float lo, float hi) { return f2bf(lo) | (f2bf(hi) << 16); }

#define XB_TMO      128
#define XB_XCNT(j)  (256  + 64 * (j))
#define XB_XSUB(j)  (1280 + 64 * (j))
#define XB_XGEN(j)  (2304 + 64 * (j))
#define XB_TOP      3328
#define XB_TOPGEN   3392
#define XCD_BAR_WORDS 3456
#define XB_SPIN_CAP (1u << 18)

__device__ __forceinline__ unsigned xb_ld(unsigned* p)              { return __hip_atomic_load(p, __ATOMIC_RELAXED, __HIP_MEMORY_SCOPE_AGENT); }
__device__ __forceinline__ unsigned xb_add(unsigned* p, unsigned v) { return __hip_atomic_fetch_add(p, v, __ATOMIC_RELAXED, __HIP_MEMORY_SCOPE_AGENT); }
__device__ __forceinline__ unsigned xb_xcc_id() { return (unsigned)__builtin_amdgcn_s_getreg((3 << 11) | 20) & 0xFu; }
#define XB_SPIN(cond, bar) do { unsigned _sp = 0; while (cond) { __builtin_amdgcn_s_sleep(1); \
    if ((++_sp & 255u) == 0u) { if (xb_ld(&(bar)[XB_TMO])) break; if (_sp > XB_SPIN_CAP) { atomicAdd(&(bar)[XB_TMO], 1u); break; } } } } while (0)

struct XcdBarrier {
    unsigned* bar; unsigned x;
    volatile LAS unsigned* st;
};

__device__ __forceinline__ XcdBarrier xcd_barrier_post(unsigned* bar, volatile LAS unsigned* st) {
    XcdBarrier b; b.bar = bar; b.x = xb_xcc_id(); b.st = st;
    if (threadIdx.x == 0) (void)xb_add(&bar[XB_XCNT(b.x)], 1u);
    return b;
}
__device__ __forceinline__ void xcd_barrier_complete(unsigned* bar, unsigned x, unsigned& nloc, unsigned& nx) {
    const unsigned G = gridDim.x * gridDim.y * gridDim.z;
    unsigned sum, cnt, mine, sp = 0u;
    for (;;) {
        sum = 0u; cnt = 0u; mine = 0u;
#pragma unroll
        for (unsigned j = 0; j < 16; ++j) { const unsigned c = xb_ld(&bar[XB_XCNT(j)]); sum += c; cnt += (c > 0u) ? 1u : 0u; mine = (j == x) ? c : mine; }
        if (sum == G) break;
        __builtin_amdgcn_s_sleep(1);
        if ((++sp & 255u) == 0u) { if (xb_ld(&bar[XB_TMO])) break; if (sp > XB_SPIN_CAP) { atomicAdd(&bar[XB_TMO], 1u); break; } }
    }
    nloc = mine > 0u ? mine : 1u; nx = cnt > 0u ? cnt : 1u;
}

__device__ __forceinline__ void xcd_barrier(const XcdBarrier& b) {
    asm volatile("s_waitcnt vmcnt(0)" ::: "memory");
    __syncthreads();
    if (threadIdx.x == 0) {
        unsigned* bar = b.bar; unsigned bx = b.x;
        asm volatile("" : "+s"(bar), "+s"(bx));
        __builtin_amdgcn_s_waitcnt(0);
        unsigned nloc = b.st[0], nx = b.st[1];
        if (nloc == 0u) { xcd_barrier_complete(bar, bx, nloc, nx); b.st[0] = nloc; b.st[1] = nx; }
        const unsigned old = xb_add(&bar[XB_XSUB(bx)], 1u);
        const unsigned gen = old / nloc;
        if (old + 1u == (gen + 1u) * nloc) {
            __builtin_amdgcn_fence(__ATOMIC_RELEASE, "agent");
            asm volatile("s_waitcnt vmcnt(0)" ::: "memory");
            const unsigned og = xb_add(&bar[XB_TOP], 1u);
            const unsigned tg = og / nx;
            if (og + 1u == (tg + 1u) * nx) xb_add(&bar[XB_TOPGEN], 1u);
            else XB_SPIN(xb_ld(&bar[XB_TOPGEN]) == tg, bar);
            __builtin_amdgcn_fence(__ATOMIC_ACQUIRE, "agent");
            xb_add(&bar[XB_XGEN(bx)], 1u);
            asm volatile("s_waitcnt vmcnt(0)" ::: "memory");
        } else {
            XB_SPIN(xb_ld(&bar[XB_XGEN(bx)]) == gen, bar);
            __builtin_amdgcn_fence(__ATOMIC_ACQUIRE, "agent");
            asm volatile("s_waitcnt vmcnt(0)" ::: "memory");
        }
    }
    __syncthreads();
}
struct Frame {
    LAS unsigned char* lds;
    volatile LAS unsigned* MISC;
    gu32* ctl;
    int tid, lane, wave;
    int vcu, G;
    unsigned char* ws;
};
struct Args { const float* in[19]; float* out; unsigned char* ws; int ph_lo, ph_hi, rep_mask, pad; };
__device__ __forceinline__ const float* ld_in(const Args& a, int i) { asm volatile("" : "+s"(i)); return a.in[i]; }
__device__ __forceinline__ unsigned char* ld_ws(const Args& a) { int i = 0; asm volatile("" : "+s"(i)); return (&a.ws)[i]; }
enum { I_X = 0, I_C, I_WADA, I_BADA, I_GMIX, I_WIN, I_CONVW, I_WAUP, I_WBOUT, I_WO, I_GFFN, I_WRG, I_BRG, I_WRE, I_BRE, I_WEG, I_WEU, I_WED, I_GFIN };

__device__ __forceinline__ float wave_sum(float v) {
#pragma unroll
    for (int o = 1; o < 64; o <<= 1) v += __shfl_xor(v, o);
    return v;
}
__device__ __forceinline__ float bfu_lo(unsigned w) { return __builtin_bit_cast(float, w << 16); }
__device__ __forceinline__ float bfu_hi(unsigned w) { return __builtin_bit_cast(float, w & 0xffff0000u); }

__device__ __forceinline__ void p0_mod(Frame& F, const Args& A, int rep) {
    LAS float* sc = (LAS float*)(F.lds);
    LAS float* red = (LAS float*)(F.lds + 16384);
    const float* c = ld_in(A, I_C); const float* W = ld_in(A, I_WADA); const float* bias = ld_in(A, I_BADA);
    float* mod = (float*)(F.ws + WS_MOD);
    for (int i = F.tid; i < 2 * D; i += NWAVES * 64) { const float v = c[i]; sc[i] = v / (1.0f + __expf(-v)); }
    __syncthreads();
    const int cq = F.tid % 12, rr = F.tid / 12;
    for (int cc = F.vcu; cc < (NMOD / 48) * rep; cc += F.G) { const int cg = cc & (NMOD / 48 - 1);
        f32x4 a0 = {0.f, 0.f, 0.f, 0.f}, a1 = {0.f, 0.f, 0.f, 0.f};
        if (rr < 42) {
            const float* wp = W + (size_t)cg * 48 + cq * 4;
#pragma unroll 8
            for (int k = rr; k < D; k += 42) { const f32x4 w = *(const f32x4*)(wp + (size_t)k * NMOD); a0 += sc[k] * w; a1 += sc[D + k] * w; }
#pragma unroll
            for (int i = 0; i < 4; ++i) { red[rr * 96 + cq * 4 + i] = a0[i]; red[rr * 96 + 48 + cq * 4 + i] = a1[i]; }
        }
        __syncthreads();
        if (F.tid < 96) { const int b = F.tid / 48, col = F.tid % 48; float s = 0.f;
            for (int r = 0; r < 42; ++r) s += red[r * 96 + F.tid];
            mod[(size_t)b * NMOD + cg * 48 + col] = s + bias[cg * 48 + col]; }
        __syncthreads();
    }
}
struct CvtItem { const float* W; bf16* WT; int N, pitch, row0, k0, n0; };
constexpr int CV_NB_IN = (NPROJ + 31) / 32;
constexpr int CV_I_IN = 32 * CV_NB_IN, CV_I_A = 16 * 64, CV_I_B = 16 * 64, CV_I_O = 32 * 64, CV_I_G = NE * 32 * 16, CV_I_U = CV_I_G, CV_I_D = NE * 8 * 64;
constexpr int CV_NITEMS = CV_I_IN + CV_I_A + CV_I_B + CV_I_O + CV_I_G + CV_I_U + CV_I_D;
__device__ __forceinline__ CvtItem cvt_decode(Frame& F, const Args& A, int it) {
    CvtItem d; int r = it;
    if (r < CV_I_IN) { const int kb = r / CV_NB_IN, nb = r % CV_NB_IN; d.W = ld_in(A, I_WIN); d.N = NPROJ; d.WT = (bf16*)(F.ws + WS_WIN); d.pitch = D; d.row0 = 32 * nb; d.k0 = 64 * kb; d.n0 = 32 * nb; return d; } r -= CV_I_IN;
    if (r < CV_I_A) { const int kb = r / 64, nb = r % 64; d.W = ld_in(A, I_WAUP); d.N = D; d.WT = (bf16*)(F.ws + WS_WMIX); d.pitch = 1024; d.row0 = 32 * nb; d.k0 = 64 * kb; d.n0 = 32 * nb; return d; } r -= CV_I_A;
    if (r < CV_I_B) { const int kb = r / 64, nb = r % 64; d.W = ld_in(A, I_WBOUT); d.N = D; d.WT = (bf16*)(F.ws + WS_WMIX + (size_t)D * 1024 * 2); d.pitch = 1024; d.row0 = 32 * nb; d.k0 = 64 * kb; d.n0 = 32 * nb; return d; } r -= CV_I_B;
    if (r < CV_I_O) { const int kb = r / 64, nb = r % 64; d.W = ld_in(A, I_WO); d.N = D; d.WT = (bf16*)(F.ws + WS_WMIX + (size_t)D * 1024 * 4); d.pitch = D; d.row0 = 32 * nb; d.k0 = 64 * kb; d.n0 = 32 * nb; return d; } r -= CV_I_O;
    if (r < CV_I_G + CV_I_U) { const int up = r >= CV_I_G; if (up) r -= CV_I_G; const int e = r / 512, q = r % 512, kb = q / 16, nb = q % 16, n0 = 32 * nb;
        d.W = ld_in(A, up ? I_WEU : I_WEG) + (size_t)e * D * FF; d.N = FF; d.WT = (bf16*)(F.ws + WS_WGU); d.pitch = D; d.row0 = e * 1024 + (n0 >> 7) * 256 + up * 128 + (n0 & 127); d.k0 = 64 * kb; d.n0 = n0; return d; } r -= CV_I_G + CV_I_U;
    { const int e = r / 512, q = r % 512, kb = q / 64, nb = q % 64;
        d.W = ld_in(A, I_WED) + (size_t)e * FF * D; d.N = D; d.WT = (bf16*)(F.ws + WS_WDN); d.pitch = FF; d.row0 = e * D + 32 * nb; d.k0 = 64 * kb; d.n0 = 32 * nb; return d; }
}
__device__ __forceinline__ void p0_convert(Frame& F, const Args& A, int it0, int it1, int worker, int nworkers, int rep) {
    LAS float* scr = (LAS float*)(F.lds + 32768 + F.wave * 8704);
    const int lane = F.lane, cq = lane & 7, rr = lane >> 3, n = it1 - it0;
    for (int base = worker * 4; base < n * rep; base += nworkers * 4) {
        CvtItem d[4]; f32x4 v[4][8]; bool ok[4];
#pragma unroll
        for (int q = 0; q < 4; ++q) { int x = base + q; ok[q] = x < n * rep; if (!ok[q]) x = base; if (x >= n) x -= n; d[q] = cvt_decode(F, A, it0 + x);
            const bool cv = d[q].n0 + 4 * cq < d[q].N;
#pragma unroll
            for (int i = 0; i < 8; ++i) v[q][i] = cv ? *(const GAS f32x4*)(d[q].W + (size_t)(d[q].k0 + rr + 8 * i) * d[q].N + d[q].n0 + 4 * cq) : (f32x4){0.f, 0.f, 0.f, 0.f}; }
#pragma unroll
        for (int q = 0; q < 4; ++q) {
#pragma unroll
            for (int i = 0; i < 8; ++i) { LAS float* p = scr + (rr + 8 * i) * 33 + 4 * cq; p[0] = v[q][i].x; p[1] = v[q][i].y; p[2] = v[q][i].z; p[3] = v[q][i].w; }
            LDS_WAIT(); asm volatile("" ::: "memory");
#pragma unroll
            for (int j = 0; j < 4; ++j) { const int nn = rr + 8 * j; const LAS float* s = scr + (8 * cq) * 33 + nn;
                v4u o; o.x = pk2(s[0 * 33], s[1 * 33]); o.y = pk2(s[2 * 33], s[3 * 33]); o.z = pk2(s[4 * 33], s[5 * 33]); o.w = pk2(s[6 * 33], s[7 * 33]);
                if (ok[q] && d[q].n0 + nn < d[q].N) *(GAS v4u*)(d[q].WT + (size_t)(d[q].row0 + nn) * d[q].pitch + d[q].k0 + 8 * cq) = o; }
            LDS_WAIT(); asm volatile("" ::: "memory");
        }
    }
}
__device__ __forceinline__ void p0_router_w(Frame& F, const Args& A) {
    bf16* WR = (bf16*)(F.ws + WS_WR); const float* wrg = ld_in(A, I_WRG); const float* wre = ld_in(A, I_WRE);
    for (int i = F.vcu * (NWAVES * 64) + F.tid; i < 64 * D; i += F.G * NWAVES * 64) { const int n = i / D, k = i % D;
        const float v = n < 4 ? wrg[k * 4 + n] : (n < 36 ? wre[k * 32 + (n - 4)] : 0.f); WR[i] = (bf16)f2bf(v); }
}
__device__ __forceinline__ void row_norm_mod_bf16(const float* xrow, const float* g, const float* sc, const float* sh, bf16* orow, int lane) {
    const GAS f32x4* xr = (const GAS f32x4*)xrow + lane; f32x4 v[8]; float s = 0.f;
#pragma unroll
    for (int j = 0; j < 8; ++j) { v[j] = xr[64 * j]; s += (v[j].x * v[j].x + v[j].y * v[j].y) + (v[j].z * v[j].z + v[j].w * v[j].w); }
    const float r = 1.0f / sqrtf(wave_sum(s) * (1.0f / D) + EPS);
    GAS unsigned long long* o8 = (GAS unsigned long long*)orow + lane;
#pragma unroll
    for (int j = 0; j < 8; ++j) { const f32x4 gg = ((const GAS f32x4*)g)[lane + 64 * j], ss = ((const GAS f32x4*)sc)[lane + 64 * j], hh = ((const GAS f32x4*)sh)[lane + 64 * j];
        const f32x4 o = (v[j] * r) * gg * (1.0f + ss) + hh;
        o8[64 * j] = (unsigned long long)pk2(o.x, o.y) | ((unsigned long long)pk2(o.z, o.w) << 32); }
}
__device__ __forceinline__ void p_norm_rows(Frame& F, const Args& A, const float* X, const float* g, int which, int rep) {
    const int gw = F.vcu * NWAVES + F.wave, NGW = F.G * NWAVES;
    const float* mod = (const float*)(F.ws + WS_MOD); bf16* H = (bf16*)(F.ws + WS_H);
    for (int mm = gw; mm < M * rep; mm += NGW) { const int m = mm & (M - 1); const float* mb = mod + (size_t)(m / SEQ) * NMOD + which * 3 * D;
        row_norm_mod_bf16(X + (size_t)m * D, g, mb + D, mb, H + (size_t)m * D, F.lane); }
}
__device__ __forceinline__ void p4_select_row(const float* srow, unsigned long long* mrow, int t, int lane) {
    unsigned key[64];
    const int ng = (t >> 9) + 1;
#pragma unroll
    for (int g = 0; g < 8; ++g) {
        float raw[8];
        if (g < ng) {
#pragma unroll
            for (int i = 0; i < 8; ++i) raw[i] = srow[(8 * g + i) * 64 + lane];
        } else {
#pragma unroll
            for (int i = 0; i < 8; ++i) raw[i] = 0.f;
        }
#pragma unroll
        for (int i = 0; i < 8; ++i) { const int j = 8 * g + i; const unsigned u = __builtin_bit_cast(unsigned, raw[i]); const unsigned k = (u & 0x80000000u) ? ~u : (u | 0x80000000u);
            key[j] = (j * 64 + lane <= t) ? k : 0u; }
    }
    unsigned thr = 1u;
    if (t >= TOPK) {
        unsigned prefix = 0u;
        for (int bit = 31; bit >= 0; --bit) {
            const unsigned cand = prefix | (1u << bit); unsigned c = 0u;
#pragma unroll
            for (int g = 0; g < 8; ++g) { if (g < ng) {
#pragma unroll
                for (int j = 8 * g; j < 8 * g + 8; ++j) c += key[j] >= cand ? 1u : 0u; } }
            unsigned cnt = 0u;
#pragma unroll
            for (int q = 0; q < 7; ++q) cnt += (unsigned)__popcll(__ballot((c >> q) & 1u)) << q;
            if (cnt >= (unsigned)TOPK) { prefix = cand; if (cnt == (unsigned)TOPK) break; }
        }
        thr = prefix;
    }
    unsigned mlo = 0u, mhi = 0u;
#define P4_WL1(j) { const unsigned long long bm_ = __ballot(key[j] >= thr); const unsigned bl_ = (unsigned)bm_, bh_ = (unsigned)(bm_ >> 32); \
        asm volatile("s_nop 3\n\tv_writelane_b32 %0, %1, %2" : "+v"(mlo) : "s"(bl_), "i"(j)); asm volatile("s_nop 3\n\tv_writelane_b32 %0, %1, %2" : "+v"(mhi) : "s"(bh_), "i"(j)); }
#define P4_WL4(j) P4_WL1(j) P4_WL1((j) + 1) P4_WL1((j) + 2) P4_WL1((j) + 3)
#define P4_WL16(j) P4_WL4(j) P4_WL4((j) + 4) P4_WL4((j) + 8) P4_WL4((j) + 12)
    P4_WL16(0) P4_WL16(16) P4_WL16(32) P4_WL16(48)
#undef P4_WL16
#undef P4_WL4
#undef P4_WL1
    mrow[lane] = ((unsigned long long)mhi << 32) | mlo;
}
__device__ __forceinline__ void p4_select_own(Frame& F, const Args& A, int pair) {
    const float* S = (const float*)(F.ws + WS_SCORE); unsigned long long* MK = (unsigned long long*)(F.ws + WS_MASK);
    const int b = pair >> 7, p = pair & 127; int lane = F.lane; asm volatile("" : "+v"(lane));
#pragma unroll 1
    for (int z = 0; z < 4; ++z) { const int qb = (z & 1) ? 255 - p : p; const int t = qb * 16 + 2 * F.wave + (z >> 1); const size_t row = (size_t)b * SEQ + t;
        p4_select_row(S + row * SEQ, MK + row * 64, t, lane); }
}
__device__ __forceinline__ void p3_scores(Frame& F, const Args& A, int rep, int rep_sel) {
    const bf16* P = (const bf16*)(F.ws + WS_PROJ); float* S = (float*)(F.ws + WS_SCORE);
    const int c16 = F.lane & 15, kq = F.lane >> 4;
    for (int pp = F.vcu; pp < 256; pp += F.G) { const int pair = pp & 255;
        const int b = pair >> 7, p = pair & 127;
#pragma unroll 1
        for (int zz = 0; zz < 2 * rep; ++zz) { const int z = zz & 1;
            const int qb = z == 0 ? p : 255 - p;
            const size_t qrow = (size_t)b * SEQ + qb * 16 + c16;
            const bf16* qp = P + qrow * NP;
            bf16x8 bq[IDXH][2]; float w[IDXH];
#pragma unroll
            for (int h = 0; h < IDXH; ++h)
#pragma unroll
                for (int ks = 0; ks < 2; ++ks) bq[h][ks] = *(const bf16x8*)(qp + C_IQ + h * 64 + ks * 32 + kq * 8);
            { const v4u w0 = *(const v4u*)(qp + C_IW), w1 = *(const v4u*)(qp + C_IW + 8);
                w[0] = bfu_lo(w0.x); w[1] = bfu_hi(w0.x); w[2] = bfu_lo(w0.y); w[3] = bfu_hi(w0.y); w[4] = bfu_lo(w0.z); w[5] = bfu_hi(w0.z); w[6] = bfu_lo(w0.w); w[7] = bfu_hi(w0.w);
                w[8] = bfu_lo(w1.x); w[9] = bfu_hi(w1.x); w[10] = bfu_lo(w1.y); w[11] = bfu_hi(w1.y); w[12] = bfu_lo(w1.z); w[13] = bfu_hi(w1.z); w[14] = bfu_lo(w1.w); w[15] = bfu_hi(w1.w); }
            float* srow = S + qrow * SEQ + kq * 4;
            const bf16* kbase = P + ((size_t)b * SEQ + c16) * NP + C_IK + kq * 8;
            int kt = F.wave;
            bf16x8 a0 = {0, 0, 0, 0, 0, 0, 0, 0}, a1 = a0;
            if (kt <= qb) { const bf16* kp = kbase + (size_t)kt * 16 * NP; a0 = *(const bf16x8*)kp; a1 = *(const bf16x8*)(kp + 32); }
            for (; kt <= qb; kt += 8) {
                bf16x8 n0 = a0, n1 = a1;
                if (kt + 8 <= qb) { const bf16* kp = kbase + (size_t)(kt + 8) * 16 * NP; n0 = *(const bf16x8*)kp; n1 = *(const bf16x8*)(kp + 32); }
                f32x4 sc = {0.f, 0.f, 0.f, 0.f};
#pragma unroll
                for (int h = 0; h < IDXH; ++h) {
                    f32x4 acc = {0.f, 0.f, 0.f, 0.f};
                    acc = __builtin_amdgcn_mfma_f32_16x16x32_bf16(a0, bq[h][0], acc, 0, 0, 0);
                    acc = __builtin_amdgcn_mfma_f32_16x16x32_bf16(a1, bq[h][1], acc, 0, 0, 0);
#pragma unroll
                    for (int i = 0; i < 4; ++i) sc[i] += w[h] * fmaxf(acc[i], 0.f);
                }
                *(f32x4*)(srow + kt * 16) = sc;
                a0 = n0; a1 = n1;
            }
        }
        __syncthreads();
        for (int r_ = 0; r_ < rep_sel; ++r_) p4_select_own(F, A, pair);
        __syncthreads();
    }
}
__device__ __forceinline__ void p3_conv(Frame& F, const Args& A, int rep) {
    const bf16* P = (const bf16*)(F.ws + WS_PROJ); bf16* CB = (bf16*)(F.ws + WS_CB); const float* cw = ld_in(A, I_CONVW);
    const int nthr = F.G * NWAVES * 64;
    for (int ii = F.vcu * (NWAVES * 64) + F.tid; ii < M * 128 * rep; ii += nthr) { const int idx = ii & (M * 128 - 1);
        const int t = idx >> 7, ch = (idx & 127) * 8, tl = t & (SEQ - 1);
        float acc[8] = {0.f, 0.f, 0.f, 0.f, 0.f, 0.f, 0.f, 0.f};
#pragma unroll
        for (int j = 0; j < 3; ++j) { if (tl - 2 + j >= 0) { const bf16* rp = P + (size_t)(t - 2 + j) * NP;
            const v4u cg = *(const v4u*)(rp + C_CG + ch), xc = *(const v4u*)(rp + C_XC + ch);
            const f32x4 w0 = *(const f32x4*)(cw + j * 1024 + ch), w1 = *(const f32x4*)(cw + j * 1024 + ch + 4);
            acc[0] += w0.x * (bfu_lo(cg.x) * bfu_lo(xc.x)); acc[1] += w0.y * (bfu_hi(cg.x) * bfu_hi(xc.x)); acc[2] += w0.z * (bfu_lo(cg.y) * bfu_lo(xc.y)); acc[3] += w0.w * (bfu_hi(cg.y) * bfu_hi(xc.y));
            acc[4] += w1.x * (bfu_lo(cg.z) * bfu_lo(xc.z)); acc[5] += w1.y * (bfu_hi(cg.z) * bfu_hi(xc.z)); acc[6] += w1.z * (bfu_lo(cg.w) * bfu_lo(xc.w)); acc[7] += w1.w * (bfu_hi(cg.w) * bfu_hi(xc.w)); } }
        const v4u bg = *(const v4u*)(P + (size_t)t * NP + C_BG + ch);
        v4u o; o.x = pk2(bfu_lo(bg.x) * acc[0], bfu_hi(bg.x) * acc[1]); o.y = pk2(bfu_lo(bg.y) * acc[2], bfu_hi(bg.y) * acc[3]);
        o.z = pk2(bfu_lo(bg.z) * acc[4], bfu_hi(bg.z) * acc[5]); o.w = pk2(bfu_lo(bg.w) * acc[6], bfu_hi(bg.w) * acc[7]);
        *(v4u*)(CB + (size_t)t * 1024 + ch) = o;
    }
}
__device__ __forceinline__ void p7_norm_route(Frame& F, const Args& A, int rep) {
    const float* mod = (const float*)(F.ws + WS_MOD); bf16* H = (bf16*)(F.ws + WS_H); const bf16* WR = (const bf16*)(F.ws + WS_WR);
    const float* X2 = A.out; const float* gffn = ld_in(A, I_GFFN); const float* brg = ld_in(A, I_BRG); const float* bre = ld_in(A, I_BRE);
    int* rowtok = (int*)(F.ws + WS_ROWTOK); float* roww = (float*)(F.ws + WS_ROWW);
    LAS float* part = (LAS float*)(F.lds);
    const int grp = F.wave >> 2, q = F.wave & 3, c16 = F.lane & 15, kq = F.lane >> 4;
    for (int bb = F.vcu; bb < (M / 32) * rep; bb += F.G) { const int blk = bb & (M / 32 - 1); const bool lastpass = bb >= (M / 32) * (rep - 1);
        const int row0 = blk * 32 + grp * 16;
#pragma unroll 1
        for (int i = 0; i < 4; ++i) { const int m = row0 + q * 4 + i; const float* mb = mod + (size_t)(m / SEQ) * NMOD + 3 * D;
            row_norm_mod_bf16(X2 + (size_t)m * D, gffn, mb + D, mb, H + (size_t)m * D, F.lane); }
        __syncthreads();
        f32x4 acc[3] = {{0.f, 0.f, 0.f, 0.f}, {0.f, 0.f, 0.f, 0.f}, {0.f, 0.f, 0.f, 0.f}};
        const bf16* ap = H + (size_t)(row0 + c16) * D + q * 512 + kq * 8; const bf16* bp = WR + (size_t)c16 * D + q * 512 + kq * 8;
#pragma unroll 4
        for (int ks = 0; ks < 16; ++ks) { const bf16x8 a = *(const bf16x8*)(ap + ks * 32);
#pragma unroll
            for (int n = 0; n < 3; ++n) { const bf16x8 bfr = *(const bf16x8*)(bp + (size_t)n * 16 * D + ks * 32); acc[n] = __builtin_amdgcn_mfma_f32_16x16x32_bf16(a, bfr, acc[n], 0, 0, 0); } }
#pragma unroll
        for (int n = 0; n < 3; ++n)
#pragma unroll
            for (int i = 0; i < 4; ++i) part[(F.wave * 16 + kq * 4 + i) * 48 + n * 16 + c16] = acc[n][i];
        __syncthreads();
        if (F.tid < 32 && lastpass) { const int g2 = F.tid >> 4, r = F.tid & 15, t = blk * 32 + F.tid;
            float lg[36];
#pragma unroll
            for (int c = 0; c < 36; ++c) lg[c] = (part[((g2 * 4 + 0) * 16 + r) * 48 + c] + part[((g2 * 4 + 1) * 16 + r) * 48 + c]) + (part[((g2 * 4 + 2) * 16 + r) * 48 + c] + part[((g2 * 4 + 3) * 16 + r) * 48 + c]);
            float gl[NGRP]; int g = 0;
#pragma unroll
            for (int i = 0; i < NGRP; ++i) gl[i] = lg[i] + brg[i];
#pragma unroll
            for (int i = 1; i < NGRP; ++i) if (gl[i] > gl[g]) g = i;
            float den = 0.f;
#pragma unroll
            for (int i = 0; i < NGRP; ++i) den += __expf(gl[i] - gl[g]);
            const float pg = 1.0f / den;
            float v0 = -INFINITY, v1 = -INFINITY; int i0 = 0, i1 = 0;
#pragma unroll
            for (int gg = 0; gg < NGRP; ++gg) { if (gg == g) {
#pragma unroll
                for (int j = 0; j < EPG; ++j) { const float v = lg[4 + gg * EPG + j] + bre[gg * EPG + j];
                    if (v > v0) { v1 = v0; i1 = i0; v0 = v; i0 = j; } else if (v > v1) { v1 = v; i1 = j; } } } }
            const float e1 = __expf(v1 - v0), p0 = 1.0f / (1.0f + e1), p1 = e1 * p0;
            const int ea = g * EPG + i0, eb = g * EPG + i1;
            const unsigned pa = __hip_atomic_fetch_add(F.ctl + CW_CNT + 64 * ea, 1u, __ATOMIC_RELAXED, __HIP_MEMORY_SCOPE_AGENT);
            const unsigned pb = __hip_atomic_fetch_add(F.ctl + CW_CNT + 64 * eb, 1u, __ATOMIC_RELAXED, __HIP_MEMORY_SCOPE_AGENT);
            rowtok[(size_t)ea * M + pa] = t * 2 + 0; roww[(size_t)ea * M + pa] = pg * p0;
            rowtok[(size_t)eb * M + pb] = t * 2 + 1; roww[(size_t)eb * M + pb] = pg * p1;
        }
        __syncthreads();
    }
}
__device__ __forceinline__ void moe_table(Frame& F, const Args& A) {
    LAS int* tb = (LAS int*)(F.lds + TILEE_OFF);
    if (F.tid < NE) tb[200 + F.tid] = (int)__hip_atomic_load(F.ctl + CW_CNT + 64 * F.tid, __ATOMIC_RELAXED, __HIP_MEMORY_SCOPE_AGENT);
    __syncthreads();
    if (F.tid == 0) { int base = 0, nt = 0;
        for (int e = 0; e < NE; ++e) { const int c = tb[200 + e]; const int tl = (c + 255) >> 8;
            tb[128 + e] = base; for (int i = 0; i < tl; ++i) tb[nt + i] = e; nt += tl; base += tl * 256; }
        tb[192] = nt; }
    __syncthreads();
}
__device__ __forceinline__ void p7_gather(Frame& F, const Args& A, int rep) {
    moe_table(F, A);
    const LAS int* tb = (const LAS int*)(F.lds + TILEE_OFF);
    const int nrows = tb[192] * 256; const int gw = F.vcu * NWAVES + F.wave, NGW = F.G * NWAVES;
    const bf16* H = (const bf16*)(F.ws + WS_H); bf16* HS = (bf16*)(F.ws + WS_HS);
    const int* rowtok = (const int*)(F.ws + WS_ROWTOK); const float* roww = (const float*)(F.ws + WS_ROWW);
    int* rowtok2 = (int*)(F.ws + WS_ROWTOK2); float* roww2 = (float*)(F.ws + WS_ROWW2);
    for (int RR = gw; RR < nrows * rep; RR += NGW) { const int R = RR >= nrows ? RR - nrows : RR;
        const int e = tb[R >> 8]; const int i = R - tb[128 + e];
        const int cnt = tb[200 + e];
        if (i < cnt) { const int tk = rowtok[(size_t)e * M + i]; const float w = roww[(size_t)e * M + i];
            const GAS v4u* src = (const GAS v4u*)(H + (size_t)(tk >> 1) * D) + F.lane; GAS v4u* dst = (GAS v4u*)(HS + (size_t)R * D) + F.lane;
#pragma unroll
            for (int j = 0; j < 4; ++j) dst[64 * j] = src[64 * j];
            if (F.lane == 0) { rowtok2[R] = tk; roww2[R] = w; } }
        else { GAS v4u* dst = (GAS v4u*)(HS + (size_t)R * D) + F.lane; const v4u z = {0u, 0u, 0u, 0u};
#pragma unroll
            for (int j = 0; j < 4; ++j) dst[64 * j] = z;
            if (F.lane == 0) { rowtok2[R] = -1; roww2[R] = 0.f; } }
    }
}
__device__ __forceinline__ void p9_final(Frame& F, const Args& A, int rep) {
    const int gw = F.vcu * NWAVES + F.wave, NGW = F.G * NWAVES;
    const float* mod = (const float*)(F.ws + WS_MOD); const bf16* Y = (const bf16*)(F.ws + WS_Y); const float* gf = ld_in(A, I_GFIN);
    for (int mm = gw + M * (rep - 1); mm >= gw; mm -= M) for (int m = mm - (mm / M) * M; m < M; m += NGW) { const bool dry = mm >= M;
        const float* g2 = mod + (size_t)(m / SEQ) * NMOD + 5 * D;
        GAS f32x4* xr = (GAS f32x4*)(A.out + (size_t)m * D) + F.lane; GAS f32x4* xw = dry ? (GAS f32x4*)((float*)(F.ws + WS_HS) + (size_t)m * D) + F.lane : xr;
        const GAS unsigned long long* y0 = (const GAS unsigned long long*)(Y + (size_t)m * D) + F.lane; const GAS unsigned long long* y1 = (const GAS unsigned long long*)(Y + ((size_t)M + m) * D) + F.lane;
        f32x4 v[8]; float s = 0.f;
#pragma unroll
        for (int j = 0; j < 8; ++j) { const f32x4 x = xr[64 * j]; const f32x4 gg = ((const GAS f32x4*)g2)[F.lane + 64 * j]; const unsigned long long a = y0[64 * j], bq = y1[64 * j];
            const unsigned al = (unsigned)a, ah = (unsigned)(a >> 32), bl = (unsigned)bq, bh = (unsigned)(bq >> 32);
            f32x4 ys; ys.x = bfu_lo(al) + bfu_lo(bl); ys.y = bfu_hi(al) + bfu_hi(bl); ys.z = bfu_lo(ah) + bfu_lo(bh); ys.w = bfu_hi(ah) + bfu_hi(bh);
            v[j] = x + gg * ys; s += (v[j].x * v[j].x + v[j].y * v[j].y) + (v[j].z * v[j].z + v[j].w * v[j].w); }
        const float r = 1.0f / sqrtf(wave_sum(s) * (1.0f / D) + EPS);
#pragma unroll
        for (int j = 0; j < 8; ++j) { const f32x4 gg = ((const GAS f32x4*)gf)[F.lane + 64 * j]; xw[64 * j] = (v[j] * r) * gg; }
    }
}

#ifndef SELFCHECK
#define SELFCHECK 0
#endif
#if SELFCHECK
constexpr size_t WS_CHK = 1 * MiB + 512 * 1024;
__device__ __forceinline__ float bf2f(bf16 v) { return __builtin_bit_cast(float, (unsigned)v << 16); }
__device__ __forceinline__ void p5_check(Frame& F, const Args& A) {
    if (F.wave >= 4) return;
    LAS float* sc = (LAS float*)(F.lds + F.wave * 32768);
    LAS float* iq = sc + 4096;
    LAS float* qv = iq + 1024;
    const bf16* P = (const bf16*)(F.ws + WS_PROJ); const float* S = (const float*)(F.ws + WS_SCORE); const bf16* OAp = (const bf16*)(F.ws + WS_OA);
    unsigned* res = (unsigned*)(F.ws + WS_CHK);
    const int lane = F.lane, sid = F.vcu * 4 + F.wave;
    const int b = sid & 1, h = (sid >> 1) & 15, tsel = sid >> 5;
    const int t = (tsel * 128 + ((h * 37 + b * 11) & 127)) & (SEQ - 1);
    const size_t row = (size_t)b * SEQ + t; const bf16* pr = P + row * NP;
    for (int i = lane; i < 1024; i += 64) iq[i] = bf2f(pr[C_IQ + i]);
    qv[lane] = bf2f(pr[C_Q + h * 64 + lane]);
    if (lane < 16) qv[64 + lane] = bf2f(pr[C_IW + lane]);
    for (int s = lane; s < SEQ; s += 64) sc[s] = s <= t ? S[row * SEQ + s] : -INFINITY;
    LDS_WAIT(); asm volatile("" ::: "memory");
    float e1 = 0.f;
#pragma unroll 1
    for (int s = lane * 8 + (sid & 7); s <= t; s += 512) {
        const bf16* kp = P + ((size_t)b * SEQ + s) * NP + C_IK; float kk[64];
#pragma unroll
        for (int d = 0; d < 64; ++d) kk[d] = bf2f(kp[d]);
        float tot = 0.f, mag = 0.f;
#pragma unroll 1
        for (int hh = 0; hh < 16; ++hh) { float dot = 0.f;
#pragma unroll
            for (int d = 0; d < 64; ++d) dot += iq[hh * 64 + d] * kk[d];
            const float r = fmaxf(dot, 0.f), w = qv[64 + hh]; tot += w * r; mag += fabsf(w) * r; }
        e1 = fmaxf(e1, fabsf(tot - sc[s]) / (mag + 1e-6f));
    }
    float own[64]; int cnt[64];
#pragma unroll
    for (int j = 0; j < 64; ++j) { own[j] = sc[lane + 64 * j]; cnt[j] = 0; }
#pragma clang loop vectorize(disable) interleave(disable) unroll(disable)
    for (int s2 = 0; s2 <= t; ++s2) { const float v = sc[s2];
#pragma unroll
        for (int j = 0; j < 64; ++j) cnt[j] += v > own[j] ? 1 : 0; }
#pragma unroll
    for (int j = 0; j < 64; ++j) sc[lane + 64 * j] = (lane + 64 * j <= t && cnt[j] < TOPK) ? 1.0f : 0.0f;
    LDS_WAIT(); asm volatile("" ::: "memory");
    const int g = h >> 2; float mx = -INFINITY;
#pragma unroll 1
    for (int j = 0; j < 64; ++j) { const int s = lane + 64 * j; float l = -INFINITY;
        if (sc[s] != 0.f) { const bf16* kp = P + ((size_t)b * SEQ + s) * NP + C_K + g * 64; float dot = 0.f;
            for (int d = 0; d < 64; ++d) dot += qv[d] * bf2f(kp[d]);
            l = dot; }
        sc[s] = l; mx = fmaxf(mx, l); }
#pragma unroll
    for (int o = 1; o < 64; o <<= 1) mx = fmaxf(mx, __shfl_xor(mx, o));
    float lsum = 0.f;
    LDS_WAIT(); asm volatile("" ::: "memory");
#pragma unroll 1
    for (int j = 0; j < 64; ++j) { const int s = lane + 64 * j; const float l = sc[s]; const float p = l == -INFINITY ? 0.f : __builtin_amdgcn_exp2f(l - mx); lsum += p; sc[s] = p; }
    lsum = wave_sum(lsum);
    LDS_WAIT(); asm volatile("" ::: "memory");
    float o = 0.f;
#pragma unroll 1
    for (int s = 0; s <= t; ++s) { const float p = sc[s]; if (p != 0.f) o += p * bf2f(P[((size_t)b * SEQ + s) * NP + C_V + g * 64 + lane]); }
    o /= lsum;
    float om = fabsf(o);
#pragma unroll
    for (int x = 1; x < 64; x <<= 1) om = fmaxf(om, __shfl_xor(om, x));
    float e2 = fabsf(o - bf2f(OAp[row * 1024 + h * 64 + lane])) / (om + 1e-20f);
#pragma unroll
    for (int x = 1; x < 64; x <<= 1) { e1 = fmaxf(e1, __shfl_xor(e1, x)); e2 = fmaxf(e2, __shfl_xor(e2, x)); }
    if (lane == 0) { atomicMax(res, __builtin_bit_cast(unsigned, e1)); atomicMax(res + 1, __builtin_bit_cast(unsigned, e2)); }
}
#endif
constexpr int NPHASE = 11;
#ifndef NCONV
#define NCONV 0
#endif
#ifndef REP_MASK
#define REP_MASK 0x0000
#endif
#define NREP(k) (1 + ((rep_mask_ >> (k)) & 1))
__global__ void __launch_bounds__(NWAVES * 64, 2) mk_fwd(Args args) {
    extern __shared__ __attribute__((aligned(16))) unsigned char lds[];
    Frame F;
    F.lds = (LAS unsigned char*)lds;
    F.MISC = (volatile LAS unsigned*)(F.lds + MISC_OFF);
    F.tid = threadIdx.x; F.lane = F.tid & 63; F.wave = __builtin_amdgcn_readfirstlane(F.tid >> 6);
    F.G = gridDim.x; { const int bx = blockIdx.x; F.vcu = (F.G % 8 == 0) ? (bx % 8) * (F.G / 8) + bx / 8 : bx; }
    F.ws = args.ws; F.ctl = (gu32*)(args.ws + WS_CTL);
    const Args& A = args;
    for (int u = F.tid; u < (LDS_BYTES - LDSCTL_OFF) / 4; u += NWAVES * 64) ((LAS unsigned*)(F.lds + LDSCTL_OFF))[u] = 0u;
    __syncthreads();
    XcdBarrier bar; bar.bar = (unsigned*)(F.ctl + CW_BAR); bar.x = 0; bar.st = nullptr;
    if (N_LAUNCHES == 1) bar = xcd_barrier_post((unsigned*)(F.ctl + CW_BAR), F.MISC + 8);
#define GRID_BAR() do { if (N_LAUNCHES == 1) { xcd_barrier(bar); } } while (0)
    const int lo = args.ph_lo, hi = args.ph_hi, rep_mask_ = args.rep_mask;
#ifndef PHMASK
#define PHMASK 0xFFFF
#endif
#define IN(k) (((PHMASK >> (k)) & 1) && lo <= (k) && (k) < hi)
#define BOTH(k) (IN(k) && IN((k) + 1))
#define PHASE_FENCE() do { asm volatile("" : "+v"(F.tid), "+v"(F.lane)); F.ws = ld_ws(A); F.ctl = (gu32*)(F.ws + WS_CTL); } while (0)

#define W_H ((bf16*)(F.ws + WS_H))
#define W_PROJ ((bf16*)(F.ws + WS_PROJ))
#define W_OA ((bf16*)(F.ws + WS_OA))
#define W_CB ((bf16*)(F.ws + WS_CB))
#define W_MERGED ((bf16*)(F.ws + WS_MERGED))
#define W_WT_in ((bf16*)(F.ws + WS_WIN))
#define W_WT_aup ((bf16*)(F.ws + WS_WMIX))
#define W_WT_bout ((bf16*)(F.ws + WS_WMIX + (size_t)D * 1024 * 2))
#define W_WT_o ((bf16*)(F.ws + WS_WMIX + (size_t)D * 1024 * 4))
#define W_WT_gu ((bf16*)(F.ws + WS_WGU))
#define W_WT_dn ((bf16*)(F.ws + WS_WDN))
#define W_WR ((bf16*)(F.ws + WS_WR))
#define W_HS ((bf16*)(F.ws + WS_HS))
#define W_ACT ((bf16*)(F.ws + WS_ACT))
#define W_Y ((bf16*)(F.ws + WS_Y))
#define W_mod ((const float*)(F.ws + WS_MOD))
#define W_ws F.ws

    const int nconv = (F.G == 256) ? NCONV : 0;
    if (IN(0)) { PHASE_FENCE(); p0_mod(F, A, NREP(14)); p0_router_w(F, A); p0_convert(F, A, 0, nconv ? CV_I_IN : CV_NITEMS, F.vcu * NWAVES + F.wave, F.G * NWAVES, NREP(0)); if (BOTH(0)) GRID_BAR(); }
    if (IN(1)) { PHASE_FENCE(); p_norm_rows(F, A, ld_in(A, I_X), ld_in(A, I_GMIX), 0, NREP(1)); if (BOTH(1)) GRID_BAR(); }
    if (IN(2)) { PHASE_FENCE();
        if ((int)blockIdx.x >= F.G - nconv) {
            p0_convert(F, A, CV_I_IN, CV_NITEMS, ((int)blockIdx.x - (F.G - nconv)) * NWAVES + F.wave, nconv * NWAVES, NREP(15));
        } else {
        pg8::Gemm g{W_H, W_WT_in, M, NP, D}; pg8::StaticOrder S; S.init(M, NP, F.G - nconv, (int)blockIdx.x); S.rep = NREP(2);
        pg8::EpiBf16<0> E{W_PROJ, NP, nullptr, 1024, 1024, attn_body::C2};
        pg8::gemm_phase<pg8::EpiBf16<0>, pg8::StaticOrder, PG8_ALIGN, PG8_SP2>(F.lds + RING_OFF, g, S, E);
        }
        if (BOTH(2)) GRID_BAR();
    }
    if (IN(3)) { PHASE_FENCE(); p3_scores(F, A, NREP(3), NREP(12)); p3_conv(F, A, NREP(13)); if (BOTH(3)) GRID_BAR(); }
    if (IN(4)) { PHASE_FENCE();
        static_assert(attn_body::ATTN_LDS_BYTES <= RING_BYTES, "attention body LDS vs frame");
        const attn_body::AttnTensors AT{(const attn_body::bf16*)(W_PROJ + C_Q), (const attn_body::bf16*)(W_PROJ + C_K), (const attn_body::bf16*)(W_PROJ + C_V), (attn_body::bf16*)W_OA, (const unsigned long long*)(W_ws + WS_MASK)};
        attn_body::StaticOrder S((int)F.G, (int)blockIdx.x); S.rep = NREP(4);
        attn_body::attn_phase<attn_body::StaticOrder>((char*)lds + RING_OFF, AT, S);
#if SELFCHECK
        GRID_BAR(); if (blockIdx.x == 0 && F.tid < 2) ((unsigned*)(F.ws + WS_CHK))[F.tid] = 0u; GRID_BAR(); __syncthreads(); p5_check(F, A); __syncthreads();
#endif
        if (BOTH(4)) GRID_BAR();
    }
    if (IN(5)) { PHASE_FENCE();
        { pg8::Gemm g{W_OA, W_WT_aup, M, D, 1024}; pg8::StaticOrder S; S.init(M, D, F.G, (int)blockIdx.x); S.rep = NREP(5);
          pg8::EpiGate E{W_MERGED, D, W_PROJ, NP, C_GA, 0};
          pg8::gemm_phase<pg8::EpiGate, pg8::StaticOrder, PG8_ALIGN, PG8_SP2>(F.lds + RING_OFF, g, S, E); }
        asm volatile("s_waitcnt vmcnt(0)" ::: "memory"); __syncthreads();
        { pg8::Gemm g{W_CB, W_WT_bout, M, D, 1024}; pg8::StaticOrder S; S.init(M, D, F.G, (int)blockIdx.x);
          pg8::EpiGate E{W_MERGED, D, W_PROJ, NP, C_GB, 1};
          pg8::gemm_phase<pg8::EpiGate, pg8::StaticOrder, PG8_ALIGN, PG8_SP2>(F.lds + RING_OFF, g, S, E); }
        if (BOTH(5)) GRID_BAR();
    }
    if (IN(6)) { PHASE_FENCE();
        pg8::Gemm g{W_MERGED, W_WT_o, M, D, D}; pg8::StaticOrder S; S.init(M, D, F.G, (int)blockIdx.x); S.rep = NREP(6);
        pg8::EpiRes E{ld_in(A, I_X), A.out, W_mod + 2 * D, NMOD, D, SEQ};
        pg8::gemm_phase<pg8::EpiRes, pg8::StaticOrder, PG8_ALIGN, PG8_SP2>(F.lds + RING_OFF, g, S, E);
        if (BOTH(6)) GRID_BAR();
    }
    if (IN(7)) { PHASE_FENCE(); p7_norm_route(F, A, NREP(7)); if (BOTH(7)) GRID_BAR(); }
    if (IN(8)) { PHASE_FENCE();
        moe_table(F, A); const LAS int* tb = (const LAS int*)(F.lds + TILEE_OFF);
        pg8::Gemm g{W_H, W_WT_gu, ROWCAP, NE * 1024, D}; pg8::MoeOrder S{tb, __builtin_amdgcn_readfirstlane(tb[192]), 4, F.G, (int)blockIdx.x, NREP(8)};
        pg8::EpiAct E{W_ACT, (const float*)(W_ws + WS_ROWW), tb, M};
        pg8::GatherTab gt{(const int*)(W_ws + WS_ROWTOK), tb, M};
        pg8::gemm_phase<pg8::EpiAct, pg8::MoeOrder, PG8_ALIGN, PG8_SP2, true>(F.lds + RING_OFF, g, S, E, gt);
        if (BOTH(8)) GRID_BAR();
    }
    if (IN(9)) { PHASE_FENCE();
        moe_table(F, A); const LAS int* tb = (const LAS int*)(F.lds + TILEE_OFF);
        pg8::Gemm g{W_ACT, W_WT_dn, ROWCAP, NE * D, FF}; pg8::MoeOrder S{tb, __builtin_amdgcn_readfirstlane(tb[192]), 8, F.G, (int)blockIdx.x, NREP(9)};
        pg8::EpiDown E{W_Y, (const int*)(W_ws + WS_ROWTOK), M, tb};
        pg8::gemm_phase<pg8::EpiDown, pg8::MoeOrder, PG8_ALIGN, PG8_SP2>(F.lds + RING_OFF, g, S, E);
        if (BOTH(9)) GRID_BAR();
    }
    if (IN(10)) { PHASE_FENCE(); p9_final(F, A, NREP(10));
#if SELFCHECK
        GRID_BAR();
        { const unsigned* res = (const unsigned*)(F.ws + WS_CHK); const float e1 = __builtin_bit_cast(float, __hip_atomic_load(res, __ATOMIC_RELAXED, __HIP_MEMORY_SCOPE_AGENT)), e2 = __builtin_bit_cast(float, __hip_atomic_load(res + 1, __ATOMIC_RELAXED, __HIP_MEMORY_SCOPE_AGENT));
          const float dl = 1.0f + fminf(10.f * e2, 3.f); float* op = A.out;
          for (size_t i = (size_t)F.vcu * (NWAVES * 64) + F.tid; i < (size_t)M * D; i += (size_t)F.G * NWAVES * 64) { float v = op[i] * dl; if (i == 0) v += 20.f + fminf(1e6f * e1, 80.f); op[i] = v; } }
#endif
    }
#undef W_H
#undef W_PROJ
#undef W_OA
#undef W_CB
#undef W_MERGED
#undef W_WT_in
#undef W_WT_aup
#undef W_WT_bout
#undef W_WT_o
#undef W_WT_gu
#undef W_WT_dn
#undef W_WR
#undef W_HS
#undef W_ACT
#undef W_Y
#undef W_mod
#undef W_ws
#undef IN
#undef BOTH
#undef GRID_BAR
}

extern "C" void kernel_launch(void* const* d_in, const int* in_sizes, int n_in, void* d_out, int out_size, void* d_ws, size_t ws_size, hipStream_t stream) {
    static int grid = 0;
    if (grid == 0) {
        if (n_in != 19 || in_sizes[0] != M * D || out_size != M * D || ws_size < WS_END) { fprintf(stderr, "kernel_launch: built for 19 inputs, x/out of %d floats, >= %zu bytes of workspace; got n_in %d, in0 %d, out %d, ws %zu; nothing launched\n", M * D, (size_t)WS_END, n_in, n_in > 0 ? in_sizes[0] : -1, out_size, ws_size); grid = -1; return; }
        int dev = 0, cus = 0, per_cu = 0;
        if (hipGetDevice(&dev) != hipSuccess || hipDeviceGetAttribute(&cus, hipDeviceAttributeMultiprocessorCount, dev) != hipSuccess) { fprintf(stderr, "kernel_launch: hipGetDevice / hipDeviceGetAttribute failed; nothing launched\n"); grid = -1; return; }
        if (hipFuncSetAttribute((const void*)mk_fwd, hipFuncAttributeMaxDynamicSharedMemorySize, LDS_BYTES) != hipSuccess) { fprintf(stderr, "kernel_launch: hipFuncSetAttribute failed\n"); grid = -1; return; }
        if (hipOccupancyMaxActiveBlocksPerMultiprocessor(&per_cu, (const void*)mk_fwd, NWAVES * 64, LDS_BYTES) != hipSuccess || per_cu < 1) { fprintf(stderr, "kernel_launch: occupancy query reports %d workgroups per CU; nothing launched\n", per_cu); (void)hipGetLastError(); grid = -1; return; }
        grid = cus;
    }
    if (grid < 0) return;
    if (hipMemsetAsync((char*)d_ws + WS_CTL, 0, CTL_ZERO_BYTES, stream) != hipSuccess) { fprintf(stderr, "kernel_launch: hipMemsetAsync of the control words failed; nothing launched\n"); return; }
    Args a{};
    for (int i = 0; i < 19; ++i) a.in[i] = (const float*)d_in[i];
    a.out = (float*)d_out; a.ws = (unsigned char*)d_ws;
    a.rep_mask = REP_MASK; a.pad = 0;
    if (N_LAUNCHES == 1) { a.ph_lo = 0; a.ph_hi = NPHASE; hipLaunchKernelGGL(mk_fwd, dim3(grid), dim3(NWAVES * 64), LDS_BYTES, stream, a); }
    else for (int li = 0; li < NPHASE; ++li) { a.ph_lo = li; a.ph_hi = li + 1; hipLaunchKernelGGL(mk_fwd, dim3(grid), dim3(NWAVES * 64), LDS_BYTES, stream, a); }
    const hipError_t le = hipPeekAtLastError();
    if (le != hipSuccess) fprintf(stderr, "kernel_launch: launch failed: %s (grid %d x %d threads, %d B LDS)\n", hipGetErrorName(le), grid, NWAVES * 64, LDS_BYTES);
}
```

```cpp
#include <hip/hip_runtime.h>
#include <cstdio>
#include <cstdint>
namespace pg8 {
#define PG8_LAS __attribute__((address_space(3)))
typedef unsigned short bf16_t;
typedef short bf16x8 __attribute__((ext_vector_type(8)));
typedef float f32x4 __attribute__((ext_vector_type(4)));
typedef unsigned u32x4 __attribute__((ext_vector_type(4)));
constexpr int BM = 256, BK = 64, HALF = 128, HTB = HALF * BK * 2  , STAGE_BYTES = 8 * HTB, NXCD = 8, WGM = 8;

__host__ __device__ __forceinline__ int lds_byte(int r, int c) { const int st = (r >> 4) * 2 + (c >> 5), rr = r & 15, cc = c & 31, ob = rr * 64 + cc * 2; return st * 1024 + (ob ^ (((ob >> 9) & 1) << 5)); }
__host__ __device__ __forceinline__ void stage_rc(int b, int& R, int& C) { const int st = b / 1024, sb = b % 1024, swz = sb ^ (((sb >> 9) & 1) << 5); R = (st >> 1) * 16 + swz / 64; C = (st & 1) * 32 + (swz % 64) / 2; }
__host__ __device__ __forceinline__ int perm32(int rho) { const int n = rho >> 4, i = rho & 15; return 8 * (i >> 2) + 4 * n + (i & 3); }

struct Unit { int pm, pn; };
struct Gemm { const bf16_t* A; const bf16_t* Bt; int M, N, K; };

struct StaticOrder {
    int nM, nN, nwg, G, c, rep;
    __host__ __device__ void init(int M, int N, int G_, int c_) { nM = M / BM; nN = N / BM; nwg = nM * nN; G = G_; c = c_; rep = 1; }
    __host__ __device__ bool next(int i, Unit& u) const {
        const long L = (long)(i / rep) * G + c; if (L >= nwg) return false;
        int wgid = (int)L; { const int q = nwg / NXCD, r = nwg % NXCD, xcd = wgid % NXCD, off = wgid / NXCD; wgid = (xcd < r ? xcd * (q + 1) : r * (q + 1) + (xcd - r) * q) + off; }
        const int nig = WGM * nN, gid = wgid / nig, fm = gid * WGM, gsz = (nM - fm) < WGM ? (nM - fm) : WGM;
        u.pm = fm + ((wgid % nig) % gsz); u.pn = (wgid % nig) / gsz; return true;
    }
    __device__ __forceinline__ void a_ready(const Unit&) const {}
    __device__ __forceinline__ void done(const Unit&) const {}
};

__device__ __forceinline__ unsigned cvt_pk_bf16(float lo, float hi) { unsigned r; asm volatile("v_cvt_pk_bf16_f32 %0, %1, %2" : "=v"(r) : "v"(lo), "v"(hi)); return r; }
typedef float f32x2 __attribute__((ext_vector_type(2)));
__device__ __forceinline__ f32x2 gelu_pk(f32x2 v) {
    const f32x2 av = __builtin_elementwise_abs(v), d = av * 0.2316418882f + 1.0f;
    f32x2 t; t.x = __builtin_amdgcn_rcpf(d.x); t.y = __builtin_amdgcn_rcpf(d.y);
    f32x2 q = t * 0.5307027145f + (-0.7265760135f); q = q * t + 0.7107068705f; q = q * t + (-0.142248368f); q = q * t + 0.127414796f; q = q * t;
    const f32x2 s = (v * v) * (-0.72134752044f);
    f32x2 e; e.x = __builtin_amdgcn_exp2f(s.x); e.y = __builtin_amdgcn_exp2f(s.y);
    const f32x2 m = v * (q * e), r = v - m;
    f32x2 o; o.x = v.x < 0.f ? m.x : r.x; o.y = v.y < 0.f ? m.y : r.y; return o;
}

template <int ACT  > struct EpiBf16 {
    static constexpr bool PERM = true, AFTER_DRAIN = false; static_assert(ACT == 0 || ACT == 1, "EpiBf16: ACT is 0 (none) or 1 (gelu_pk)");
    bf16_t* O; int ldc; const float* bias; int split_cols; size_t split_stride; float scale0;
    __device__ __forceinline__ void operator()(const f32x4 (&acc)[2][2][4][2], const Unit& u, int wr, int wc, int fr, int fq) const {
        const int row0 = u.pm * BM + wr * 64 + fr; int colt = u.pn * BM; bf16_t* base = O;
        float sc = 1.f; if (split_cols) { const int t = colt / split_cols; base += (size_t)t * split_stride; colt -= t * split_cols; if (t == 0) sc = scale0; }
        const int col0 = colt + wc * 32 + 8 * fq, bcol0 = u.pn * BM + wc * 32 + 8 * fq;
        f32x4 bv[2][2];
#pragma unroll
        for (int bj = 0; bj < 2; ++bj)
#pragma unroll
            for (int n = 0; n < 2; ++n) bv[bj][n] = bias ? *(const f32x4*)(bias + bcol0 + bj * HALF + 4 * n) : (f32x4){0.f, 0.f, 0.f, 0.f};
#pragma unroll
        for (int ai = 0; ai < 2; ++ai)
#pragma unroll
            for (int m = 0; m < 4; ++m) { bf16_t* rowp = base + (size_t)(row0 + ai * HALF + m * 16) * ldc + col0;
#pragma unroll
                for (int bj = 0; bj < 2; ++bj) { f32x4 v0 = acc[ai][bj][m][0] + bv[bj][0], v1 = acc[ai][bj][m][1] + bv[bj][1];
                    if (ACT == 1) { f32x2 a = gelu_pk((f32x2){v0[0], v0[1]}), b = gelu_pk((f32x2){v0[2], v0[3]}), c = gelu_pk((f32x2){v1[0], v1[1]}), d = gelu_pk((f32x2){v1[2], v1[3]});
                        v0 = (f32x4){a.x, a.y, b.x, b.y}; v1 = (f32x4){c.x, c.y, d.x, d.y}; }
                    v0 = v0 * sc; v1 = v1 * sc; u32x4 w; w.x = cvt_pk_bf16(v0[0], v0[1]); w.y = cvt_pk_bf16(v0[2], v0[3]); w.z = cvt_pk_bf16(v1[0], v1[1]); w.w = cvt_pk_bf16(v1[2], v1[3]);
                    *(u32x4*)(rowp + bj * HALF) = w; } }
    }
};
__device__ __forceinline__ float bf_lo(unsigned w) { return __builtin_bit_cast(float, w << 16); }
__device__ __forceinline__ float bf_hi(unsigned w) { return __builtin_bit_cast(float, w & 0xffff0000u); }
__device__ __forceinline__ float sigmoid_f(float x) { return __builtin_amdgcn_rcpf(1.0f + __builtin_amdgcn_exp2f(-1.4426950408889634f * x)); }
struct EpiGate {
    static constexpr bool PERM = true, AFTER_DRAIN = false;
    bf16_t* O; int ldc; const bf16_t* Gt; int ldg; int goff; int add;
    __device__ __forceinline__ void operator()(const f32x4 (&acc)[2][2][4][2], const Unit& u, int wr, int wc, int fr, int fq) const {
        const int row0 = u.pm * BM + wr * 64 + fr, col0 = u.pn * BM + wc * 32 + 8 * fq;
#pragma unroll
        for (int ai = 0; ai < 2; ++ai)
#pragma unroll
            for (int m = 0; m < 4; ++m) { const size_t row = (size_t)(row0 + ai * HALF + m * 16);
#pragma unroll
                for (int bj = 0; bj < 2; ++bj) { const int col = col0 + bj * HALF;
                    const u32x4 g = *(const u32x4*)(Gt + row * ldg + goff + col);
                    const f32x4 v0 = acc[ai][bj][m][0], v1 = acc[ai][bj][m][1];
                    float r0 = sigmoid_f(bf_lo(g.x)) * v0[0], r1 = sigmoid_f(bf_hi(g.x)) * v0[1], r2 = sigmoid_f(bf_lo(g.y)) * v0[2], r3 = sigmoid_f(bf_hi(g.y)) * v0[3];
                    float r4 = sigmoid_f(bf_lo(g.z)) * v1[0], r5 = sigmoid_f(bf_hi(g.z)) * v1[1], r6 = sigmoid_f(bf_lo(g.w)) * v1[2], r7 = sigmoid_f(bf_hi(g.w)) * v1[3];
                    bf16_t* op = O + row * ldc + col;
                    if (add) { const u32x4 o = *(const u32x4*)op; r0 += bf_lo(o.x); r1 += bf_hi(o.x); r2 += bf_lo(o.y); r3 += bf_hi(o.y); r4 += bf_lo(o.z); r5 += bf_hi(o.z); r6 += bf_lo(o.w); r7 += bf_hi(o.w); }
                    u32x4 w; w.x = cvt_pk_bf16(r0, r1); w.y = cvt_pk_bf16(r2, r3); w.z = cvt_pk_bf16(r4, r5); w.w = cvt_pk_bf16(r6, r7);
                    *(u32x4*)op = w; } }
    }
};
struct EpiRes {
    static constexpr bool PERM = false, AFTER_DRAIN = false;
    const float* X; float* O; const float* gate0; int gate_bstride; int ldc; int rows_per_batch;
    __device__ __forceinline__ void operator()(const f32x4 (&acc)[2][2][4][2], const Unit& u, int wr, int wc, int fr, int fq) const {
        const int row0 = u.pm * BM + wr * 64 + fr, col0 = u.pn * BM + wc * 32 + 4 * fq;
        const float* gp = gate0 + (size_t)((u.pm * BM) / rows_per_batch) * gate_bstride;
#pragma unroll
        for (int bj = 0; bj < 2; ++bj)
#pragma unroll
            for (int n = 0; n < 2; ++n) { const int col = col0 + bj * HALF + n * 16; const f32x4 g = *(const f32x4*)(gp + col);
#pragma unroll
                for (int ai = 0; ai < 2; ++ai)
#pragma unroll
                    for (int m = 0; m < 4; ++m) { const size_t off = (size_t)(row0 + ai * HALF + m * 16) * ldc + col;
                        const f32x4 x = *(const f32x4*)(X + off); *(f32x4*)(O + off) = x + g * acc[ai][bj][m][n]; } }
    }
};
struct EpiLogit {
    static constexpr bool PERM = false, AFTER_DRAIN = false;
    float* O;
    __device__ __forceinline__ void operator()(const f32x4 (&acc)[2][2][4][2], const Unit& u, int wr, int wc, int fr, int fq) const {
        if (wc < 2) {
            const int row0 = u.pm * BM + wr * 64 + fr, col0 = wc * 32 + 4 * fq;
#pragma unroll
            for (int ai = 0; ai < 2; ++ai)
#pragma unroll
                for (int m = 0; m < 4; ++m)
#pragma unroll
                    for (int n = 0; n < 2; ++n) *(f32x4*)(O + (size_t)(row0 + ai * HALF + m * 16) * 64 + col0 + n * 16) = acc[ai][0][m][n];
        }
    }
};
struct EpiAct {
    static constexpr bool PERM = true, AFTER_DRAIN = false;
    bf16_t* ACT; const float* roww; const PG8_LAS int* tb; int ntok;
    __device__ __forceinline__ void operator()(const f32x4 (&acc)[2][2][4][2], const Unit& u, int wr, int wc, int fr, int fq) const {
        const int row0 = u.pm * BM + wr * 64 + fr, col0 = (u.pn & 3) * 128 + wc * 32 + 8 * fq;
        const int e = tb[u.pm], ebase = tb[128 + e], ecnt = tb[200 + e];
#pragma unroll
        for (int ai = 0; ai < 2; ++ai)
#pragma unroll
            for (int m = 0; m < 4; ++m) { const size_t R = (size_t)(row0 + ai * HALF + m * 16); const int li = (int)R - ebase; const float w = li < ecnt ? roww[(size_t)e * ntok + li] : 0.f;
                const f32x4 g0 = acc[ai][0][m][0], g1 = acc[ai][0][m][1], u0 = acc[ai][1][m][0], u1 = acc[ai][1][m][1];
                float r[8];
#pragma unroll
                for (int i = 0; i < 4; ++i) { r[i] = g0[i] * sigmoid_f(g0[i]) * u0[i] * w; r[4 + i] = g1[i] * sigmoid_f(g1[i]) * u1[i] * w; }
                u32x4 o; o.x = cvt_pk_bf16(r[0], r[1]); o.y = cvt_pk_bf16(r[2], r[3]); o.z = cvt_pk_bf16(r[4], r[5]); o.w = cvt_pk_bf16(r[6], r[7]);
                *(u32x4*)(ACT + R * 512 + col0) = o; }
    }
};
struct EpiDown {
    static constexpr bool PERM = true, AFTER_DRAIN = false;
    bf16_t* Y; const int* rowtok; int ntok; const PG8_LAS int* tb;
    __device__ __forceinline__ void operator()(const f32x4 (&acc)[2][2][4][2], const Unit& u, int wr, int wc, int fr, int fq) const {
        const int row0 = u.pm * BM + wr * 64 + fr, col0 = (u.pn & 7) * BM + wc * 32 + 8 * fq;
        const int e = tb[u.pm], ebase = tb[128 + e], ecnt = tb[200 + e];
#pragma unroll
        for (int ai = 0; ai < 2; ++ai)
#pragma unroll
            for (int m = 0; m < 4; ++m) { const int li = row0 + ai * HALF + m * 16 - ebase; const int tk = li < ecnt ? rowtok[(size_t)e * ntok + li] : -1;
                if (tk >= 0) { bf16_t* yp = Y + ((size_t)(tk & 1) * ntok + (size_t)(tk >> 1)) * 2048 + col0;
#pragma unroll
                    for (int bj = 0; bj < 2; ++bj) { const f32x4 v0 = acc[ai][bj][m][0], v1 = acc[ai][bj][m][1];
                        u32x4 o; o.x = cvt_pk_bf16(v0[0], v0[1]); o.y = cvt_pk_bf16(v0[2], v0[3]); o.z = cvt_pk_bf16(v1[0], v1[1]); o.w = cvt_pk_bf16(v1[2], v1[3]);
                        *(u32x4*)(yp + bj * HALF) = o; } } }
    }
};
struct PairOrder {
    StaticOrder base;
    __device__ __forceinline__ bool next(int i, Unit& u) const { if (!base.next(i >> 1, u)) return false; if (i & 1) { u.pm += 32; u.pn += 8; } return true; }
    __device__ __forceinline__ void a_ready(const Unit&) const {}
    __device__ __forceinline__ void done(const Unit&) const {}
};
struct EpiGate2 {
    static constexpr bool PERM = true, AFTER_DRAIN = false;
    bf16_t* O; int ldc; const bf16_t* Gt; int ldg; int goff_a, goff_b;
    __device__ __forceinline__ void operator()(const f32x4 (&acc)[2][2][4][2], const Unit& u, int wr, int wc, int fr, int fq) const {
        const bool second = u.pm >= 32; const int goff = second ? goff_b : goff_a;
        const int row0 = (u.pm & 31) * BM + wr * 64 + fr, col0 = (u.pn & 7) * BM + wc * 32 + 8 * fq;
        if (second) asm volatile("s_waitcnt vmcnt(0)" ::: "memory");
#pragma unroll
        for (int ai = 0; ai < 2; ++ai)
#pragma unroll
            for (int m = 0; m < 4; ++m) { const size_t row = (size_t)(row0 + ai * HALF + m * 16);
#pragma unroll
                for (int bj = 0; bj < 2; ++bj) { const int col = col0 + bj * HALF;
                    const u32x4 g = *(const u32x4*)(Gt + row * ldg + goff + col);
                    const f32x4 v0 = acc[ai][bj][m][0], v1 = acc[ai][bj][m][1];
                    float r0 = sigmoid_f(bf_lo(g.x)) * v0[0], r1 = sigmoid_f(bf_hi(g.x)) * v0[1], r2 = sigmoid_f(bf_lo(g.y)) * v0[2], r3 = sigmoid_f(bf_hi(g.y)) * v0[3];
                    float r4 = sigmoid_f(bf_lo(g.z)) * v1[0], r5 = sigmoid_f(bf_hi(g.z)) * v1[1], r6 = sigmoid_f(bf_lo(g.w)) * v1[2], r7 = sigmoid_f(bf_hi(g.w)) * v1[3];
                    bf16_t* op = O + row * ldc + col;
                    if (second) { const u32x4 o = *(const u32x4*)op; r0 += bf_lo(o.x); r1 += bf_hi(o.x); r2 += bf_lo(o.y); r3 += bf_hi(o.y); r4 += bf_lo(o.z); r5 += bf_hi(o.z); r6 += bf_lo(o.w); r7 += bf_hi(o.w); }
                    u32x4 w; w.x = cvt_pk_bf16(r0, r1); w.y = cvt_pk_bf16(r2, r3); w.z = cvt_pk_bf16(r4, r5); w.w = cvt_pk_bf16(r6, r7);
                    *(u32x4*)op = w; } }
    }
};
struct MoeOrder {
    const PG8_LAS int* tile_e; int ntiles, ncol, G, c, rep;
    __device__ __forceinline__ bool next(int i, Unit& u) const {
        const long L = (long)(i / rep) * G + c; if (L >= (long)ntiles * ncol) return false;
        const int rt = (int)(L / ncol), pl = (int)(L % ncol); u.pm = rt; u.pn = __builtin_amdgcn_readfirstlane(tile_e[rt]) * ncol + pl; return true;
    }
    __device__ __forceinline__ void a_ready(const Unit&) const {}
    __device__ __forceinline__ void done(const Unit&) const {}
};

struct GatherTab { const int* rowtok; const PG8_LAS int* tb; int ntok;
    __device__ __forceinline__ int tok(int pm, int r) const { const int e = tb[pm], i = pm * 256 + r - tb[128 + e]; return i < tb[200 + e] ? (rowtok[(size_t)e * ntok + i] >> 1) : 0; } };
template <class Epi, class Sched, bool ALIGN_EPI = false, bool SP2 = false, bool GATHER = false>
__device__ __forceinline__ void gemm_phase(PG8_LAS unsigned char* lds, const Gemm g, const Sched& S, const Epi& E, const GatherTab gt = GatherTab{nullptr, nullptr, 0}) {
    int tid_ = threadIdx.x; asm volatile("" : "+v"(tid_));
    const int tid = tid_, wid = __builtin_amdgcn_readfirstlane(tid >> 6), lane = tid & 63, wr = wid >> 2, wc = wid & 3, fr = lane & 15, fq = lane >> 4;
    const int K = g.K, nt = K / BK;
    unsigned voffA[2], voffB[2];
#pragma unroll
    for (int i = 0; i < 2; ++i) { int R, C; stage_rc(tid * 16 + i * 8192, R, C); const int Rb = Epi::PERM ? ((R & ~31) + perm32(R & 31)) : R;
        voffA[i] = (unsigned)(R * K + C) * 2u; voffB[i] = (unsigned)(Rb * K + C) * 2u; }
    unsigned vAc[2][2], vAn[2][2];
    int RA[2], CA[2];
#pragma unroll
    for (int i = 0; i < 2; ++i) stage_rc(tid * 16 + i * 8192, RA[i], CA[i]);
#define PG8_GVOFF(dst, unit) do { _Pragma("unroll") for (int h_ = 0; h_ < 2; ++h_) _Pragma("unroll") for (int i_ = 0; i_ < 2; ++i_) \
        dst[h_][i_] = (unsigned)((size_t)gt.tok((unit).pm, h_ * HALF + RA[i_]) * K + CA[i_]) * 2u; } while (0)
    const size_t kstep = (size_t)(BK * 2);
    const size_t hstep = (size_t)HALF * K * 2;
    const size_t tstep = 2 * hstep;
    const unsigned ldsw = (unsigned)wid * 1024u;
    const int aoff = lds_byte(wr * 64 + fr, fq * 8), boff = lds_byte(wc * 32 + fr, fq * 8);
#define PG8_SA(b, h) (((b) * 2 + (h)) * HTB)
#define PG8_SB(b, h) ((4 + (b) * 2 + (h)) * HTB)
#define PG8_STAGE(bufoff, gbase, voff) do { _Pragma("unroll") for (int _i = 0; _i < 2; ++_i) \
        __builtin_amdgcn_global_load_lds((const unsigned*)((const char*)(gbase) + (voff)[_i]), (PG8_LAS unsigned*)(lds + (bufoff) + ldsw + _i * 8192), 16, 0, 0); } while (0)
#define PG8_STAGE_A(bufoff, gbase, h, nx) do { if constexpr (GATHER) { if (nx) PG8_STAGE(bufoff, gbase, vAn[h]); else PG8_STAGE(bufoff, gbase, vAc[h]); } else { PG8_STAGE(bufoff, (gbase) + (h) * hstep, voffA); } } while (0)
#define PG8_LDA(dst, b, h) do { _Pragma("unroll") for (int m = 0; m < 4; ++m) _Pragma("unroll") for (int k = 0; k < 2; ++k) dst[m][k] = *(const PG8_LAS bf16x8*)(lds + PG8_SA(b, h) + aoff + m * 2048 + k * 1024); } while (0)
#define PG8_LDB(dst, b, h) do { _Pragma("unroll") for (int n = 0; n < 2; ++n) _Pragma("unroll") for (int k = 0; k < 2; ++k) dst[n][k] = *(const PG8_LAS bf16x8*)(lds + PG8_SB(b, h) + boff + n * 2048 + k * 1024); } while (0)
#define PG8_MMA(ai, bj, At, Bt) do { __builtin_amdgcn_s_setprio(1); _Pragma("unroll") for (int m = 0; m < 4; ++m) _Pragma("unroll") for (int n = 0; n < 2; ++n) _Pragma("unroll") for (int k = 0; k < 2; ++k) \
        acc[ai][bj][m][n] = __builtin_amdgcn_mfma_f32_16x16x32_bf16(Bt[n][k], At[m][k], acc[ai][bj][m][n], 0, 0, 0); __builtin_amdgcn_s_setprio(0); } while (0)
#define PG8_WAIT_V(n) asm volatile("s_waitcnt vmcnt(" #n ")" ::: "memory")
#define PG8_WAIT_L(n) asm volatile("s_waitcnt lgkmcnt(" #n ")" ::: "memory")
#define PG8_BAR __builtin_amdgcn_s_barrier()
#define PG8_SCHED __builtin_amdgcn_sched_barrier(0)
    Unit cur, nxt; int ui = 0;
    if (!S.next(0, cur)) return;
    f32x4 acc[2][2][4][2];
#pragma unroll
    for (int a = 0; a < 2; ++a)
#pragma unroll
        for (int b = 0; b < 2; ++b)
#pragma unroll
            for (int m = 0; m < 4; ++m)
#pragma unroll
                for (int n = 0; n < 2; ++n) acc[a][b][m][n] = (f32x4){0.f, 0.f, 0.f, 0.f};
    bf16x8 At[4][2], B0[2][2], B1[2][2];
    const char* cA = (const char*)g.A + (GATHER ? (size_t)0 : (size_t)cur.pm * tstep); const char* cB = (const char*)g.Bt + (size_t)cur.pn * tstep;
    if constexpr (GATHER) { PG8_GVOFF(vAc, cur); }
    S.a_ready(cur);
    if constexpr (SP2) {
        PG8_STAGE(PG8_SB(0, 0), cB, voffB); PG8_STAGE(PG8_SB(0, 1), cB + hstep, voffB); PG8_STAGE_A(PG8_SA(0, 0), cA, 0, false); PG8_STAGE_A(PG8_SA(0, 1), cA, 1, false);
        if (wr == 1) PG8_BAR;
        PG8_WAIT_V(2); PG8_BAR;
        PG8_STAGE(PG8_SB(1, 0), cB + kstep, voffB); PG8_STAGE_A(PG8_SA(1, 0), cA + kstep, 0, false); PG8_STAGE(PG8_SB(1, 1), cB + hstep + kstep, voffB);
        PG8_WAIT_V(6); PG8_BAR;
    } else {
        PG8_STAGE(PG8_SB(0, 0), cB, voffB); PG8_STAGE_A(PG8_SA(0, 0), cA, 0, false); PG8_STAGE(PG8_SB(0, 1), cB + hstep, voffB); PG8_STAGE_A(PG8_SA(0, 1), cA, 1, false);
        if (wr == 1) PG8_BAR;
        PG8_WAIT_V(4); PG8_BAR;
        PG8_STAGE(PG8_SB(1, 0), cB + kstep, voffB); PG8_STAGE_A(PG8_SA(1, 0), cA + kstep, 0, false); PG8_STAGE(PG8_SB(1, 1), cB + hstep + kstep, voffB);
        PG8_WAIT_V(6); PG8_BAR;
    }
    for (;;) {
        const bool has_next = S.next(ui + 1, nxt);
        if constexpr (GATHER) { if (has_next) { PG8_GVOFF(vAn, nxt); } else { _Pragma("unroll") for (int h_ = 0; h_ < 2; ++h_) _Pragma("unroll") for (int i_ = 0; i_ < 2; ++i_) vAn[h_][i_] = vAc[h_][i_]; } }
        const char* nA = has_next ? (const char*)g.A + (GATHER ? (size_t)0 : (size_t)nxt.pm * tstep) : cA; const char* nB = has_next ? (const char*)g.Bt + (size_t)nxt.pn * tstep : cB;
        for (int t = 0; t < nt; t += 2) {
            const bool last = (t == nt - 2);
            const char* a1 = cA + (size_t)(t + 1) * kstep;
            const char* a2 = last ? nA : cA + (size_t)(t + 2) * kstep; const char* b2 = last ? nB : cB + (size_t)(t + 2) * kstep;
            const char* a3 = a2 + kstep; const char* b3 = b2 + kstep;
            if (last && has_next) S.a_ready(nxt);
            if constexpr (SP2) {
            PG8_LDB(B0, 0, 0); PG8_LDB(B1, 0, 1); PG8_SCHED; PG8_LDA(At, 0, 0); PG8_STAGE_A(PG8_SA(1, 1), a1, 1, false);
            PG8_WAIT_V(8); PG8_WAIT_L(0); PG8_BAR; PG8_MMA(0, 0, At, B0); PG8_MMA(0, 1, At, B1); PG8_BAR; PG8_SCHED;
            PG8_LDA(At, 0, 1); PG8_STAGE(PG8_SB(0, 0), b2, voffB); PG8_STAGE(PG8_SB(0, 1), b2 + hstep, voffB); PG8_STAGE_A(PG8_SA(0, 0), a2, 0, last);
            PG8_WAIT_V(8); PG8_WAIT_L(0); PG8_BAR; PG8_MMA(1, 0, At, B0); PG8_MMA(1, 1, At, B1); PG8_BAR; PG8_SCHED;
            PG8_LDB(B0, 1, 0); PG8_LDB(B1, 1, 1); PG8_SCHED; PG8_LDA(At, 1, 0); PG8_STAGE_A(PG8_SA(0, 1), a2, 1, last);
            PG8_WAIT_V(8); PG8_WAIT_L(0); PG8_BAR; PG8_MMA(0, 0, At, B0); PG8_MMA(0, 1, At, B1); PG8_BAR; PG8_SCHED;
            PG8_LDA(At, 1, 1); PG8_STAGE(PG8_SB(1, 0), b3, voffB); PG8_STAGE(PG8_SB(1, 1), b3 + hstep, voffB); PG8_STAGE_A(PG8_SA(1, 0), a3, 0, last);
            PG8_WAIT_V(8); PG8_WAIT_L(0); PG8_BAR; PG8_MMA(1, 0, At, B0); PG8_MMA(1, 1, At, B1); PG8_BAR; PG8_SCHED;
            } else {
            PG8_LDB(B0, 0, 0); PG8_SCHED; PG8_LDA(At, 0, 0); PG8_STAGE_A(PG8_SA(1, 1), a1, 1, false);
            PG8_WAIT_L(8); PG8_BAR; PG8_WAIT_L(0); PG8_MMA(0, 0, At, B0); PG8_BAR; PG8_SCHED;
            PG8_LDB(B1, 0, 1); PG8_STAGE(PG8_SB(0, 0), b2, voffB);
            PG8_BAR; PG8_WAIT_L(0); PG8_MMA(0, 1, At, B1); PG8_BAR;
            PG8_LDA(At, 0, 1); PG8_STAGE_A(PG8_SA(0, 0), a2, 0, last);
            PG8_BAR; PG8_WAIT_L(0); PG8_MMA(1, 0, At, B0); PG8_BAR; PG8_SCHED;
            PG8_STAGE(PG8_SB(0, 1), b2 + hstep, voffB);
            PG8_WAIT_V(6); PG8_BAR; PG8_MMA(1, 1, At, B1); PG8_BAR;
            PG8_LDB(B0, 1, 0); PG8_SCHED; PG8_LDA(At, 1, 0); PG8_STAGE_A(PG8_SA(0, 1), a2, 1, last);
            PG8_WAIT_L(8); PG8_BAR; PG8_WAIT_L(0); PG8_MMA(0, 0, At, B0); PG8_BAR; PG8_SCHED;
            PG8_LDB(B1, 1, 1); PG8_STAGE(PG8_SB(1, 0), b3, voffB);
            PG8_BAR; PG8_WAIT_L(0); PG8_MMA(0, 1, At, B1); PG8_BAR;
            PG8_LDA(At, 1, 1); PG8_STAGE_A(PG8_SA(1, 0), a3, 0, last);
            PG8_BAR; PG8_WAIT_L(0); PG8_MMA(1, 0, At, B0); PG8_BAR; PG8_SCHED;
            PG8_STAGE(PG8_SB(1, 1), b3 + hstep, voffB);
            PG8_WAIT_V(6); PG8_BAR; PG8_MMA(1, 1, At, B1); PG8_BAR;
            }
        }
        if constexpr (ALIGN_EPI) { if (wr == 0) PG8_BAR; }
        if constexpr (!Epi::AFTER_DRAIN) { E(acc, cur, wr, wc, fr, fq); S.done(cur); }
        if (!has_next) break;
#pragma unroll
        for (int a = 0; a < 2; ++a)
#pragma unroll
            for (int b = 0; b < 2; ++b)
#pragma unroll
                for (int m = 0; m < 4; ++m)
#pragma unroll
                    for (int n = 0; n < 2; ++n) acc[a][b][m][n] = (f32x4){0.f, 0.f, 0.f, 0.f};
        cur = nxt; cA = nA; cB = nB; ++ui;
        if constexpr (GATHER) { _Pragma("unroll") for (int h_ = 0; h_ < 2; ++h_) _Pragma("unroll") for (int i_ = 0; i_ < 2; ++i_) vAc[h_][i_] = vAn[h_][i_]; }
        if constexpr (ALIGN_EPI) { if (wr == 1) PG8_BAR; }
    }
    PG8_WAIT_V(0);
    if constexpr (!ALIGN_EPI) { if (wr == 0) PG8_BAR; }
    PG8_BAR;
    if constexpr (Epi::AFTER_DRAIN) { E.fused(acc, cur, wr, wc, fr, fq, lds, wid, lane); S.done(cur); }
#undef PG8_SA
#undef PG8_SB
#undef PG8_STAGE
#undef PG8_LDA
#undef PG8_STAGE_A
#undef PG8_GVOFF
#undef PG8_LDB
#undef PG8_MMA
#undef PG8_WAIT_V
#undef PG8_WAIT_L
#undef PG8_BAR
#undef PG8_SCHED
}
}

#ifndef PG8_SP2
#define PG8_SP2 true
#endif
#ifndef PG8_ALIGN
#define PG8_ALIGN true
#endif
#include <hip/hip_bf16.h>
#include <cmath>
namespace attn_body {
using bf16=__hip_bfloat16;
using bf16x8=__attribute__((ext_vector_type(8)))short;
using s16x4=__attribute__((ext_vector_type(4)))short;
using f32x16=__attribute__((ext_vector_type(16)))float;
using u32x4=__attribute__((ext_vector_type(4)))unsigned;
constexpr int BATCH=2,NHEAD=16,SEQ=4096,D=64,DM=NHEAD*D,QP=9984,KP=9984,VP=9984,OP=1024,GQA=4;
constexpr int NW=8,QBLK=32,QB=QBLK*NW,KVBLK=64,NQB=SEQ/QB;
constexpr int ATTN_UNIT_ROWS=QB;
__device__ __forceinline__ int crow(int r,int hi){return (r&3)+8*(r>>2)+4*hi;}
#define SBAR() __builtin_amdgcn_sched_barrier(0)
__device__ __forceinline__ void cmask(f32x16&p0,f32x16&p1,int jb,int qrel,int hi){
  const float NEG=-INFINITY; int kb=64*jb+4*hi;
  #pragma unroll
  for(int r=0;r<16;++r){int kv=kb+(r&3)+8*(r>>2); if(kv>qrel)p0[r]=NEG; if(kv+32>qrel)p1[r]=NEG;}
}

constexpr int NSLOT=3, SLOTB=8192;
constexpr int LDS_K=0, LDS_V=NSLOT*SLOTB, LDS_WS=2*NSLOT*SLOTB, LDS_OST=LDS_WS+NW*64*4, LDS_MK=LDS_OST+NW*4096, LDS_BYTES=LDS_MK+NW*4096;
constexpr float C2=0.125f*1.4426950408889634f;
__device__ __forceinline__ void glds16(const void*gsrc,unsigned lds_dst){unsigned keep;
  asm volatile("s_mov_b32 %0, m0\n\ts_mov_b32 m0, %2\n\ts_nop 0\n\tglobal_load_lds_dwordx4 %1, off\n\ts_mov_b32 m0, %0":"=&s"(keep):"v"(gsrc),"s"(lds_dst):"memory");}
__device__ __forceinline__ float max3f(float a,float b,float c){float r;asm("v_max3_f32 %0, %1, %2, %3":"=v"(r):"v"(a),"v"(b),"v"(c));return r;}
__device__ __forceinline__ float max2f(float a,float b){float r;asm("v_max_f32_e32 %0, %1, %2":"=v"(r):"v"(a),"v"(b));return r;}
__device__ __forceinline__ float fadd_s(float a,float b){float r;asm("v_add_f32_e32 %0, %1, %2":"=v"(r):"v"(a),"v"(b));return r;}
__device__ __forceinline__ float fsub_s(float a,float b){float r;asm("v_sub_f32_e32 %0, %1, %2":"=v"(r):"v"(a),"v"(b));return r;}
typedef float f32x2_t __attribute__((ext_vector_type(2))); typedef __bf16 bf16x2_t __attribute__((ext_vector_type(2)));
__device__ __forceinline__ unsigned cvtpk_s(float lo,float hi){f32x2_t v={lo,hi};bf16x2_t b=__builtin_convertvector(v,bf16x2_t);return __builtin_bit_cast(unsigned,b);}
#define WAIT_BAR(N) asm volatile("s_waitcnt vmcnt(" #N ") lgkmcnt(0)\n\ts_barrier":::"memory")

__device__ __forceinline__ void qkt(f32x16&p0,f32x16&p1,const char*Kslot,const bf16x8*qr,const f32x16&negm,int r32,int hi){
  const char*kb=Kslot+hi*1024+r32*16;
  #pragma unroll
  for(int d0=0;d0<4;++d0){
    const bf16x8 b0=*reinterpret_cast<const bf16x8*>(kb+d0*2048);
    const bf16x8 b1=*reinterpret_cast<const bf16x8*>(kb+d0*2048+512);
    if(d0==0){p0=__builtin_amdgcn_mfma_f32_32x32x16_bf16(b0,qr[0],negm,0,0,0);p1=__builtin_amdgcn_mfma_f32_32x32x16_bf16(b1,qr[0],negm,0,0,0);}
    else{p0=__builtin_amdgcn_mfma_f32_32x32x16_bf16(b0,qr[d0],p0,0,0,0);p1=__builtin_amdgcn_mfma_f32_32x32x16_bf16(b1,qr[d0],p1,0,0,0);}}
}
typedef __attribute__((address_space(3))) const char* lds_cptr;
typedef short v4i16_t __attribute__((ext_vector_type(4)));
__device__ __forceinline__ void kload8(bf16x8*kf,lds_cptr kp){
  kf[0]=*(const __attribute__((address_space(3))) bf16x8*)(kp);      kf[1]=*(const __attribute__((address_space(3))) bf16x8*)(kp+512);
  kf[2]=*(const __attribute__((address_space(3))) bf16x8*)(kp+2048); kf[3]=*(const __attribute__((address_space(3))) bf16x8*)(kp+2560);
  kf[4]=*(const __attribute__((address_space(3))) bf16x8*)(kp+4096); kf[5]=*(const __attribute__((address_space(3))) bf16x8*)(kp+4608);
  kf[6]=*(const __attribute__((address_space(3))) bf16x8*)(kp+6144); kf[7]=*(const __attribute__((address_space(3))) bf16x8*)(kp+6656);
}
__device__ __forceinline__ void kload2(bf16x8*kf,lds_cptr kp,int j){ kf[2*j]=*(const __attribute__((address_space(3))) bf16x8*)(kp+j*2048); kf[2*j+1]=*(const __attribute__((address_space(3))) bf16x8*)(kp+j*2048+512); }
__device__ __forceinline__ s16x4 vtr(lds_cptr p){ return __builtin_bit_cast(s16x4,__builtin_amdgcn_ds_read_tr16_b64_v4i16((__attribute__((address_space(3))) v4i16_t*)p)); }
template<int BIT> __device__ __forceinline__ float mand_asm(float x,unsigned m){ int t; asm("v_bfe_i32 %0, %1, %2, 1":"=v"(t):"v"(m),"i"(BIT)); float y; asm("v_and_b32 %0, %1, %2":"=v"(y):"v"(t),"v"(x)); return y; }
__device__ __forceinline__ float rowmax(const f32x16&p0,const f32x16&p1){
  float a=max3f(p0[0],p0[1],p1[0]),b=max3f(p0[2],p0[3],p1[1]);a=max3f(a,p1[2],p1[3]);
  #pragma unroll
  for(int r=4;r<16;r+=4){a=max3f(a,p0[r],p0[r+1]);b=max3f(b,p0[r+2],p0[r+3]);a=max3f(a,p1[r],p1[r+1]);b=max3f(b,p1[r+2],p1[r+3]);}
  const float m=max2f(a,b);
  auto rr=__builtin_amdgcn_permlane32_swap(__float_as_uint(m),__float_as_uint(m),false,false);
  return max2f(__uint_as_float(rr[0]),__uint_as_float(rr[1]));
}
__device__ __forceinline__ void pv(f32x16*o,int vb,bf16x8 pa0,bf16x8 pa1,bf16x8 pa2,bf16x8 pa3){
  #pragma unroll
  for(int d0=0;d0<2;++d0){s16x4 lo[4],hi[4];
    #pragma unroll
    for(int ks=0;ks<4;++ks){
      asm volatile("ds_read_b64_tr_b16 %0,%1 offset:%c2":"=&v"(lo[ks]):"v"(vb),"i"(d0*4096+ks*1024):"memory");
      asm volatile("ds_read_b64_tr_b16 %0,%1 offset:%c2":"=&v"(hi[ks]):"v"(vb),"i"(d0*4096+ks*1024+512):"memory");}
    asm volatile("s_waitcnt lgkmcnt(0)":::"memory");SBAR();
    #define PK(k) (bf16x8){lo[k][0],lo[k][1],lo[k][2],lo[k][3],hi[k][0],hi[k][1],hi[k][2],hi[k][3]}
    o[d0]=__builtin_amdgcn_mfma_f32_32x32x16_bf16(pa0,PK(0),o[d0],0,0,0);
    o[d0]=__builtin_amdgcn_mfma_f32_32x32x16_bf16(pa1,PK(1),o[d0],0,0,0);
    o[d0]=__builtin_amdgcn_mfma_f32_32x32x16_bf16(pa2,PK(2),o[d0],0,0,0);
    o[d0]=__builtin_amdgcn_mfma_f32_32x32x16_bf16(pa3,PK(3),o[d0],0,0,0);
    #undef PK
  }
}

#ifndef ATTN_STORE16
#define ATTN_STORE16(p,v) (*(u32x4*)(p)=(v))
#endif
template<int THRL> __device__ __forceinline__ void attn_unit(int b,int h,int qb,const bf16*Q,const bf16*__restrict__ K,const bf16*__restrict__ V,bf16*O,const unsigned long long*__restrict__ MK,char*shm){
  int tid_=threadIdx.x; asm volatile("":"+v"(tid_)); const int tid=tid_,lane=tid&63,r32=lane&31,hi=lane>>5; const int wid=__builtin_amdgcn_readfirstlane(tid>>6);
  const long rowbase=(long)b*SEQ; const int q0=qb*QB;
  const bf16*Qw=Q+(rowbase+q0+wid*QBLK)*QP+h*D;
  const bf16*Kh=K+rowbase*KP+(h/GQA)*D,*Vh=V+rowbase*VP+(h/GQA)*D;
  const unsigned lds0=(unsigned)(uintptr_t)shm;
  float*wsf=(float*)(shm+LDS_WS)+wid*64;
  const bf16*ksrc=Kh+(long)lane*KP+wid*8;
  const bf16*vsrc=Vh+(long)(16*(wid&3)+(lane>>2))*VP+(wid>>2)*32+(lane&3)*8;
  const unsigned kdst=lds0+LDS_K+wid*1024, vdst=lds0+LDS_V+wid*1024;
  #define DMA_K(t,slot) glds16(ksrc+(long)(t)*KVBLK*KP,(unsigned)__builtin_amdgcn_readfirstlane(kdst+(slot)))
  #define DMA_V(t,slot) glds16(vsrc+(long)(t)*KVBLK*VP,(unsigned)__builtin_amdgcn_readfirstlane(vdst+(slot)))
  const int vb0=(int)(lds0+LDS_V)+((lane>>4)&1)*32+(lane&3)*8+(4*hi+((lane&15)>>2))*64;
  const char*Kbase=shm+LDS_K; bf16x8 kf[8];
  const lds_cptr shm3=(lds_cptr)shm; const lds_cptr kp0=shm3+LDS_K+hi*1024+r32*16; const lds_cptr vp0=shm3+LDS_V+((lane>>4)&1)*32+(lane&3)*8+(4*hi+((lane&15)>>2))*64;
  const int NT=(q0+QB)/KVBLK;
  DMA_K(0,0);DMA_V(0,0);DMA_K(1,SLOTB);
  bf16x8 qr[4];
  #pragma unroll
  for(int d0=0;d0<4;++d0)qr[d0]=*reinterpret_cast<const bf16x8*>(&Qw[(long)r32*QP+d0*16+hi*8]);
  float mhat=0.f,l_reg=0.f;f32x16 o[2];o[0]=f32x16{};o[1]=f32x16{};const f32x16 negm=f32x16{};
  const int qrel=wid*QBLK+r32; (void)qrel;
  const unsigned long long*MKw=MK+((size_t)(rowbase+q0+wid*QBLK))*64;
  typedef __attribute__((address_space(3))) unsigned long long lds_u64;
  lds_u64*mks=(lds_u64*)((lds_cptr)shm+LDS_MK+wid*4096);
  #define MK_REFILL(t0) do{ _Pragma("unroll") for(int i_=0;i_<4;++i_){ const int idx_=i_*64+lane, q_=idx_>>3, pr_=idx_&7; \
      const u32x4 w_=*(const u32x4*)(MKw+(size_t)q_*64+(t0)+2*pr_); \
      mks[(2*pr_)*32+q_]=((unsigned long long)w_.y<<32)|w_.x; mks[(2*pr_+1)*32+q_]=((unsigned long long)w_.w<<32)|w_.z; } }while(0)
  #define MK_LOAD(t,ML,MH) do{ if(((t)&15)==0){ MK_REFILL(t); } const unsigned long long mw_=mks[((t)&15)*32+r32]; ML=(unsigned)mw_>>(4*hi); MH=(unsigned)(mw_>>32)>>(4*hi); }while(0)
  #define MKB(r) (((r)&3)+8*((r)>>2))
  #define MAND(x,M,r) __builtin_bit_cast(float,__builtin_bit_cast(unsigned,(x))&(unsigned)__builtin_amdgcn_sbfe((int)(M),MKB(r),1))
  unsigned mlo,mhi;
  #define CMASK(P0,P1,t) do{}while(0)
  bool resc=false;
  #define START(P0,P1) do{ const float rm=rowmax(P0,P1); resc=false; \
    { const float dl=rm; mhat=fadd_s(mhat,dl); \
      _Pragma("unroll") for(int r=0;r<16;++r){P0[r]=fsub_s(P0[r],dl);P1[r]=fsub_s(P1[r],dl);} \
      } \
    _Pragma("unroll") for(int r=0;r<16;++r)P0[r]=MAND(__builtin_amdgcn_exp2f(P0[r]),mlo,r); }while(0)
  #define RESC() do{ if(resc){ asm volatile("s_waitcnt lgkmcnt(0)":::"memory"); \
      _Pragma("unroll") for(int d_=0;d_<2;++d_) _Pragma("unroll") for(int r=0;r<16;++r)o[d_][r]*=wsf[crow(r,hi)]; } }while(0)
  f32x16 pA0,pA1,pB0,pB1;
  int sl_prev=0,sl_cur=0,sl_next=SLOTB;
  #define ROT() do{sl_prev=sl_cur;sl_cur=sl_next;sl_next=(sl_next==(NSLOT-1)*SLOTB)?0:sl_next+SLOTB;}while(0)
  DMA_K(2,2*SLOTB);
  WAIT_BAR(3);
  qkt(pA0,pA1,Kbase,qr,negm,r32,hi);asm volatile("s_nop 15\n\ts_nop 7":"+v"(pA0),"+v"(pA1));CMASK(pA0,pA1,0);
  MK_LOAD(0,mlo,mhi);
  START(pA0,pA1);
  _Pragma("unroll") for(int r=0;r<16;++r)pA1[r]=MAND(__builtin_amdgcn_exp2f(pA1[r]),mhi,r);
  WAIT_BAR(0);
  DMA_K(3,0);DMA_V(1,SLOTB);
  ROT();
  kload8(kf,kp0+sl_cur);
  WAIT_BAR(2);
  s16x4 vlo[8],vhi[8]; u32x4 pw0,pw1,pw2,pw3;
  #define PKW(P,B) cvtpk_s(P[B],P[B+1])
  #define PAF(k) __builtin_bit_cast(bf16x8,pw##k)
  #define VFR(i) (bf16x8){vlo[i][0],vlo[i][1],vlo[i][2],vlo[i][3],vhi[i][0],vhi[i][1],vhi[i][2],vhi[i][3]}
  #define PIN(x) asm volatile("":"+v"(x))
  #define MX3(a,b,c) __builtin_fmaxf(__builtin_fmaxf((a),(b)),(c))
  #define GAPA(MF,A0,A1,A2,A3,W0,W1,PW) do{ MF; sacc+=A0; sacc+=A1; sacc+=A2; sacc+=A3; PIN(sacc); W0; W1; PIN(PW); SBAR(); }while(0)
  #define EX(v) __builtin_amdgcn_exp2f(v)
  #define MANDA(x,M,r) mand_asm<MKB(r)>((x),(M))
  #define GAPB(MF,X,B,M) do{ MF; X[B]=MANDA(EX(X[B]),M,B); X[B+1]=MANDA(EX(X[B+1]),M,B+1); X[B+2]=MANDA(EX(X[B+2]),M,B+2); X[B+3]=MANDA(EX(X[B+3]),M,B+3); PIN(X); SBAR(); }while(0)
  #define VRD(i) do{ vlo[i]=vtr(vp_+(((i)>>2)*4096+((i)&3)*1024)); vhi[i]=vtr(vp_+(((i)>>2)*4096+((i)&3)*1024+512)); }while(0)
  #define KRD(G,j) do{ if(G){ kload2(kf,kp0+sl_next,j); SBAR(); } }while(0)
  #define STEP(C0,C1,P0,P1,t,GK,GV,GL) do{ SBAR(); MK_LOAD(t,mlo,mhi); SBAR(); \
    const lds_cptr vp_=vp0+sl_prev; \
    VRD(0); SBAR(); float sacc=(P0[0]+P0[1]); \
    GAPA(C0=__builtin_amdgcn_mfma_f32_32x32x16_bf16(kf[0],qr[0],negm,0,0,0), P0[2],P0[3],P0[4],P0[5],     pw0[0]=PKW(P0,0), pw0[1]=PKW(P0,2), pw0); \
    VRD(4); SBAR(); GAPA(C1=__builtin_amdgcn_mfma_f32_32x32x16_bf16(kf[1],qr[0],negm,0,0,0), P0[6],P0[7],P0[8],P0[9],     pw0[2]=PKW(P0,4), pw0[3]=PKW(P0,6), pw0); \
    VRD(1); SBAR(); GAPA(C0=__builtin_amdgcn_mfma_f32_32x32x16_bf16(kf[2],qr[1],C0,0,0,0),   P0[10],P0[11],P0[12],P0[13], pw1[0]=PKW(P0,8), pw1[1]=PKW(P0,10), pw1); \
    VRD(5); SBAR(); GAPA(C1=__builtin_amdgcn_mfma_f32_32x32x16_bf16(kf[3],qr[1],C1,0,0,0),   P0[14],P0[15],P1[0],P1[1],   pw1[2]=PKW(P0,12),pw1[3]=PKW(P0,14), pw1); \
    VRD(2); SBAR(); GAPA(C0=__builtin_amdgcn_mfma_f32_32x32x16_bf16(kf[4],qr[2],C0,0,0,0),   P1[2],P1[3],P1[4],P1[5],     pw2[0]=PKW(P1,0), pw2[1]=PKW(P1,2), pw2); \
    VRD(6); SBAR(); GAPA(C1=__builtin_amdgcn_mfma_f32_32x32x16_bf16(kf[5],qr[2],C1,0,0,0),   P1[6],P1[7],P1[8],P1[9],     pw2[2]=PKW(P1,4), pw2[3]=PKW(P1,6), pw2); \
    VRD(3); SBAR(); GAPA(C0=__builtin_amdgcn_mfma_f32_32x32x16_bf16(kf[6],qr[3],C0,0,0,0),   P1[10],P1[11],P1[12],P1[13], pw3[0]=PKW(P1,8), pw3[1]=PKW(P1,10), pw3); \
    VRD(7); SBAR(); GAPA(C1=__builtin_amdgcn_mfma_f32_32x32x16_bf16(kf[7],qr[3],C1,0,0,0),   P1[14],P1[15],0.f,0.f,       pw3[2]=PKW(P1,12),pw3[3]=PKW(P1,14), pw3); \
    l_reg+=sacc; \
    if(GK){DMA_K((t)+3,sl_cur);} if(GV){DMA_V((t)+1,sl_next);} \
    { const float nm_=-mhat; _Pragma("unroll") for(int r=0;r<16;++r){C0[r]+=nm_;C1[r]+=nm_;} } \
    { float a=MX3(C0[0],C0[1],C1[0]),b=MX3(C0[2],C0[3],C1[1]); a=MX3(a,C1[2],C1[3]); \
      _Pragma("unroll") for(int r=4;r<16;r+=4){a=MX3(a,C0[r],C0[r+1]);b=MX3(b,C0[r+2],C0[r+3]);a=MX3(a,C1[r],C1[r+1]);b=MX3(b,C1[r+2],C1[r+3]);} \
      float rm=__builtin_fmaxf(a,b); { auto rr=__builtin_amdgcn_permlane32_swap(__float_as_uint(rm),__float_as_uint(rm),false,false); rm=__builtin_fmaxf(__uint_as_float(rr[0]),__uint_as_float(rr[1])); } \
      resc=false; \
      if(__builtin_expect(__any(rm>(float)THRL),0)){ const float dl=__builtin_fmaxf(rm,0.f); mhat+=dl; \
        _Pragma("unroll") for(int r=0;r<16;++r){C0[r]-=dl;C1[r]-=dl;} \
        const float f=__builtin_amdgcn_exp2f(-dl); l_reg*=f; if(hi==0)wsf[r32]=f; resc=true; } } \
    SBAR(); \
    GAPB(o[0]=__builtin_amdgcn_mfma_f32_32x32x16_bf16(PAF(0),VFR(0),o[0],0,0,0), C0,0,mlo); \
    GAPB(o[1]=__builtin_amdgcn_mfma_f32_32x32x16_bf16(PAF(0),VFR(4),o[1],0,0,0), C0,4,mlo); \
    KRD(GL,0); GAPB(o[0]=__builtin_amdgcn_mfma_f32_32x32x16_bf16(PAF(1),VFR(1),o[0],0,0,0), C0,8,mlo); \
    KRD(GL,1); GAPB(o[1]=__builtin_amdgcn_mfma_f32_32x32x16_bf16(PAF(1),VFR(5),o[1],0,0,0), C0,12,mlo); \
    KRD(GL,2); GAPB(o[0]=__builtin_amdgcn_mfma_f32_32x32x16_bf16(PAF(2),VFR(2),o[0],0,0,0), C1,0,mhi); \
    KRD(GL,3); GAPB(o[1]=__builtin_amdgcn_mfma_f32_32x32x16_bf16(PAF(2),VFR(6),o[1],0,0,0), C1,4,mhi); \
    GAPB(o[0]=__builtin_amdgcn_mfma_f32_32x32x16_bf16(PAF(3),VFR(3),o[0],0,0,0), C1,8,mhi); \
    GAPB(o[1]=__builtin_amdgcn_mfma_f32_32x32x16_bf16(PAF(3),VFR(7),o[1],0,0,0), C1,12,mhi); \
    }while(0)
  int t=1;
  #undef CMASK
  #define CMASK(P0,P1,t) do{}while(0)
  for(;t+5<NT;t+=2){
    STEP(pB0,pB1,pA0,pA1,t,true,true,true);     WAIT_BAR(2); RESC(); ROT();
    STEP(pA0,pA1,pB0,pB1,t+1,true,true,true);   WAIT_BAR(2); RESC(); ROT();
  }
  #undef CMASK
  #define CMASK(P0,P1,t) do{}while(0)
  #define ENDW(tt) do{ if((tt)+3<NT){WAIT_BAR(2);} else if((tt)+2<NT){WAIT_BAR(1);} else {WAIT_BAR(0);} }while(0)
  for(;t+1<NT;t+=2){
    STEP(pB0,pB1,pA0,pA1,t,(t+3<NT),(t+1<NT),(t+1<NT));       ENDW(t);   RESC(); ROT();
    STEP(pA0,pA1,pB0,pB1,t+1,(t+4<NT),(t+2<NT),(t+2<NT));     ENDW(t+1); RESC(); ROT();
  }
  STEP(pB0,pB1,pA0,pA1,NT-1,false,false,false); RESC();
  { float sacc=pB0[0]+pB0[1]; _Pragma("unroll") for(int r=2;r<16;++r)sacc+=pB0[r]; _Pragma("unroll") for(int r=0;r<16;++r)sacc+=pB1[r]; l_reg+=sacc;
    pw0=(u32x4){PKW(pB0,0),PKW(pB0,2),PKW(pB0,4),PKW(pB0,6)};pw1=(u32x4){PKW(pB0,8),PKW(pB0,10),PKW(pB0,12),PKW(pB0,14)};pw2=(u32x4){PKW(pB1,0),PKW(pB1,2),PKW(pB1,4),PKW(pB1,6)};pw3=(u32x4){PKW(pB1,8),PKW(pB1,10),PKW(pB1,12),PKW(pB1,14)};
    SBAR(); pv(o,vb0+sl_cur,PAF(0),PAF(1),PAF(2),PAF(3)); }
  #undef PKW
  #undef PAF
  #undef VFR
  #undef PIN
  #undef MX3
  #undef GAPA
  #undef GAPB
  #undef EX
  #undef VRD
  #undef KRD
  #undef STEP
  #undef ENDW
  {auto rr=__builtin_amdgcn_permlane32_swap(__float_as_uint(l_reg),__float_as_uint(l_reg),false,false);l_reg=__uint_as_float(rr[0])+__uint_as_float(rr[1]);}
  if(hi==0)wsf[32+r32]=l_reg;asm volatile("s_waitcnt lgkmcnt(0)":::"memory");
  float rli[16];
  #pragma unroll
  for(int r=0;r<16;++r)rli[r]=__builtin_amdgcn_rcpf(wsf[32+crow(r,hi)]);
  bf16*Ow=O+(rowbase+q0+wid*QBLK)*OP+h*D;
  { bf16*stg=(bf16*)(shm+LDS_OST)+wid*2048;
    #pragma unroll
    for(int r=0;r<16;++r){const int orow=crow(r,hi);
      #pragma unroll
      for(int d0=0;d0<2;++d0)stg[orow*64+d0*32+r32]=__float2bfloat16(o[d0][r]*rli[r]);}
    asm volatile("s_waitcnt lgkmcnt(0)":::"memory");
    #pragma unroll
    for(int i=0;i<4;++i){const int row=i*8+(lane>>3),ch=lane&7; const u32x4 v=*(const u32x4*)(stg+row*64+ch*8); ATTN_STORE16(Ow+(long)row*OP+ch*8,v);} }
  asm volatile("s_waitcnt lgkmcnt(0)\n\ts_barrier":::"memory");
  #undef DMA_K
  #undef MK_REFILL
  #undef MK_LOAD
  #undef MKB
  #undef MAND
  #undef DMA_V
  #undef CMASK
  #undef START
  #undef RESC
  #undef ROT
}
constexpr int ATTN_LDS_BYTES=LDS_BYTES;
struct AttnTensors { const bf16* Q; const bf16* K; const bf16* V; bf16* O; const unsigned long long* MK; };
struct AttnUnit { int bh; int qb; };
struct StaticOrder {
  int vcu;
  __device__ __forceinline__ explicit StaticOrder(int grid,int block):vcu((grid%8==0)?(block%8)*(grid/8)+block/8:block),G(grid){}
  int G,rep=1;
  __device__ __forceinline__ bool next(int i,AttnUnit&u)const{ const int L=(i/rep)*G+vcu; if(L>=512)return false; const int s=L&7; u.bh=(L&255)>>3; u.qb=(L<256)?s:15-s; return true; }
  __device__ __forceinline__ void a_ready(const AttnUnit&)const{}
  __device__ __forceinline__ void done(const AttnUnit&)const{}
};
template<class Sched,int THRL=8> __device__ __forceinline__ void attn_phase(char*lds,const AttnTensors&T,const Sched&S){
  AttnUnit u;
  for(int i=0;S.next(i,u);++i){ S.a_ready(u); attn_unit<THRL>(u.bh/NHEAD,u.bh%NHEAD,u.qb,T.Q,T.K,T.V,T.O,T.MK,lds); S.done(u); }
}
#undef SBAR
#undef WAIT_BAR
}
constexpr int NWAVES = 8;
#ifndef MK_N_LAUNCHES
#define MK_N_LAUNCHES 1
#endif
constexpr int N_LAUNCHES = MK_N_LAUNCHES;

constexpr int D = 2048, BATCH = 2, SEQ = 4096, M = BATCH * SEQ;
constexpr int NHEAD = 16, HD = 64, NKV = 4, IDXH = 16, IDXD = 64, TOPK = 256;
constexpr int NE = 32, EPG = 8, NGRP = 4, FF = 512;
constexpr int NPROJ = 9808, NP = 9984;
constexpr int C_Q = 0, C_K = 1024, C_V = 1280, C_IQ = 1536, C_IK = 2560, C_IW = 2624, C_BG = 2640, C_CG = 3664, C_XC = 4688, C_GA = 5712, C_GB = 7760;
constexpr int NMOD = 6 * D;
constexpr float EPS = 1e-6f;
constexpr int ROWCAP = 24576;
constexpr int MAXTILES = ROWCAP / 256;

constexpr size_t MiB = 1u << 20;
constexpr size_t WS_CTL = 0, CTL_ZERO_BYTES = 65536;
constexpr size_t WS_MOD = 1 * MiB;
constexpr size_t WS_ROWTOK = 2 * MiB;
constexpr size_t WS_ROWW = 3 * MiB;
constexpr size_t WS_ROWTOK2 = 4 * MiB;
constexpr size_t WS_ROWW2 = 4 * MiB + 512 * 1024;
constexpr size_t WS_LOGIT = 5 * MiB;
constexpr size_t WS_MASK = 8 * MiB;
constexpr size_t WS_WMIX = 12 * MiB;
constexpr size_t WS_WR = 28 * MiB;
constexpr size_t WS_WIN = 32 * MiB;
constexpr size_t WS_OA = 32 * MiB, WS_CB = 48 * MiB;
constexpr size_t WS_WGU = 72 * MiB;
constexpr size_t WS_WDN = 200 * MiB;
constexpr size_t WS_H = 264 * MiB;
constexpr size_t WS_PROJ = 296 * MiB;
constexpr size_t WS_HS = 296 * MiB;
constexpr size_t WS_ACT = 392 * MiB;
constexpr size_t WS_SCORE = 452 * MiB;
constexpr size_t WS_MERGED = 452 * MiB;
constexpr size_t WS_Y = 484 * MiB;
constexpr size_t WS_END = 580 * MiB;
static_assert(WS_WIN + (size_t)NP * D * 2 <= WS_WGU && WS_PROJ + (size_t)M * NP * 2 <= WS_SCORE && WS_ACT + (size_t)ROWCAP * FF * 2 <= WS_SCORE && WS_Y + (size_t)2 * M * D * 2 <= WS_END, "d_ws map");
constexpr int CW_CNT = 64;
constexpr int CW_BAR = 4096;

constexpr int RING_OFF = 0, RING_BYTES = 131072;
constexpr int LDSCTL_OFF = RING_BYTES, MISC_OFF = LDSCTL_OFF + 320;
constexpr int TILEE_OFF = RING_BYTES + 1024;
constexpr int LDS_BYTES = 147456;
static_assert(MISC_OFF + 128 <= TILEE_OFF && TILEE_OFF + 1024 <= LDS_BYTES, "LDS map");

#define GAS __attribute__((address_space(1)))
#define LAS __attribute__((address_space(3)))
typedef unsigned short bf16;
typedef unsigned v4u __attribute__((ext_vector_type(4)));
typedef float f32x4 __attribute__((ext_vector_type(4)));
typedef short bf16x8 __attribute__((ext_vector_type(8)));
typedef GAS unsigned gu32;
typedef GAS unsigned long long gu64;
#define RLX_AGENT __ATOMIC_RELAXED, __HIP_MEMORY_SCOPE_AGENT
#define LDS_WAIT() asm volatile("s_waitcnt lgkmcnt(0)" ::: "memory")
#define VM_WAIT() asm volatile("s_waitcnt vmcnt(0)" ::: "memory")
__device__ __forceinline__ unsigned long long rt() { return __builtin_amdgcn_s_memrealtime(); }
__device__ __forceinline__ unsigned f2bf(float f) { unsigned u = __builtin_bit_cast(unsigned, f); return (u + 0x7fffu + ((u >> 16) & 1u)) >> 16; }
__device__ __forceinline__ unsigned pk2(float lo, float hi) { return f2bf(lo) | (f2bf(hi) << 16); }

#define XB_TMO      128
#define XB_XCNT(j)  (256  + 64 * (j))
#define XB_XSUB(j)  (1280 + 64 * (j))
#define XB_XGEN(j)  (2304 + 64 * (j))
#define XB_TOP      3328
#define XB_TOPGEN   3392
#define XCD_BAR_WORDS 3456
#define XB_SPIN_CAP (1u << 18)

__device__ __forceinline__ unsigned xb_ld(unsigned* p)              { return __hip_atomic_load(p, __ATOMIC_RELAXED, __HIP_MEMORY_SCOPE_AGENT); }
__device__ __forceinline__ unsigned xb_add(unsigned* p, unsigned v) { return __hip_atomic_fetch_add(p, v, __ATOMIC_RELAXED, __HIP_MEMORY_SCOPE_AGENT); }
__device__ __forceinline__ unsigned xb_xcc_id() { return (unsigned)__builtin_amdgcn_s_getreg((3 << 11) | 20) & 0xFu; }
#define XB_SPIN(cond, bar) do { unsigned _sp = 0; while (cond) { __builtin_amdgcn_s_sleep(1); \
    if ((++_sp & 255u) == 0u) { if (xb_ld(&(bar)[XB_TMO])) break; if (_sp > XB_SPIN_CAP) { atomicAdd(&(bar)[XB_TMO], 1u); break; } } } } while (0)

struct XcdBarrier {
    unsigned* bar; unsigned x;
    volatile LAS unsigned* st;
};

__device__ __forceinline__ XcdBarrier xcd_barrier_post(unsigned* bar, volatile LAS unsigned* st) {
    XcdBarrier b; b.bar = bar; b.x = xb_xcc_id(); b.st = st;
    if (threadIdx.x == 0) (void)xb_add(&bar[XB_XCNT(b.x)], 1u);
    return b;
}
__device__ __forceinline__ void xcd_barrier_complete(unsigned* bar, unsigned x, unsigned& nloc, unsigned& nx) {
    const unsigned G = gridDim.x * gridDim.y * gridDim.z;
    unsigned sum, cnt, mine, sp = 0u;
    for (;;) {
        sum = 0u; cnt = 0u; mine = 0u;
#pragma unroll
        for (unsigned j = 0; j < 16; ++j) { const unsigned c = xb_ld(&bar[XB_XCNT(j)]); sum += c; cnt += (c > 0u) ? 1u : 0u; mine = (j == x) ? c : mine; }
        if (sum == G) break;
        __builtin_amdgcn_s_sleep(1);
        if ((++sp & 255u) == 0u) { if (xb_ld(&bar[XB_TMO])) break; if (sp > XB_SPIN_CAP) { atomicAdd(&bar[XB_TMO], 1u); break; } }
    }
    nloc = mine > 0u ? mine : 1u; nx = cnt > 0u ? cnt : 1u;
}

__device__ __forceinline__ void xcd_barrier(const XcdBarrier& b) {
    asm volatile("s_waitcnt vmcnt(0)" ::: "memory");
    __syncthreads();
    if (threadIdx.x == 0) {
        unsigned* bar = b.bar; unsigned bx = b.x;
        asm volatile("" : "+s"(bar), "+s"(bx));
        __builtin_amdgcn_s_waitcnt(0);
        unsigned nloc = b.st[0], nx = b.st[1];
        if (nloc == 0u) { xcd_barrier_complete(bar, bx, nloc, nx); b.st[0] = nloc; b.st[1] = nx; }
        const unsigned old = xb_add(&bar[XB_XSUB(bx)], 1u);
        const unsigned gen = old / nloc;
        if (old + 1u == (gen + 1u) * nloc) {
            __builtin_amdgcn_fence(__ATOMIC_RELEASE, "agent");
            asm volatile("s_waitcnt vmcnt(0)" ::: "memory");
            const unsigned og = xb_add(&bar[XB_TOP], 1u);
            const unsigned tg = og / nx;
            if (og + 1u == (tg + 1u) * nx) xb_add(&bar[XB_TOPGEN], 1u);
            else XB_SPIN(xb_ld(&bar[XB_TOPGEN]) == tg, bar);
            __builtin_amdgcn_fence(__ATOMIC_ACQUIRE, "agent");
            xb_add(&bar[XB_XGEN(bx)], 1u);
            asm volatile("s_waitcnt vmcnt(0)" ::: "memory");
        } else {
            XB_SPIN(xb_ld(&bar[XB_XGEN(bx)]) == gen, bar);
            __builtin_amdgcn_fence(__ATOMIC_ACQUIRE, "agent");
            asm volatile("s_waitcnt vmcnt(0)" ::: "memory");
        }
    }
    __syncthreads();
}
struct Frame {
    LAS unsigned char* lds;
    volatile LAS unsigned* MISC;
    gu32* ctl;
    int tid, lane, wave;
    int vcu, G;
    unsigned char* ws;
};
struct Args { const float* in[19]; float* out; unsigned char* ws; int ph_lo, ph_hi, rep_mask, pad; };
__device__ __forceinline__ const float* ld_in(const Args& a, int i) { asm volatile("" : "+s"(i)); return a.in[i]; }
__device__ __forceinline__ unsigned char* ld_ws(const Args& a) { int i = 0; asm volatile("" : "+s"(i)); return (&a.ws)[i]; }
enum { I_X = 0, I_C, I_WADA, I_BADA, I_GMIX, I_WIN, I_CONVW, I_WAUP, I_WBOUT, I_WO, I_GFFN, I_WRG, I_BRG, I_WRE, I_BRE, I_WEG, I_WEU, I_WED, I_GFIN };

__device__ __forceinline__ float wave_sum(float v) {
#pragma unroll
    for (int o = 1; o < 64; o <<= 1) v += __shfl_xor(v, o);
    return v;
}
__device__ __forceinline__ float bfu_lo(unsigned w) { return __builtin_bit_cast(float, w << 16); }
__device__ __forceinline__ float bfu_hi(unsigned w) { return __builtin_bit_cast(float, w & 0xffff0000u); }

__device__ __forceinline__ void p0_mod(Frame& F, const Args& A, int rep) {
    LAS float* sc = (LAS float*)(F.lds);
    LAS float* red = (LAS float*)(F.lds + 16384);
    const float* c = ld_in(A, I_C); const float* W = ld_in(A, I_WADA); const float* bias = ld_in(A, I_BADA);
    float* mod = (float*)(F.ws + WS_MOD);
    for (int i = F.tid; i < 2 * D; i += NWAVES * 64) { const float v = c[i]; sc[i] = v / (1.0f + __expf(-v)); }
    __syncthreads();
    const int cq = F.tid % 12, rr = F.tid / 12;
    for (int cc = F.vcu; cc < (NMOD / 48) * rep; cc += F.G) { const int cg = cc & (NMOD / 48 - 1);
        f32x4 a0 = {0.f, 0.f, 0.f, 0.f}, a1 = {0.f, 0.f, 0.f, 0.f};
        if (rr < 42) {
            const float* wp = W + (size_t)cg * 48 + cq * 4;
#pragma unroll 8
            for (int k = rr; k < D; k += 42) { const f32x4 w = *(const f32x4*)(wp + (size_t)k * NMOD); a0 += sc[k] * w; a1 += sc[D + k] * w; }
#pragma unroll
            for (int i = 0; i < 4; ++i) { red[rr * 96 + cq * 4 + i] = a0[i]; red[rr * 96 + 48 + cq * 4 + i] = a1[i]; }
        }
        __syncthreads();
        if (F.tid < 96) { const int b = F.tid / 48, col = F.tid % 48; float s = 0.f;
            for (int r = 0; r < 42; ++r) s += red[r * 96 + F.tid];
            mod[(size_t)b * NMOD + cg * 48 + col] = s + bias[cg * 48 + col]; }
        __syncthreads();
    }
}
struct CvtItem { const float* W; bf16* WT; int N, pitch, row0, k0, n0; };
constexpr int CV_NB_IN = (NPROJ + 31) / 32;
constexpr int CV_I_IN = 32 * CV_NB_IN, CV_I_A = 16 * 64, CV_I_B = 16 * 64, CV_I_O = 32 * 64, CV_I_G = NE * 32 * 16, CV_I_U = CV_I_G, CV_I_D = NE * 8 * 64;
constexpr int CV_NITEMS = CV_I_IN + CV_I_A + CV_I_B + CV_I_O + CV_I_G + CV_I_U + CV_I_D;
__device__ __forceinline__ CvtItem cvt_decode(Frame& F, const Args& A, int it) {
    CvtItem d; int r = it;
    if (r < CV_I_IN) { const int kb = r / CV_NB_IN, nb = r % CV_NB_IN; d.W = ld_in(A, I_WIN); d.N = NPROJ; d.WT = (bf16*)(F.ws + WS_WIN); d.pitch = D; d.row0 = 32 * nb; d.k0 = 64 * kb; d.n0 = 32 * nb; return d; } r -= CV_I_IN;
    if (r < CV_I_A) { const int kb = r / 64, nb = r % 64; d.W = ld_in(A, I_WAUP); d.N = D; d.WT = (bf16*)(F.ws + WS_WMIX); d.pitch = 1024; d.row0 = 32 * nb; d.k0 = 64 * kb; d.n0 = 32 * nb; return d; } r -= CV_I_A;
    if (r < CV_I_B) { const int kb = r / 64, nb = r % 64; d.W = ld_in(A, I_WBOUT); d.N = D; d.WT = (bf16*)(F.ws + WS_WMIX + (size_t)D * 1024 * 2); d.pitch = 1024; d.row0 = 32 * nb; d.k0 = 64 * kb; d.n0 = 32 * nb; return d; } r -= CV_I_B;
    if (r < CV_I_O) { const int kb = r / 64, nb = r % 64; d.W = ld_in(A, I_WO); d.N = D; d.WT = (bf16*)(F.ws + WS_WMIX + (size_t)D * 1024 * 4); d.pitch = D; d.row0 = 32 * nb; d.k0 = 64 * kb; d.n0 = 32 * nb; return d; } r -= CV_I_O;
    if (r < CV_I_G + CV_I_U) { const int up = r >= CV_I_G; if (up) r -= CV_I_G; const int e = r / 512, q = r % 512, kb = q / 16, nb = q % 16, n0 = 32 * nb;
        d.W = ld_in(A, up ? I_WEU : I_WEG) + (size_t)e * D * FF; d.N = FF; d.WT = (bf16*)(F.ws + WS_WGU); d.pitch = D; d.row0 = e * 1024 + (n0 >> 7) * 256 + up * 128 + (n0 & 127); d.k0 = 64 * kb; d.n0 = n0; return d; } r -= CV_I_G + CV_I_U;
    { const int e = r / 512, q = r % 512, kb = q / 64, nb = q % 64;
        d.W = ld_in(A, I_WED) + (size_t)e * FF * D; d.N = D; d.WT = (bf16*)(F.ws + WS_WDN); d.pitch = FF; d.row0 = e * D + 32 * nb; d.k0 = 64 * kb; d.n0 = 32 * nb; return d; }
}
__device__ __forceinline__ void p0_convert(Frame& F, const Args& A, int it0, int it1, int worker, int nworkers, int rep) {
    LAS float* scr = (LAS float*)(F.lds + 32768 + F.wave * 8704);
    const int lane = F.lane, cq = lane & 7, rr = lane >> 3, n = it1 - it0;
    for (int base = worker * 4; base < n * rep; base += nworkers * 4) {
        CvtItem d[4]; f32x4 v[4][8]; bool ok[4];
#pragma unroll
        for (int q = 0; q < 4; ++q) { int x = base + q; ok[q] = x < n * rep; if (!ok[q]) x = base; if (x >= n) x -= n; d[q] = cvt_decode(F, A, it0 + x);
            const bool cv = d[q].n0 + 4 * cq < d[q].N;
#pragma unroll
            for (int i = 0; i < 8; ++i) v[q][i] = cv ? *(const GAS f32x4*)(d[q].W + (size_t)(d[q].k0 + rr + 8 * i) * d[q].N + d[q].n0 + 4 * cq) : (f32x4){0.f, 0.f, 0.f, 0.f}; }
#pragma unroll
        for (int q = 0; q < 4; ++q) {
#pragma unroll
            for (int i = 0; i < 8; ++i) { LAS float* p = scr + (rr + 8 * i) * 33 + 4 * cq; p[0] = v[q][i].x; p[1] = v[q][i].y; p[2] = v[q][i].z; p[3] = v[q][i].w; }
            LDS_WAIT(); asm volatile("" ::: "memory");
#pragma unroll
            for (int j = 0; j < 4; ++j) { const int nn = rr + 8 * j; const LAS float* s = scr + (8 * cq) * 33 + nn;
                v4u o; o.x = pk2(s[0 * 33], s[1 * 33]); o.y = pk2(s[2 * 33], s[3 * 33]); o.z = pk2(s[4 * 33], s[5 * 33]); o.w = pk2(s[6 * 33], s[7 * 33]);
                if (ok[q] && d[q].n0 + nn < d[q].N) *(GAS v4u*)(d[q].WT + (size_t)(d[q].row0 + nn) * d[q].pitch + d[q].k0 + 8 * cq) = o; }
            LDS_WAIT(); asm volatile("" ::: "memory");
        }
    }
}
__device__ __forceinline__ void p0_router_w(Frame& F, const Args& A) {
    bf16* WR = (bf16*)(F.ws + WS_WR); const float* wrg = ld_in(A, I_WRG); const float* wre = ld_in(A, I_WRE);
    for (int i = F.vcu * (NWAVES * 64) + F.tid; i < 64 * D; i += F.G * NWAVES * 64) { const int n = i / D, k = i % D;
        const float v = n < 4 ? wrg[k * 4 + n] : (n < 36 ? wre[k * 32 + (n - 4)] : 0.f); WR[i] = (bf16)f2bf(v); }
}
__device__ __forceinline__ void row_norm_mod_bf16(const float* xrow, const float* g, const float* sc, const float* sh, bf16* orow, int lane) {
    const GAS f32x4* xr = (const GAS f32x4*)xrow + lane; f32x4 v[8]; float s = 0.f;
#pragma unroll
    for (int j = 0; j < 8; ++j) { v[j] = xr[64 * j]; s += (v[j].x * v[j].x + v[j].y * v[j].y) + (v[j].z * v[j].z + v[j].w * v[j].w); }
    const float r = 1.0f / sqrtf(wave_sum(s) * (1.0f / D) + EPS);
    GAS unsigned long long* o8 = (GAS unsigned long long*)orow + lane;
#pragma unroll
    for (int j = 0; j < 8; ++j) { const f32x4 gg = ((const GAS f32x4*)g)[lane + 64 * j], ss = ((const GAS f32x4*)sc)[lane + 64 * j], hh = ((const GAS f32x4*)sh)[lane + 64 * j];
        const f32x4 o = (v[j] * r) * gg * (1.0f + ss) + hh;
        o8[64 * j] = (unsigned long long)pk2(o.x, o.y) | ((unsigned long long)pk2(o.z, o.w) << 32); }
}
__device__ __forceinline__ void p_norm_rows(Frame& F, const Args& A, const float* X, const float* g, int which, int rep) {
    const int gw = F.vcu * NWAVES + F.wave, NGW = F.G * NWAVES;
    const float* mod = (const float*)(F.ws + WS_MOD); bf16* H = (bf16*)(F.ws + WS_H);
    for (int mm = gw; mm < M * rep; mm += NGW) { const int m = mm & (M - 1); const float* mb = mod + (size_t)(m / SEQ) * NMOD + which * 3 * D;
        row_norm_mod_bf16(X + (size_t)m * D, g, mb + D, mb, H + (size_t)m * D, F.lane); }
}
__device__ __forceinline__ unsigned wave_sum_dpp(unsigned v) {
    v += (unsigned)__builtin_amdgcn_update_dpp(0, (int)v, 0xB1, 0xF, 0xF, false);
    v += (unsigned)__builtin_amdgcn_update_dpp(0, (int)v, 0x4E, 0xF, 0xF, false);
    v += (unsigned)__builtin_amdgcn_update_dpp(0, (int)v, 0x141, 0xF, 0xF, false);
    v += (unsigned)__builtin_amdgcn_update_dpp(0, (int)v, 0x140, 0xF, 0xF, false);
    v += (unsigned)__builtin_amdgcn_update_dpp(0, (int)v, 0x142, 0xA, 0xF, false);
    v += (unsigned)__builtin_amdgcn_update_dpp(0, (int)v, 0x143, 0xC, 0xF, false);
    return (unsigned)__builtin_amdgcn_readlane((int)v, 63);
}
__device__ __forceinline__ void p4_write_mask(const unsigned (&key)[64], unsigned thr, unsigned long long* mrow, int lane) {
    unsigned mlo = 0u, mhi = 0u;
#define P4_WL1(j) { const unsigned long long bm_ = __ballot(key[j] >= thr); const unsigned bl_ = (unsigned)bm_, bh_ = (unsigned)(bm_ >> 32); \
        asm volatile("s_nop 3\n\tv_writelane_b32 %0, %1, %2" : "+v"(mlo) : "s"(bl_), "i"(j)); asm volatile("s_nop 3\n\tv_writelane_b32 %0, %1, %2" : "+v"(mhi) : "s"(bh_), "i"(j)); }
#define P4_WL4(j) P4_WL1(j) P4_WL1((j) + 1) P4_WL1((j) + 2) P4_WL1((j) + 3)
#define P4_WL16(j) P4_WL4(j) P4_WL4((j) + 4) P4_WL4((j) + 8) P4_WL4((j) + 12)
    P4_WL16(0) P4_WL16(16) P4_WL16(32) P4_WL16(48)
#undef P4_WL16
#undef P4_WL4
#undef P4_WL1
    mrow[lane] = ((unsigned long long)mhi << 32) | mlo;
}
__device__ __forceinline__ void p4_load_keys(const float* srow, int t, int ng, int lane, unsigned (&key)[64]) {
    const float* pp = srow + lane;
#pragma unroll
    for (int g = 0; g < 8; ++g) {
        float raw[8];
        if (g < ng) {
#pragma unroll
            for (int i = 0; i < 8; ++i) raw[i] = pp[i * 64];
            pp += 512; asm volatile("" : "+v"(pp));
        } else {
#pragma unroll
            for (int i = 0; i < 8; ++i) raw[i] = 0.f;
        }
#pragma unroll
        for (int i = 0; i < 8; ++i) { const int j = 8 * g + i; const unsigned u = __builtin_bit_cast(unsigned, raw[i]); const unsigned k = (u & 0x80000000u) ? ~u : (u | 0x80000000u);
            key[j] = (j * 64 + lane <= t) ? k : 0u; }
    }
}
__device__ __forceinline__ void p4_select_pair(const float* srowA, const float* srowB, unsigned long long* mrowA, unsigned long long* mrowB, int tA, int tB, int lane) {
    unsigned keyA[64], keyB[64];
    const int ng = ((tA > tB ? tA : tB) >> 9) + 1;
    p4_load_keys(srowA, tA, ng, lane, keyA); p4_load_keys(srowB, tB, ng, lane, keyB);
    unsigned prefA = 0u, prefB = 0u; bool doneA = tA < TOPK, doneB = tB < TOPK;
    for (int bit = 31; bit >= 0 && !(doneA && doneB); --bit) {
        const unsigned candA = prefA | (1u << bit), candB = prefB | (1u << bit); unsigned cA = 0u, cB = 0u;
#pragma unroll
        for (int g = 0; g < 8; ++g) { if (g < ng) {
#pragma unroll
            for (int j = 8 * g; j < 8 * g + 8; ++j) { cA += keyA[j] >= candA ? 1u : 0u; cB += keyB[j] >= candB ? 1u : 0u; } } }
        const unsigned nA = wave_sum_dpp(cA), nB = wave_sum_dpp(cB);
        if (!doneA && nA >= (unsigned)TOPK) { prefA = candA; doneA = nA == (unsigned)TOPK; }
        if (!doneB && nB >= (unsigned)TOPK) { prefB = candB; doneB = nB == (unsigned)TOPK; }
    }
    p4_write_mask(keyA, tA < TOPK ? 1u : prefA, mrowA, lane);
    p4_write_mask(keyB, tB < TOPK ? 1u : prefB, mrowB, lane);
}
__device__ __forceinline__ void p4_select_own(Frame& F, const Args& A, int pair) {
    const float* S = (const float*)(F.ws + WS_SCORE); unsigned long long* MK = (unsigned long long*)(F.ws + WS_MASK);
    const int b = pair >> 7, p = pair & 127; int lane = F.lane; asm volatile("" : "+v"(lane));
#pragma unroll 1
    for (int z = 0; z < 2; ++z) { const int qb = z ? 255 - p : p; const int t = qb * 16 + 2 * F.wave; const size_t row = (size_t)b * SEQ + t;
        p4_select_pair(S + row * SEQ, S + (row + 1) * SEQ, MK + row * 64, MK + (row + 1) * 64, t, t + 1, lane); }
}
__device__ __forceinline__ void p3_scores(Frame& F, const Args& A, int rep, int rep_sel) {
    const bf16* P = (const bf16*)(F.ws + WS_PROJ); float* S = (float*)(F.ws + WS_SCORE);
    const int c16 = F.lane & 15, kq = F.lane >> 4;
    for (int pp = F.vcu; pp < 256; pp += F.G) { const int pair = pp & 255;
        const int b = pair >> 7, p = pair & 127;
#pragma unroll 1
        for (int zz = 0; zz < 2 * rep; ++zz) { const int z = zz & 1;
            const int qb = z == 0 ? p : 255 - p;
            const size_t qrow = (size_t)b * SEQ + qb * 16 + c16;
            const bf16* qp = P + qrow * NP;
            bf16x8 bq[IDXH][2]; float w[IDXH];
#pragma unroll
            for (int h = 0; h < IDXH; ++h)
#pragma unroll
                for (int ks = 0; ks < 2; ++ks) bq[h][ks] = *(const bf16x8*)(qp + C_IQ + h * 64 + ks * 32 + kq * 8);
            { const v4u w0 = *(const v4u*)(qp + C_IW), w1 = *(const v4u*)(qp + C_IW + 8);
                w[0] = bfu_lo(w0.x); w[1] = bfu_hi(w0.x); w[2] = bfu_lo(w0.y); w[3] = bfu_hi(w0.y); w[4] = bfu_lo(w0.z); w[5] = bfu_hi(w0.z); w[6] = bfu_lo(w0.w); w[7] = bfu_hi(w0.w);
                w[8] = bfu_lo(w1.x); w[9] = bfu_hi(w1.x); w[10] = bfu_lo(w1.y); w[11] = bfu_hi(w1.y); w[12] = bfu_lo(w1.z); w[13] = bfu_hi(w1.z); w[14] = bfu_lo(w1.w); w[15] = bfu_hi(w1.w); }
            float* srow = S + qrow * SEQ + kq * 4;
            const bf16* kbase = P + ((size_t)b * SEQ + c16) * NP + C_IK + kq * 8;
            int kt = F.wave;
            bf16x8 a0 = {0, 0, 0, 0, 0, 0, 0, 0}, a1 = a0;
            if (kt <= qb) { const bf16* kp = kbase + (size_t)kt * 16 * NP; a0 = *(const bf16x8*)kp; a1 = *(const bf16x8*)(kp + 32); }
            for (; kt <= qb; kt += 8) {
                bf16x8 n0 = a0, n1 = a1;
                if (kt + 8 <= qb) { const bf16* kp = kbase + (size_t)(kt + 8) * 16 * NP; n0 = *(const bf16x8*)kp; n1 = *(const bf16x8*)(kp + 32); }
                f32x4 sc = {0.f, 0.f, 0.f, 0.f};
#pragma unroll
                for (int hq = 0; hq < IDXH; hq += 4) {
                    f32x4 acc[4];
#pragma unroll
                    for (int i = 0; i < 4; ++i) acc[i] = __builtin_amdgcn_mfma_f32_16x16x32_bf16(a0, bq[hq + i][0], (f32x4){0.f, 0.f, 0.f, 0.f}, 0, 0, 0);
#pragma unroll
                    for (int i = 0; i < 4; ++i) acc[i] = __builtin_amdgcn_mfma_f32_16x16x32_bf16(a1, bq[hq + i][1], acc[i], 0, 0, 0);
#pragma unroll
                    for (int i = 0; i < 4; ++i)
#pragma unroll
                        for (int e = 0; e < 4; ++e) { const float xf = acc[i][e]; const int xb = __float_as_int(xf); const float r = __int_as_float(xb > 0 ? xb : 0); sc[e] += w[hq + i] * r; }
                }
                *(f32x4*)(srow + kt * 16) = sc;
                a0 = n0; a1 = n1;
            }
        }
        __syncthreads();
        for (int r_ = 0; r_ < rep_sel; ++r_) p4_select_own(F, A, pair);
        __syncthreads();
    }
}
__device__ __forceinline__ void unpack8(const v4u p, float (&f)[8]) { f[0] = bfu_lo(p.x); f[1] = bfu_hi(p.x); f[2] = bfu_lo(p.y); f[3] = bfu_hi(p.y); f[4] = bfu_lo(p.z); f[5] = bfu_hi(p.z); f[6] = bfu_lo(p.w); f[7] = bfu_hi(p.w); }
__device__ __forceinline__ void p3_conv(Frame& F, const Args& A, int rep) {
    const bf16* P = (const bf16*)(F.ws + WS_PROJ); bf16* CB = (bf16*)(F.ws + WS_CB); const float* cw = ld_in(A, I_CONVW);
    const int nthr = F.G * NWAVES * 64; constexpr int NIT = (M / 8) * 128;
    for (int ii = F.vcu * (NWAVES * 64) + F.tid; ii < NIT * rep; ii += nthr) { const int it = ii & (NIT - 1);
        const int t0 = (it >> 7) * 8, ch = (it & 127) * 8; const bool first = (t0 & (SEQ - 1)) == 0;
        float w[3][8];
#pragma unroll
        for (int j = 0; j < 3; ++j) { const f32x4 a = *(const f32x4*)(cw + j * 1024 + ch), b = *(const f32x4*)(cw + j * 1024 + ch + 4);
            w[j][0] = a.x; w[j][1] = a.y; w[j][2] = a.z; w[j][3] = a.w; w[j][4] = b.x; w[j][5] = b.y; w[j][6] = b.z; w[j][7] = b.w; }
        v4u cgv[10], xcv[10], bgv[8];
        const int tp = first ? t0 : t0 - 2;
#pragma unroll
        for (int k = 0; k < 2; ++k) { const bf16* rp = P + (size_t)(tp + k) * NP; cgv[k] = *(const v4u*)(rp + C_CG + ch); xcv[k] = *(const v4u*)(rp + C_XC + ch); }
#pragma unroll
        for (int k = 0; k < 8; ++k) { const bf16* rp = P + (size_t)(t0 + k) * NP; cgv[2 + k] = *(const v4u*)(rp + C_CG + ch); xcv[2 + k] = *(const v4u*)(rp + C_XC + ch); bgv[k] = *(const v4u*)(rp + C_BG + ch); }
        float u2[8], u1[8];
        { float c[8], x[8]; unpack8(cgv[0], c); unpack8(xcv[0], x);
#pragma unroll
          for (int i = 0; i < 8; ++i) u2[i] = first ? 0.f : c[i] * x[i];
          unpack8(cgv[1], c); unpack8(xcv[1], x);
#pragma unroll
          for (int i = 0; i < 8; ++i) u1[i] = first ? 0.f : c[i] * x[i]; }
#pragma unroll
        for (int k = 0; k < 8; ++k) { float c[8], x[8], g[8], y[8]; unpack8(cgv[2 + k], c); unpack8(xcv[2 + k], x); unpack8(bgv[k], g);
#pragma unroll
            for (int i = 0; i < 8; ++i) { const float u0 = c[i] * x[i]; y[i] = g[i] * (w[0][i] * u2[i] + w[1][i] * u1[i] + w[2][i] * u0); u2[i] = u1[i]; u1[i] = u0; }
            v4u o; o.x = pk2(y[0], y[1]); o.y = pk2(y[2], y[3]); o.z = pk2(y[4], y[5]); o.w = pk2(y[6], y[7]);
            *(v4u*)(CB + (size_t)(t0 + k) * 1024 + ch) = o; }
    }
}
__device__ __forceinline__ void p7_norm_route(Frame& F, const Args& A, int rep) {
    const float* mod = (const float*)(F.ws + WS_MOD); bf16* H = (bf16*)(F.ws + WS_H); const bf16* WR = (const bf16*)(F.ws + WS_WR);
    const float* X2 = A.out; const float* gffn = ld_in(A, I_GFFN); const float* brg = ld_in(A, I_BRG); const float* bre = ld_in(A, I_BRE);
    int* rowtok = (int*)(F.ws + WS_ROWTOK); float* roww = (float*)(F.ws + WS_ROWW);
    LAS float* part = (LAS float*)(F.lds);
    const int grp = F.wave >> 2, q = F.wave & 3, c16 = F.lane & 15, kq = F.lane >> 4;
    for (int bb = F.vcu; bb < (M / 32) * rep; bb += F.G) { const int blk = bb & (M / 32 - 1); const bool lastpass = bb >= (M / 32) * (rep - 1);
        const int row0 = blk * 32 + grp * 16;
#pragma unroll 1
        for (int i = 0; i < 4; ++i) { const int m = row0 + q * 4 + i; const float* mb = mod + (size_t)(m / SEQ) * NMOD + 3 * D;
            row_norm_mod_bf16(X2 + (size_t)m * D, gffn, mb + D, mb, H + (size_t)m * D, F.lane); }
        __syncthreads();
        f32x4 acc[3] = {{0.f, 0.f, 0.f, 0.f}, {0.f, 0.f, 0.f, 0.f}, {0.f, 0.f, 0.f, 0.f}};
        const bf16* ap = H + (size_t)(row0 + c16) * D + q * 512 + kq * 8; const bf16* bp = WR + (size_t)c16 * D + q * 512 + kq * 8;
#pragma unroll 4
        for (int ks = 0; ks < 16; ++ks) { const bf16x8 a = *(const bf16x8*)(ap + ks * 32);
#pragma unroll
            for (int n = 0; n < 3; ++n) { const bf16x8 bfr = *(const bf16x8*)(bp + (size_t)n * 16 * D + ks * 32); acc[n] = __builtin_amdgcn_mfma_f32_16x16x32_bf16(a, bfr, acc[n], 0, 0, 0); } }
#pragma unroll
        for (int n = 0; n < 3; ++n)
#pragma unroll
            for (int i = 0; i < 4; ++i) part[(F.wave * 16 + kq * 4 + i) * 48 + n * 16 + c16] = acc[n][i];
        __syncthreads();
        if (F.tid < 32 && lastpass) { const int g2 = F.tid >> 4, r = F.tid & 15, t = blk * 32 + F.tid;
            float lg[36];
#pragma unroll
            for (int c = 0; c < 36; ++c) lg[c] = (part[((g2 * 4 + 0) * 16 + r) * 48 + c] + part[((g2 * 4 + 1) * 16 + r) * 48 + c]) + (part[((g2 * 4 + 2) * 16 + r) * 48 + c] + part[((g2 * 4 + 3) * 16 + r) * 48 + c]);
            float gl[NGRP]; int g = 0;
#pragma unroll
            for (int i = 0; i < NGRP; ++i) gl[i] = lg[i] + brg[i];
#pragma unroll
            for (int i = 1; i < NGRP; ++i) if (gl[i] > gl[g]) g = i;
            float den = 0.f;
#pragma unroll
            for (int i = 0; i < NGRP; ++i) den += __expf(gl[i] - gl[g]);
            const float pg = 1.0f / den;
            float v0 = -INFINITY, v1 = -INFINITY; int i0 = 0, i1 = 0;
#pragma unroll
            for (int gg = 0; gg < NGRP; ++gg) { if (gg == g) {
#pragma unroll
                for (int j = 0; j < EPG; ++j) { const float v = lg[4 + gg * EPG + j] + bre[gg * EPG + j];
                    if (v > v0) { v1 = v0; i1 = i0; v0 = v; i0 = j; } else if (v > v1) { v1 = v; i1 = j; } } } }
            const float e1 = __expf(v1 - v0), p0 = 1.0f / (1.0f + e1), p1 = e1 * p0;
            const int ea = g * EPG + i0, eb = g * EPG + i1;
            const unsigned pa = __hip_atomic_fetch_add(F.ctl + CW_CNT + 64 * ea, 1u, __ATOMIC_RELAXED, __HIP_MEMORY_SCOPE_AGENT);
            const unsigned pb = __hip_atomic_fetch_add(F.ctl + CW_CNT + 64 * eb, 1u, __ATOMIC_RELAXED, __HIP_MEMORY_SCOPE_AGENT);
            rowtok[(size_t)ea * M + pa] = t * 2 + 0; roww[(size_t)ea * M + pa] = pg * p0;
            rowtok[(size_t)eb * M + pb] = t * 2 + 1; roww[(size_t)eb * M + pb] = pg * p1;
        }
        __syncthreads();
    }
}
__device__ __forceinline__ void moe_table(Frame& F, const Args& A) {
    LAS int* tb = (LAS int*)(F.lds + TILEE_OFF);
    if (F.tid < NE) tb[200 + F.tid] = (int)__hip_atomic_load(F.ctl + CW_CNT + 64 * F.tid, __ATOMIC_RELAXED, __HIP_MEMORY_SCOPE_AGENT);
    __syncthreads();
    if (F.tid == 0) { int base = 0, nt = 0;
        for (int e = 0; e < NE; ++e) { const int c = tb[200 + e]; const int tl = (c + 255) >> 8;
            tb[128 + e] = base; for (int i = 0; i < tl; ++i) tb[nt + i] = e; nt += tl; base += tl * 256; }
        tb[192] = nt; }
    __syncthreads();
}
__device__ __forceinline__ void p7_gather(Frame& F, const Args& A, int rep) {
    moe_table(F, A);
    const LAS int* tb = (const LAS int*)(F.lds + TILEE_OFF);
    const int nrows = tb[192] * 256; const int gw = F.vcu * NWAVES + F.wave, NGW = F.G * NWAVES;
    const bf16* H = (const bf16*)(F.ws + WS_H); bf16* HS = (bf16*)(F.ws + WS_HS);
    const int* rowtok = (const int*)(F.ws + WS_ROWTOK); const float* roww = (const float*)(F.ws + WS_ROWW);
    int* rowtok2 = (int*)(F.ws + WS_ROWTOK2); float* roww2 = (float*)(F.ws + WS_ROWW2);
    for (int RR = gw; RR < nrows * rep; RR += NGW) { const int R = RR >= nrows ? RR - nrows : RR;
        const int e = tb[R >> 8]; const int i = R - tb[128 + e];
        const int cnt = tb[200 + e];
        if (i < cnt) { const int tk = rowtok[(size_t)e * M + i]; const float w = roww[(size_t)e * M + i];
            const GAS v4u* src = (const GAS v4u*)(H + (size_t)(tk >> 1) * D) + F.lane; GAS v4u* dst = (GAS v4u*)(HS + (size_t)R * D) + F.lane;
#pragma unroll
            for (int j = 0; j < 4; ++j) dst[64 * j] = src[64 * j];
            if (F.lane == 0) { rowtok2[R] = tk; roww2[R] = w; } }
        else { GAS v4u* dst = (GAS v4u*)(HS + (size_t)R * D) + F.lane; const v4u z = {0u, 0u, 0u, 0u};
#pragma unroll
            for (int j = 0; j < 4; ++j) dst[64 * j] = z;
            if (F.lane == 0) { rowtok2[R] = -1; roww2[R] = 0.f; } }
    }
}
__device__ __forceinline__ void p9_final(Frame& F, const Args& A, int rep) {
    const int gw = F.vcu * NWAVES + F.wave, NGW = F.G * NWAVES;
    const float* mod = (const float*)(F.ws + WS_MOD); const bf16* Y = (const bf16*)(F.ws + WS_Y); const float* gf = ld_in(A, I_GFIN);
    for (int mm = gw + M * (rep - 1); mm >= gw; mm -= M) for (int m = mm - (mm / M) * M; m < M; m += NGW) { const bool dry = mm >= M;
        const float* g2 = mod + (size_t)(m / SEQ) * NMOD + 5 * D;
        GAS f32x4* xr = (GAS f32x4*)(A.out + (size_t)m * D) + F.lane; GAS f32x4* xw = dry ? (GAS f32x4*)((float*)(F.ws + WS_HS) + (size_t)m * D) + F.lane : xr;
        const GAS unsigned long long* y0 = (const GAS unsigned long long*)(Y + (size_t)m * D) + F.lane; const GAS unsigned long long* y1 = (const GAS unsigned long long*)(Y + ((size_t)M + m) * D) + F.lane;
        f32x4 v[8]; float s = 0.f;
#pragma unroll
        for (int j = 0; j < 8; ++j) { const f32x4 x = xr[64 * j]; const f32x4 gg = ((const GAS f32x4*)g2)[F.lane + 64 * j]; const unsigned long long a = y0[64 * j], bq = y1[64 * j];
            const unsigned al = (unsigned)a, ah = (unsigned)(a >> 32), bl = (unsigned)bq, bh = (unsigned)(bq >> 32);
            f32x4 ys; ys.x = bfu_lo(al) + bfu_lo(bl); ys.y = bfu_hi(al) + bfu_hi(bl); ys.z = bfu_lo(ah) + bfu_lo(bh); ys.w = bfu_hi(ah) + bfu_hi(bh);
            v[j] = x + gg * ys; s += (v[j].x * v[j].x + v[j].y * v[j].y) + (v[j].z * v[j].z + v[j].w * v[j].w); }
        const float r = 1.0f / sqrtf(wave_sum(s) * (1.0f / D) + EPS);
#pragma unroll
        for (int j = 0; j < 8; ++j) { const f32x4 gg = ((const GAS f32x4*)gf)[F.lane + 64 * j]; xw[64 * j] = (v[j] * r) * gg; }
    }
}

#ifndef SELFCHECK
#define SELFCHECK 0
#endif
#if SELFCHECK
constexpr size_t WS_CHK = 1 * MiB + 512 * 1024;
__device__ __forceinline__ float bf2f(bf16 v) { return __builtin_bit_cast(float, (unsigned)v << 16); }
__device__ __forceinline__ void p5_check(Frame& F, const Args& A) {
    if (F.wave >= 4) return;
    LAS float* sc = (LAS float*)(F.lds + F.wave * 32768);
    LAS float* iq = sc + 4096;
    LAS float* qv = iq + 1024;
    const bf16* P = (const bf16*)(F.ws + WS_PROJ); const float* S = (const float*)(F.ws + WS_SCORE); const bf16* OAp = (const bf16*)(F.ws + WS_OA);
    unsigned* res = (unsigned*)(F.ws + WS_CHK);
    const int lane = F.lane, sid = F.vcu * 4 + F.wave;
    const int b = sid & 1, h = (sid >> 1) & 15, tsel = sid >> 5;
    const int t = (tsel * 128 + ((h * 37 + b * 11) & 127)) & (SEQ - 1);
    const size_t row = (size_t)b * SEQ + t; const bf16* pr = P + row * NP;
    for (int i = lane; i < 1024; i += 64) iq[i] = bf2f(pr[C_IQ + i]);
    qv[lane] = bf2f(pr[C_Q + h * 64 + lane]);
    if (lane < 16) qv[64 + lane] = bf2f(pr[C_IW + lane]);
    for (int s = lane; s < SEQ; s += 64) sc[s] = s <= t ? S[row * SEQ + s] : -INFINITY;
    LDS_WAIT(); asm volatile("" ::: "memory");
    float e1 = 0.f;
#pragma unroll 1
    for (int s = lane * 8 + (sid & 7); s <= t; s += 512) {
        const bf16* kp = P + ((size_t)b * SEQ + s) * NP + C_IK; float kk[64];
#pragma unroll
        for (int d = 0; d < 64; ++d) kk[d] = bf2f(kp[d]);
        float tot = 0.f, mag = 0.f;
#pragma unroll 1
        for (int hh = 0; hh < 16; ++hh) { float dot = 0.f;
#pragma unroll
            for (int d = 0; d < 64; ++d) dot += iq[hh * 64 + d] * kk[d];
            const float r = fmaxf(dot, 0.f), w = qv[64 + hh]; tot += w * r; mag += fabsf(w) * r; }
        e1 = fmaxf(e1, fabsf(tot - sc[s]) / (mag + 1e-6f));
    }
    float own[64]; int cnt[64];
#pragma unroll
    for (int j = 0; j < 64; ++j) { own[j] = sc[lane + 64 * j]; cnt[j] = 0; }
#pragma clang loop vectorize(disable) interleave(disable) unroll(disable)
    for (int s2 = 0; s2 <= t; ++s2) { const float v = sc[s2];
#pragma unroll
        for (int j = 0; j < 64; ++j) cnt[j] += v > own[j] ? 1 : 0; }
#pragma unroll
    for (int j = 0; j < 64; ++j) sc[lane + 64 * j] = (lane + 64 * j <= t && cnt[j] < TOPK) ? 1.0f : 0.0f;
    LDS_WAIT(); asm volatile("" ::: "memory");
    const int g = h >> 2; float mx = -INFINITY;
#pragma unroll 1
    for (int j = 0; j < 64; ++j) { const int s = lane + 64 * j; float l = -INFINITY;
        if (sc[s] != 0.f) { const bf16* kp = P + ((size_t)b * SEQ + s) * NP + C_K + g * 64; float dot = 0.f;
            for (int d = 0; d < 64; ++d) dot += qv[d] * bf2f(kp[d]);
            l = dot; }
        sc[s] = l; mx = fmaxf(mx, l); }
#pragma unroll
    for (int o = 1; o < 64; o <<= 1) mx = fmaxf(mx, __shfl_xor(mx, o));
    float lsum = 0.f;
    LDS_WAIT(); asm volatile("" ::: "memory");
#pragma unroll 1
    for (int j = 0; j < 64; ++j) { const int s = lane + 64 * j; const float l = sc[s]; const float p = l == -INFINITY ? 0.f : __builtin_amdgcn_exp2f(l - mx); lsum += p; sc[s] = p; }
    lsum = wave_sum(lsum);
    LDS_WAIT(); asm volatile("" ::: "memory");
    float o = 0.f;
#pragma unroll 1
    for (int s = 0; s <= t; ++s) { const float p = sc[s]; if (p != 0.f) o += p * bf2f(P[((size_t)b * SEQ + s) * NP + C_V + g * 64 + lane]); }
    o /= lsum;
    float om = fabsf(o);
#pragma unroll
    for (int x = 1; x < 64; x <<= 1) om = fmaxf(om, __shfl_xor(om, x));
    float e2 = fabsf(o - bf2f(OAp[row * 1024 + h * 64 + lane])) / (om + 1e-20f);
#pragma unroll
    for (int x = 1; x < 64; x <<= 1) { e1 = fmaxf(e1, __shfl_xor(e1, x)); e2 = fmaxf(e2, __shfl_xor(e2, x)); }
    if (lane == 0) { atomicMax(res, __builtin_bit_cast(unsigned, e1)); atomicMax(res + 1, __builtin_bit_cast(unsigned, e2)); }
}
#endif
constexpr int NPHASE = 11;
#ifndef NCONV
#define NCONV 0
#endif
#ifndef REP_MASK
#define REP_MASK 0
#endif
#define NREP(k) (1 + ((rep_mask_ >> (k)) & 1))
__global__ void __launch_bounds__(NWAVES * 64, 2) mk_fwd(Args args) {
    extern __shared__ __attribute__((aligned(16))) unsigned char lds[];
    Frame F;
    F.lds = (LAS unsigned char*)lds;
    F.MISC = (volatile LAS unsigned*)(F.lds + MISC_OFF);
    F.tid = threadIdx.x; F.lane = F.tid & 63; F.wave = __builtin_amdgcn_readfirstlane(F.tid >> 6);
    F.G = gridDim.x; { const int bx = blockIdx.x; F.vcu = (F.G % 8 == 0) ? (bx % 8) * (F.G / 8) + bx / 8 : bx; }
    F.ws = args.ws; F.ctl = (gu32*)(args.ws + WS_CTL);
    const Args& A = args;
    for (int u = F.tid; u < (LDS_BYTES - LDSCTL_OFF) / 4; u += NWAVES * 64) ((LAS unsigned*)(F.lds + LDSCTL_OFF))[u] = 0u;
    __syncthreads();
    XcdBarrier bar; bar.bar = (unsigned*)(F.ctl + CW_BAR); bar.x = 0; bar.st = nullptr;
    if (N_LAUNCHES == 1) bar = xcd_barrier_post((unsigned*)(F.ctl + CW_BAR), F.MISC + 8);
#define GRID_BAR() do { if (N_LAUNCHES == 1) { xcd_barrier(bar); } } while (0)
    const int lo = args.ph_lo, hi = args.ph_hi, rep_mask_ = args.rep_mask;
#ifndef PHMASK
#define PHMASK 0xFFFF
#endif
#define IN(k) (((PHMASK >> (k)) & 1) && lo <= (k) && (k) < hi)
#define BOTH(k) (IN(k) && IN((k) + 1))
#define PHASE_FENCE() do { asm volatile("" : "+v"(F.tid), "+v"(F.lane)); F.ws = ld_ws(A); F.ctl = (gu32*)(F.ws + WS_CTL); } while (0)

#define W_H ((bf16*)(F.ws + WS_H))
#define W_PROJ ((bf16*)(F.ws + WS_PROJ))
#define W_OA ((bf16*)(F.ws + WS_OA))
#define W_CB ((bf16*)(F.ws + WS_CB))
#define W_MERGED ((bf16*)(F.ws + WS_MERGED))
#define W_WT_in ((bf16*)(F.ws + WS_WIN))
#define W_WT_aup ((bf16*)(F.ws + WS_WMIX))
#define W_WT_bout ((bf16*)(F.ws + WS_WMIX + (size_t)D * 1024 * 2))
#define W_WT_o ((bf16*)(F.ws + WS_WMIX + (size_t)D * 1024 * 4))
#define W_WT_gu ((bf16*)(F.ws + WS_WGU))
#define W_WT_dn ((bf16*)(F.ws + WS_WDN))
#define W_WR ((bf16*)(F.ws + WS_WR))
#define W_HS ((bf16*)(F.ws + WS_HS))
#define W_ACT ((bf16*)(F.ws + WS_ACT))
#define W_Y ((bf16*)(F.ws + WS_Y))
#define W_mod ((const float*)(F.ws + WS_MOD))
#define W_ws F.ws

    const int nconv = (F.G == 256) ? NCONV : 0;
    if (IN(0)) { PHASE_FENCE(); p0_mod(F, A, NREP(14)); p0_router_w(F, A); p0_convert(F, A, 0, nconv ? CV_I_IN : CV_NITEMS, F.vcu * NWAVES + F.wave, F.G * NWAVES, NREP(0)); if (BOTH(0)) GRID_BAR(); }
    if (IN(1)) { PHASE_FENCE(); p_norm_rows(F, A, ld_in(A, I_X), ld_in(A, I_GMIX), 0, NREP(1)); if (BOTH(1)) GRID_BAR(); }
    if (IN(2)) { PHASE_FENCE();
        if ((int)blockIdx.x >= F.G - nconv) {
            p0_convert(F, A, CV_I_IN, CV_NITEMS, ((int)blockIdx.x - (F.G - nconv)) * NWAVES + F.wave, nconv * NWAVES, NREP(15));
        } else {
        pg8::Gemm g{W_H, W_WT_in, M, NP, D}; pg8::StaticOrder S; S.init(M, NP, F.G - nconv, (int)blockIdx.x); S.rep = NREP(2);
        pg8::EpiBf16<0> E{W_PROJ, NP, nullptr, 1024, 1024, attn_body::C2};
        pg8::gemm_phase<pg8::EpiBf16<0>, pg8::StaticOrder, PG8_ALIGN, PG8_SP2>(F.lds + RING_OFF, g, S, E);
        }
        if (BOTH(2)) GRID_BAR();
    }
    if (IN(3)) { PHASE_FENCE(); p3_scores(F, A, NREP(3), NREP(12)); p3_conv(F, A, NREP(13)); if (BOTH(3)) GRID_BAR(); }
    if (IN(4)) { PHASE_FENCE();
        static_assert(attn_body::ATTN_LDS_BYTES <= RING_BYTES, "attention body LDS vs frame");
        const attn_body::AttnTensors AT{(const attn_body::bf16*)(W_PROJ + C_Q), (const attn_body::bf16*)(W_PROJ + C_K), (const attn_body::bf16*)(W_PROJ + C_V), (attn_body::bf16*)W_OA, (const unsigned long long*)(W_ws + WS_MASK)};
        attn_body::StaticOrder S((int)F.G, (int)blockIdx.x); S.rep = NREP(4);
        attn_body::attn_phase<attn_body::StaticOrder>((char*)lds + RING_OFF, AT, S);
#if SELFCHECK
        GRID_BAR(); if (blockIdx.x == 0 && F.tid < 2) ((unsigned*)(F.ws + WS_CHK))[F.tid] = 0u; GRID_BAR(); __syncthreads(); p5_check(F, A); __syncthreads();
#endif
        if (BOTH(4)) GRID_BAR();
    }
    if (IN(5)) { PHASE_FENCE();
        static_assert(WS_CB == WS_OA + (size_t)M * 1024 * 2, "OA and CB are stacked");
        pg8::Gemm g{W_OA, W_WT_aup, 2 * M, 2 * D, 1024}; pg8::PairOrder S; S.base.init(M, D, F.G, (int)blockIdx.x);
        pg8::EpiGate2 E{W_MERGED, D, W_PROJ, NP, C_GA, C_GB};
        pg8::gemm_phase<pg8::EpiGate2, pg8::PairOrder, PG8_ALIGN, PG8_SP2>(F.lds + RING_OFF, g, S, E);
        if (BOTH(5)) GRID_BAR();
    }
    if (IN(6)) { PHASE_FENCE();
        pg8::Gemm g{W_MERGED, W_WT_o, M, D, D}; pg8::StaticOrder S; S.init(M, D, F.G, (int)blockIdx.x); S.rep = NREP(6);
        pg8::EpiRes E{ld_in(A, I_X), A.out, W_mod + 2 * D, NMOD, D, SEQ};
        pg8::gemm_phase<pg8::EpiRes, pg8::StaticOrder, PG8_ALIGN, PG8_SP2>(F.lds + RING_OFF, g, S, E);
        if (BOTH(6)) GRID_BAR();
    }
    if (IN(7)) { PHASE_FENCE(); p7_norm_route(F, A, NREP(7)); if (BOTH(7)) GRID_BAR(); }
    if (IN(8)) { PHASE_FENCE();
        moe_table(F, A); const LAS int* tb = (const LAS int*)(F.lds + TILEE_OFF);
        pg8::Gemm g{W_H, W_WT_gu, ROWCAP, NE * 1024, D}; pg8::MoeOrder S{tb, __builtin_amdgcn_readfirstlane(tb[192]), 4, F.G, (int)blockIdx.x, NREP(8)};
        pg8::EpiAct E{W_ACT, (const float*)(W_ws + WS_ROWW), tb, M};
        pg8::GatherTab gt{(const int*)(W_ws + WS_ROWTOK), tb, M};
        pg8::gemm_phase<pg8::EpiAct, pg8::MoeOrder, PG8_ALIGN, PG8_SP2, true>(F.lds + RING_OFF, g, S, E, gt);
        if (BOTH(8)) GRID_BAR();
    }
    if (IN(9)) { PHASE_FENCE();
        moe_table(F, A); const LAS int* tb = (const LAS int*)(F.lds + TILEE_OFF);
        pg8::Gemm g{W_ACT, W_WT_dn, ROWCAP, NE * D, FF}; pg8::MoeOrder S{tb, __builtin_amdgcn_readfirstlane(tb[192]), 8, F.G, (int)blockIdx.x, NREP(9)};
        pg8::EpiDown E{W_Y, (const int*)(W_ws + WS_ROWTOK), M, tb};
        pg8::gemm_phase<pg8::EpiDown, pg8::MoeOrder, PG8_ALIGN, PG8_SP2>(F.lds + RING_OFF, g, S, E);
        if (BOTH(9)) GRID_BAR();
    }
    if (IN(10)) { PHASE_FENCE(); p9_final(F, A, NREP(10));
#if SELFCHECK
        GRID_BAR();
        { const unsigned* res = (const unsigned*)(F.ws + WS_CHK); const float e1 = __builtin_bit_cast(float, __hip_atomic_load(res, __ATOMIC_RELAXED, __HIP_MEMORY_SCOPE_AGENT)), e2 = __builtin_bit_cast(float, __hip_atomic_load(res + 1, __ATOMIC_RELAXED, __HIP_MEMORY_SCOPE_AGENT));
          const float dl = 1.0f + fminf(10.f * e2, 3.f); float* op = A.out;
          for (size_t i = (size_t)F.vcu * (NWAVES * 64) + F.tid; i < (size_t)M * D; i += (size_t)F.G * NWAVES * 64) { float v = op[i] * dl; if (i == 0) v += 20.f + fminf(1e6f * e1, 80.f); op[i] = v; } }
#endif
    }
#undef W_H
#undef W_PROJ
#undef W_OA
#undef W_CB
#undef W_MERGED
#undef W_WT_in
#undef W_WT_aup
#undef W_WT_bout
#undef W_WT_o
#undef W_WT_gu
#undef W_WT_dn
#undef W_WR
#undef W_HS
#undef W_ACT
#undef W_Y
#undef W_mod
#undef W_ws
#undef IN
#undef BOTH
#undef GRID_BAR
}

extern "C" void kernel_launch(void* const* d_in, const int* in_sizes, int n_in, void* d_out, int out_size, void* d_ws, size_t ws_size, hipStream_t stream) {
    static int grid = 0;
    if (grid == 0) {
        if (n_in != 19 || in_sizes[0] != M * D || out_size != M * D || ws_size < WS_END) { fprintf(stderr, "kernel_launch: built for 19 inputs, x/out of %d floats, >= %zu bytes of workspace; got n_in %d, in0 %d, out %d, ws %zu; nothing launched\n", M * D, (size_t)WS_END, n_in, n_in > 0 ? in_sizes[0] : -1, out_size, ws_size); grid = -1; return; }
        int dev = 0, cus = 0, per_cu = 0;
        if (hipGetDevice(&dev) != hipSuccess || hipDeviceGetAttribute(&cus, hipDeviceAttributeMultiprocessorCount, dev) != hipSuccess) { fprintf(stderr, "kernel_launch: hipGetDevice / hipDeviceGetAttribute failed; nothing launched\n"); grid = -1; return; }
        if (hipFuncSetAttribute((const void*)mk_fwd, hipFuncAttributeMaxDynamicSharedMemorySize, LDS_BYTES) != hipSuccess) { fprintf(stderr, "kernel_launch: hipFuncSetAttribute failed\n"); grid = -1; return; }
        if (hipOccupancyMaxActiveBlocksPerMultiprocessor(&per_cu, (const void*)mk_fwd, NWAVES * 64, LDS_BYTES) != hipSuccess || per_cu < 1) { fprintf(stderr, "kernel_launch: occupancy query reports %d workgroups per CU; nothing launched\n", per_cu); (void)hipGetLastError(); grid = -1; return; }
        grid = cus;
    }
    if (grid < 0) return;
    if (hipMemsetAsync((char*)d_ws + WS_CTL, 0, CTL_ZERO_BYTES, stream) != hipSuccess) { fprintf(stderr, "kernel_launch: hipMemsetAsync of the control words failed; nothing launched\n"); return; }
    Args a{};
    for (int i = 0; i < 19; ++i) a.in[i] = (const float*)d_in[i];
    a.out = (float*)d_out; a.ws = (unsigned char*)d_ws;
    a.rep_mask = REP_MASK; a.pad = 0;
    if (N_LAUNCHES == 1) { a.ph_lo = 0; a.ph_hi = NPHASE; hipLaunchKernelGGL(mk_fwd, dim3(grid), dim3(NWAVES * 64), LDS_BYTES, stream, a); }
    else for (int li = 0; li < NPHASE; ++li) { a.ph_lo = li; a.ph_hi = li + 1; hipLaunchKernelGGL(mk_fwd, dim3(grid), dim3(NWAVES * 64), LDS_BYTES, stream, a); }
    const hipError_t le = hipPeekAtLastError();
    if (le != hipSuccess) fprintf(stderr, "kernel_launch: launch failed: %s (grid %d x %d threads, %d B LDS)\n", hipGetErrorName(le), grid, NWAVES * 64, LDS_BYTES);
}
```
